# Optimizing an MI355X kernel written in HIP

```python
import jax, jax.numpy as jnp
from jax import lax
import numpy as np

D_MODEL = 1024
BATCH = 8
SEQ = 2048
DEPTH = 4

GRID_W = 64
CTX_LEN = 256
N_MIXERS = 3
MOD_CHUNKS = 6
NORM_EPS = 1e-6

SGU_CHUNK = 128
SGU_WIDTH = 2 * D_MODEL
SGU_GROUPS = 8
SGU_GROUP_DIM = SGU_WIDTH // SGU_GROUPS

POOL_WINDOWS = (2, 4, 8, 16)
POOL_WIDTH = D_MODEL
POOL_GROUPS = len(POOL_WINDOWS)
POOL_GROUP_DIM = POOL_WIDTH // POOL_GROUPS

HEAD_DIM = 128
N_Q_HEADS = D_MODEL // HEAD_DIM
N_KV_HEADS = 2
Q_PER_KV = N_Q_HEADS // N_KV_HEADS
AXIS_DIM = HEAD_DIM // 2
ROPE_THETA = 10000.0
ATTN_BLOCK = 128

PEER_HEADS = 8
PEER_KEYS = 128
PEER_EXPERTS = PEER_KEYS * PEER_KEYS
PEER_TOPK = 16
PEER_QDIM = 256
PEER_HALF = PEER_QDIM // 2
PEER_CHUNK = 128

kernel_name = 'hybrid_diffusion_sgu_pool_gqa_peer'


def _rmsnorm(x, gain):
    xf = x.astype(jnp.float32)
    y = xf * lax.rsqrt(jnp.mean(xf * xf, axis=-1, keepdims=True) + NORM_EPS)
    return (y * gain.astype(jnp.float32)).astype(x.dtype)


def _modulate(x, gain, shift, scale):
    return _rmsnorm(x, gain) * (1 + scale) + shift


def _gelu(x):
    return jax.nn.gelu(x, approximate=False)


def _sgu_mixer(h, w_in, v_gain, w_s, b_s, w_out):
    bsz, length, _ = h.shape
    z = _gelu(h @ w_in)
    u, v = z[..., :SGU_WIDTH], z[..., SGU_WIDTH:]
    v = _rmsnorm(v, v_gain).reshape(bsz, length // SGU_CHUNK, SGU_CHUNK, SGU_GROUPS, SGU_GROUP_DIM)
    sv = jnp.einsum('gpq,bnqgd->bnpgd', w_s, v) + b_s.T[:, :, None]
    return (u * sv.reshape(bsz, length, SGU_WIDTH)) @ w_out


def _pool_mixer(h, w_in, w_grp, scale, w_out):
    bsz, length, _ = h.shape
    z = (h @ w_in).astype(jnp.float32).reshape(bsz, length, POOL_GROUPS, POOL_GROUP_DIM)
    cs = jnp.concatenate([jnp.zeros_like(z[:, :1]), jnp.cumsum(z, axis=1)], axis=1)
    t = jnp.arange(length)[:, None]
    half = jnp.array(POOL_WINDOWS, dtype=jnp.int32)[None, :] // 2
    lo = jnp.clip(t - half, 0, length)
    hi = jnp.clip(t + half, 0, length)
    gidx = jnp.arange(POOL_GROUPS)[None, :]
    cnt = (hi - lo).astype(jnp.float32)[None, :, :, None]
    pooled = (cs[:, hi, gidx] - cs[:, lo, gidx]) / cnt - z
    y = jnp.einsum('blgc,gcd->blgd', pooled, w_grp.astype(jnp.float32)).reshape(bsz, length, POOL_WIDTH)
    y = (y * scale.astype(jnp.float32)).astype(h.dtype)
    return y @ w_out


def _axial_rope_tables(length):
    rows = length // GRID_W
    r, col = jnp.meshgrid(jnp.arange(rows), jnp.arange(GRID_W), indexing='ij')
    pos = jnp.stack([r.reshape(-1), col.reshape(-1)], axis=-1).astype(jnp.float32)
    freqs = ROPE_THETA ** (-jnp.arange(0, AXIS_DIM, 2, dtype=jnp.float32) / AXIS_DIM)
    ang = pos[:, :, None] * freqs
    return jnp.cos(ang), jnp.sin(ang)


def _apply_axial_rope(x, cos, sin):
    xf = x.astype(jnp.float32).reshape(*x.shape[:-1], 2, AXIS_DIM)
    x1, x2 = xf[..., :AXIS_DIM // 2], xf[..., AXIS_DIM // 2:]
    c = cos[None, :, None]
    s = sin[None, :, None]
    out = jnp.concatenate([x1 * c - x2 * s, x2 * c + x1 * s], axis=-1)
    return out.reshape(x.shape).astype(x.dtype)


def _attend(q, k, v):
    s = jnp.einsum('bqhgd,bkhd->bhgqk', q, k).astype(jnp.float32) * (HEAD_DIM ** -0.5)
    p = jax.nn.softmax(s, axis=-1).astype(v.dtype)
    return jnp.einsum('bhgqk,bkhd->bqhgd', p, v)


def _attn_mixer(h_lat, h_ctx, w_qkv, q_gain, k_gain, w_o, need_ctx):
    def project(h):
        b, l, _ = h.shape
        qkv = h @ w_qkv
        nq, nk = N_Q_HEADS * HEAD_DIM, N_KV_HEADS * HEAD_DIM
        q = _rmsnorm(qkv[..., :nq].reshape(b, l, N_Q_HEADS, HEAD_DIM), q_gain)
        k = _rmsnorm(qkv[..., nq:nq + nk].reshape(b, l, N_KV_HEADS, HEAD_DIM), k_gain)
        v = qkv[..., nq + nk:].reshape(b, l, N_KV_HEADS, HEAD_DIM)
        return q, k, v

    bsz, length, _ = h_lat.shape
    ctx_len = h_ctx.shape[1]
    q_lat, k_lat, v_lat = project(h_lat)
    q_ctx, k_ctx, v_ctx = project(h_ctx)
    cos, sin = _axial_rope_tables(length)
    q_lat = _apply_axial_rope(q_lat, cos, sin).reshape(bsz, length, N_KV_HEADS, Q_PER_KV, HEAD_DIM)
    k_lat = _apply_axial_rope(k_lat, cos, sin)
    keys = jnp.concatenate([k_lat, k_ctx], axis=1)
    vals = jnp.concatenate([v_lat, v_ctx], axis=1)
    qb = q_lat.reshape(bsz, length // ATTN_BLOCK, ATTN_BLOCK, N_KV_HEADS, Q_PER_KV, HEAD_DIM).swapaxes(0, 1)
    o = lax.map(lambda blk: _attend(blk, keys, vals), qb)
    y_lat = o.swapaxes(0, 1).reshape(bsz, length, N_Q_HEADS * HEAD_DIM) @ w_o
    y_ctx = None
    if need_ctx:
        qc = q_ctx.reshape(bsz, ctx_len, N_KV_HEADS, Q_PER_KV, HEAD_DIM)
        y_ctx = _attend(qc, k_ctx, v_ctx).reshape(bsz, ctx_len, N_Q_HEADS * HEAD_DIM) @ w_o
    return y_lat, y_ctx


def _peer(h, w_q, k1, k2, u_tab, v_tab):
    n_tok = h.shape[0]
    q = (h @ w_q).reshape(n_tok, PEER_HEADS, PEER_QDIM)
    s1 = jnp.einsum('thd,hnd->thn', q[..., :PEER_HALF], k1).astype(jnp.float32)
    s2 = jnp.einsum('thd,hnd->thn', q[..., PEER_HALF:], k2).astype(jnp.float32)
    v1, i1 = lax.top_k(s1, PEER_TOPK)
    v2, i2 = lax.top_k(s2, PEER_TOPK)
    cand = (v1[..., :, None] + v2[..., None, :]).reshape(n_tok, PEER_HEADS, PEER_TOPK * PEER_TOPK)
    cidx = (i1[..., :, None] * PEER_KEYS + i2[..., None, :]).reshape(n_tok, PEER_HEADS, PEER_TOPK * PEER_TOPK)
    best, pos = lax.top_k(cand, PEER_TOPK)
    eidx = jnp.take_along_axis(cidx, pos, axis=-1)
    gate = jax.nn.softmax(best, axis=-1).astype(h.dtype)

    def block(args):
        hc, ic, gc = args
        act = jnp.einsum('chkd,cd->chk', jnp.take(u_tab, ic, axis=0), hc)
        return jnp.einsum('chk,chkd->cd', _gelu(act) * gc, jnp.take(v_tab, ic, axis=0))

    nb = n_tok // PEER_CHUNK
    out = lax.map(block, (h.reshape(nb, PEER_CHUNK, -1),
                          eidx.reshape(nb, PEER_CHUNK, PEER_HEADS, PEER_TOPK),
                          gate.reshape(nb, PEER_CHUNK, PEER_HEADS, PEER_TOPK)))
    return out.reshape(n_tok, -1)


def setup_inputs(seed: int = 0) -> dict:
    key = jax.random.key(seed)
    ks = iter(jax.random.split(key, 32))

    def nrm(shape, scale):
        return jax.random.normal(next(ks), shape, jnp.float32) * scale

    d = D_MODEL
    n_sgu = len(range(0, DEPTH, N_MIXERS))
    n_pool = len(range(1, DEPTH, N_MIXERS))
    n_attn = len(range(2, DEPTH, N_MIXERS))
    qkv_w = (N_Q_HEADS + 2 * N_KV_HEADS) * HEAD_DIM
    return {
        'x': nrm((BATCH, SEQ, d), 1.0),
        'c': nrm((BATCH, d), 1.0),
        'ctx': nrm((BATCH, CTX_LEN, d), 1.0),
        'c_ctx': nrm((d,), 1.0),
        'ada_w': nrm((DEPTH, d, MOD_CHUNKS * d), 0.5 * d ** -0.5),
        'ada_b': nrm((DEPTH, MOD_CHUNKS * d), 0.02),
        'norm1_g': 1.0 + nrm((DEPTH, d), 0.05),
        'norm2_g': 1.0 + nrm((DEPTH, d), 0.05),
        'sgu_w_in': nrm((n_sgu, d, 2 * SGU_WIDTH), d ** -0.5),
        'sgu_v_gain': 1.0 + nrm((n_sgu, SGU_WIDTH), 0.05),
        'sgu_w_s': nrm((n_sgu, SGU_GROUPS, SGU_CHUNK, SGU_CHUNK), SGU_CHUNK ** -0.5),
        'sgu_b_s': 1.0 + nrm((n_sgu, SGU_GROUPS, SGU_CHUNK), 0.05),
        'sgu_w_out': nrm((n_sgu, SGU_WIDTH, d), SGU_WIDTH ** -0.5),
        'pool_w_in': nrm((n_pool, d, POOL_WIDTH), d ** -0.5),
        'pool_w_grp': nrm((n_pool, POOL_GROUPS, POOL_GROUP_DIM, POOL_GROUP_DIM), POOL_GROUP_DIM ** -0.5),
        'pool_scale': 1.0 + nrm((n_pool, POOL_WIDTH), 0.05),
        'pool_w_out': nrm((n_pool, POOL_WIDTH, d), POOL_WIDTH ** -0.5),
        'attn_w_qkv': nrm((n_attn, d, qkv_w), d ** -0.5),
        'attn_q_gain': 1.0 + nrm((n_attn, HEAD_DIM), 0.05),
        'attn_k_gain': 1.0 + nrm((n_attn, HEAD_DIM), 0.05),
        'attn_w_o': nrm((n_attn, N_Q_HEADS * HEAD_DIM, d), (N_Q_HEADS * HEAD_DIM) ** -0.5),
        'peer_w_q': nrm((DEPTH, d, PEER_HEADS * PEER_QDIM), d ** -0.5),
        'peer_k1': nrm((DEPTH, PEER_HEADS, PEER_KEYS, PEER_HALF), PEER_HALF ** -0.5),
        'peer_k2': nrm((DEPTH, PEER_HEADS, PEER_KEYS, PEER_HALF), PEER_HALF ** -0.5),
        'peer_u': nrm((DEPTH, PEER_EXPERTS, d), d ** -0.5),
        'peer_v': nrm((DEPTH, PEER_EXPERTS, d), PEER_HEADS ** -0.5),
        'final_gain': 1.0 + nrm((d,), 0.05),
    }


def reference(x, c, ctx, c_ctx, ada_w, ada_b, norm1_g, norm2_g, sgu_w_in, sgu_v_gain, sgu_w_s, sgu_b_s,
              sgu_w_out, pool_w_in, pool_w_grp, pool_scale, pool_w_out, attn_w_qkv, attn_q_gain, attn_k_gain,
              attn_w_o, peer_w_q, peer_k1, peer_k2, peer_u, peer_v, final_gain):
    bsz, seq, d = x.shape
    ctx_len = ctx.shape[1]
    x_lat, x_ctx = x, ctx
    for i in range(DEPTH):
        kind, j = i % N_MIXERS, i // N_MIXERS
        need_ctx = i < DEPTH - 1
        mod_lat = jnp.split((jax.nn.silu(c) @ ada_w[i] + ada_b[i])[:, None, :], MOD_CHUNKS, axis=-1)
        mod_ctx = jnp.split((jax.nn.silu(c_ctx) @ ada_w[i] + ada_b[i])[None, None, :], MOD_CHUNKS, axis=-1)

        h_lat = _modulate(x_lat, norm1_g[i], mod_lat[0], mod_lat[1])
        h_ctx = _modulate(x_ctx, norm1_g[i], mod_ctx[0], mod_ctx[1]) if (need_ctx or kind == 2) else None
        y_ctx = None
        if kind == 0:
            y_lat = _sgu_mixer(h_lat, sgu_w_in[j], sgu_v_gain[j], sgu_w_s[j], sgu_b_s[j], sgu_w_out[j])
            if need_ctx:
                y_ctx = _sgu_mixer(h_ctx, sgu_w_in[j], sgu_v_gain[j], sgu_w_s[j], sgu_b_s[j], sgu_w_out[j])
        elif kind == 1:
            y_lat = _pool_mixer(h_lat, pool_w_in[j], pool_w_grp[j], pool_scale[j], pool_w_out[j])
            if need_ctx:
                y_ctx = _pool_mixer(h_ctx, pool_w_in[j], pool_w_grp[j], pool_scale[j], pool_w_out[j])
        else:
            y_lat, y_ctx = _attn_mixer(h_lat, h_ctx, attn_w_qkv[j], attn_q_gain[j], attn_k_gain[j],
                                       attn_w_o[j], need_ctx)
        x_lat = x_lat + mod_lat[2] * y_lat
        if need_ctx:
            x_ctx = x_ctx + mod_ctx[2] * y_ctx

        f_lat_in = _modulate(x_lat, norm2_g[i], mod_lat[3], mod_lat[4]).reshape(bsz * seq, d)
        if need_ctx:
            f_ctx_in = _modulate(x_ctx, norm2_g[i], mod_ctx[3], mod_ctx[4]).reshape(bsz * ctx_len, d)
            f = _peer(jnp.concatenate([f_lat_in, f_ctx_in], axis=0), peer_w_q[i], peer_k1[i], peer_k2[i],
                      peer_u[i], peer_v[i])
            f_lat = f[:bsz * seq]
            x_ctx = x_ctx + mod_ctx[5] * f[bsz * seq:].reshape(bsz, ctx_len, d)
        else:
            f_lat = _peer(f_lat_in, peer_w_q[i], peer_k1[i], peer_k2[i], peer_u[i], peer_v[i])
        x_lat = x_lat + mod_lat[5] * f_lat.reshape(bsz, seq, d)
    return _rmsnorm(x_lat, final_gain)
```

```cpp
#include <hip/hip_runtime.h>
#include <hip/hip_bf16.h>
#include <cstdio>
#include <cstdint>

#ifndef MK_MULTI
#define MK_MULTI 0
#endif
#ifndef PEER_SCALE
#define PEER_SCALE 1.0f
#endif
#ifndef REPL
#define REPL 15
#endif
#ifndef PREPREP
#define PREPREP 0
#endif
#ifndef GVAR
#define GVAR 0
#endif
#ifndef EMASK
#define EMASK 0xffffffff
#endif
#ifndef REPK
#define REPK 0
#endif
#ifndef TOPK_REF
#define TOPK_REF 0
#endif
#ifndef GATHER_REF
#define GATHER_REF 0
#endif
#ifndef ZB
#define ZB 0
#endif

template <int M> __device__ __forceinline__ unsigned shx_u(unsigned v) {
    if (M == 1) return (unsigned)__builtin_amdgcn_mov_dpp((int)v, 0xB1, 0xf, 0xf, true);
    if (M == 2) return (unsigned)__builtin_amdgcn_mov_dpp((int)v, 0x4E, 0xf, 0xf, true);
    if (M == 8) return (unsigned)__builtin_amdgcn_mov_dpp((int)v, 0x128, 0xf, 0xf, true);
    return (unsigned)__builtin_amdgcn_ds_swizzle((int)v, (M << 10) | 0x1f);
}
template <int M> __device__ __forceinline__ float shx(float v) { return __uint_as_float(shx_u<M>(__float_as_uint(v))); }
__device__ __forceinline__ unsigned shx32_u(unsigned v, bool upper) {
    auto r = __builtin_amdgcn_permlane32_swap(v, v, false, false); return upper ? r[0] : r[1]; }
__device__ __forceinline__ float shx32(float v, bool upper) { return __uint_as_float(shx32_u(__float_as_uint(v), upper)); }
__device__ __forceinline__ float bperm(int srcLane, float v) { return __uint_as_float((unsigned)__builtin_amdgcn_ds_bpermute(srcLane << 2, (int)__float_as_uint(v))); }
__device__ __forceinline__ int bperm_i(int srcLane, int v) { return __builtin_amdgcn_ds_bpermute(srcLane << 2, v); }
namespace pg8 {
#define PG8_LAS __attribute__((address_space(3)))
typedef unsigned short bf16_t;
typedef short bf16x8 __attribute__((ext_vector_type(8)));
typedef float f32x4 __attribute__((ext_vector_type(4)));
typedef float f32x2 __attribute__((ext_vector_type(2)));
typedef unsigned u32x4 __attribute__((ext_vector_type(4)));
typedef unsigned u32x2 __attribute__((ext_vector_type(2)));
constexpr int BM = 256, BK = 64, HALF = 128, HTB = HALF * BK * 2, STAGE_BYTES = 8 * HTB, NXCD = 8, WGM = 8;

__host__ __device__ __forceinline__ int lds_byte(int r, int c) { const int st = (r >> 4) * 2 + (c >> 5), rr = r & 15, cc = c & 31, ob = rr * 64 + cc * 2; return st * 1024 + (ob ^ (((ob >> 9) & 1) << 5)); }
__host__ __device__ __forceinline__ void stage_rc(int b, int& R, int& C) { const int st = b / 1024, sb = b % 1024, swz = sb ^ (((sb >> 9) & 1) << 5); R = (st >> 1) * 16 + swz / 64; C = (st & 1) * 32 + (swz % 64) / 2; }
__host__ __device__ __forceinline__ int perm32(int rho) { const int n = rho >> 4, i = rho & 15; return 8 * (i >> 2) + 4 * n + (i & 3); }

struct Unit { int pm, pn; };
struct Gemm { const bf16_t* A; const bf16_t* Bt; int lda, ldb, K, nM, nN; long a_pm, a_pn, b_pm, b_pn; };

struct StaticOrder {
    int nM, nN, nwg, G, c;
    __host__ __device__ void init(int nM_, int nN_, int G_, int c_) { nM = nM_; nN = nN_; nwg = nM * nN; G = G_; c = c_; }
    __host__ __device__ bool next(int i, Unit& u) const {
        const long L = (long)i * G + c; if (L >= nwg) return false;
        int wgid = (int)L; { const int q = nwg / NXCD, r = nwg % NXCD, xcd = wgid % NXCD, off = wgid / NXCD; wgid = (xcd < r ? xcd * (q + 1) : r * (q + 1) + (xcd - r) * q) + off; }
        const int nig = WGM * nN, gid = wgid / nig, fm = gid * WGM, gsz = (nM - fm) < WGM ? (nM - fm) : WGM;
        u.pm = fm + ((wgid % nig) % gsz); u.pn = (wgid % nig) / gsz; return true;
    }
};

__device__ __forceinline__ unsigned cvt_pk_bf16(float lo, float hi) { unsigned r; asm volatile("v_cvt_pk_bf16_f32 %0, %1, %2" : "=v"(r) : "v"(lo), "v"(hi)); return r; }
__device__ __forceinline__ f32x2 gelu_pk(f32x2 v) {
    const f32x2 av = __builtin_elementwise_abs(v), d = av * 0.2316418882f + 1.0f;
    f32x2 t; t.x = __builtin_amdgcn_rcpf(d.x); t.y = __builtin_amdgcn_rcpf(d.y);
    f32x2 q = t * 0.5307027145f + (-0.7265760135f); q = q * t + 0.7107068705f; q = q * t + (-0.142248368f); q = q * t + 0.127414796f; q = q * t;
    const f32x2 s = (v * v) * (-0.72134752044f);
    f32x2 e; e.x = __builtin_amdgcn_exp2f(s.x); e.y = __builtin_amdgcn_exp2f(s.y);
    const f32x2 m = v * (q * e), r = v - m;
    f32x2 o; o.x = v.x < 0.f ? m.x : r.x; o.y = v.y < 0.f ? m.y : r.y; return o;
}
__device__ __forceinline__ float gelu1(float v) { f32x2 r = gelu_pk((f32x2){v, v}); return r.x; }
__device__ __forceinline__ f32x4 gelu4(f32x4 v) { f32x2 a = gelu_pk((f32x2){v[0], v[1]}), b = gelu_pk((f32x2){v[2], v[3]}); return (f32x4){a.x, a.y, b.x, b.y}; }

struct EpiAny {
    int type;
    bool perm;
    void* O; int ldc; int act; const float* mul; long o_pm, o_pn;
    const float* srcLat; const float* srcCtx; void* X; const void* Xsrc; const float* modl; int nlat; int chunk;
    float* SS;
    float gs;
    __device__ __forceinline__ void bf16_store(const f32x4 (&acc)[2][2][4][2], const Unit& u, int wr, int wc, int fr, int fq) const {
        bf16_t* base = (bf16_t*)O + u.pm * o_pm + u.pn * o_pn;
        const int row0 = wr * 64 + fr, col0 = wc * 32 + 8 * fq;
        f32x4 mv[2][2];
#pragma unroll
        for (int bj = 0; bj < 2; ++bj)
#pragma unroll
            for (int n = 0; n < 2; ++n) mv[bj][n] = mul ? *(const f32x4*)(mul + u.pn * BM + col0 + bj * HALF + 4 * n) : (f32x4){1.f, 1.f, 1.f, 1.f};
#pragma unroll
        for (int ai = 0; ai < 2; ++ai)
#pragma unroll
            for (int m = 0; m < 4; ++m) { bf16_t* rowp = base + (size_t)(row0 + ai * HALF + m * 16) * ldc + col0;
#pragma unroll
                for (int bj = 0; bj < 2; ++bj) { f32x4 v0 = acc[ai][bj][m][0], v1 = acc[ai][bj][m][1];
                    if (act == 1) { v0 = gelu4(v0); v1 = gelu4(v1); }
                    v0 = v0 * mv[bj][0]; v1 = v1 * mv[bj][1];
                    u32x4 w;
                    if (act == 2) {
                        w.x = __builtin_bit_cast(unsigned, __builtin_amdgcn_cvt_pkrtz(v0[0], v0[1])); w.y = __builtin_bit_cast(unsigned, __builtin_amdgcn_cvt_pkrtz(v0[2], v0[3]));
                        w.z = __builtin_bit_cast(unsigned, __builtin_amdgcn_cvt_pkrtz(v1[0], v1[1])); w.w = __builtin_bit_cast(unsigned, __builtin_amdgcn_cvt_pkrtz(v1[2], v1[3]));
                    } else { w.x = cvt_pk_bf16(v0[0], v0[1]); w.y = cvt_pk_bf16(v0[2], v0[3]); w.z = cvt_pk_bf16(v1[0], v1[1]); w.w = cvt_pk_bf16(v1[2], v1[3]); }
                    *(u32x4*)(rowp + bj * HALF) = w; } }
    }
    __device__ __forceinline__ void f32_store(const f32x4 (&acc)[2][2][4][2], const Unit& u, int wr, int wc, int fr, int fq) const {
        float* C = (float*)O;
        const int row0 = u.pm * BM + wr * 64 + fr, col0 = u.pn * BM + wc * 32 + 4 * fq;
#pragma unroll
        for (int ai = 0; ai < 2; ++ai)
#pragma unroll
            for (int m = 0; m < 4; ++m) { float* rowp = C + (size_t)(row0 + ai * HALF + m * 16) * ldc + col0;
#pragma unroll
                for (int bj = 0; bj < 2; ++bj)
#pragma unroll
                    for (int n = 0; n < 2; ++n) *(f32x4*)(rowp + bj * HALF + n * 16) = acc[ai][bj][m][n]; }
    }
    __device__ __forceinline__ void resid(const f32x4 (&acc)[2][2][4][2], const Unit& u, int wr, int wc, int fr, int fq) const {
        const int rowt = u.pm * BM; const int mr = rowt < nlat ? (rowt >> 11) : 8;
        const float* gp = modl + mr * 6144 + chunk * 1024;
        bf16_t* xp = (bf16_t*)X + (size_t)rowt * 1024;
        const int row0 = wr * 64 + fr, col0 = u.pn * BM + wc * 32 + 8 * fq;
        f32x4 gv[2][2];
#pragma unroll
        for (int bj = 0; bj < 2; ++bj)
#pragma unroll
            for (int n = 0; n < 2; ++n) gv[bj][n] = *(const f32x4*)(gp + col0 + bj * HALF + n * 4) * gs;
        if (srcLat) {
            const float* sp = rowt < nlat ? srcLat + (size_t)rowt * 1024 : srcCtx + (size_t)(rowt - nlat) * 1024;
#pragma unroll
            for (int ai = 0; ai < 2; ++ai)
#pragma unroll
                for (int m = 0; m < 4; ++m) { const size_t off = (size_t)(row0 + ai * HALF + m * 16) * 1024 + col0;
#pragma unroll
                    for (int bj = 0; bj < 2; ++bj) { const f32x4 s0 = *(const f32x4*)(sp + off + bj * HALF), s1 = *(const f32x4*)(sp + off + bj * HALF + 4);
                        const f32x4 y0 = s0 + gv[bj][0] * acc[ai][bj][m][0], y1 = s1 + gv[bj][1] * acc[ai][bj][m][1];
                        u32x4 w; w.x = cvt_pk_bf16(y0[0], y0[1]); w.y = cvt_pk_bf16(y0[2], y0[3]); w.z = cvt_pk_bf16(y1[0], y1[1]); w.w = cvt_pk_bf16(y1[2], y1[3]);
                        *(u32x4*)(xp + off + bj * HALF) = w; }
                    if (m & 1) asm volatile("" ::: "memory"); }
        } else {
            const bf16_t* sp = (const bf16_t*)Xsrc + (size_t)rowt * 1024;
#pragma unroll
            for (int ai = 0; ai < 2; ++ai)
#pragma unroll
                for (int m = 0; m < 4; ++m) { const size_t off = (size_t)(row0 + ai * HALF + m * 16) * 1024 + col0;
#pragma unroll
                    for (int bj = 0; bj < 2; ++bj) { const u32x4 sv = *(const u32x4*)(sp + off + bj * HALF);
                        const f32x4 s0 = {__uint_as_float(sv.x << 16), __uint_as_float(sv.x & 0xffff0000u), __uint_as_float(sv.y << 16), __uint_as_float(sv.y & 0xffff0000u)};
                        const f32x4 s1 = {__uint_as_float(sv.z << 16), __uint_as_float(sv.z & 0xffff0000u), __uint_as_float(sv.w << 16), __uint_as_float(sv.w & 0xffff0000u)};
                        const f32x4 y0 = s0 + gv[bj][0] * acc[ai][bj][m][0], y1 = s1 + gv[bj][1] * acc[ai][bj][m][1];
                        u32x4 w; w.x = cvt_pk_bf16(y0[0], y0[1]); w.y = cvt_pk_bf16(y0[2], y0[3]); w.z = cvt_pk_bf16(y1[0], y1[1]); w.w = cvt_pk_bf16(y1[2], y1[3]);
                        *(u32x4*)(xp + off + bj * HALF) = w; }
                    if (m & 1) asm volatile("" ::: "memory"); }
        }
    }
    __device__ __forceinline__ void swapv(const f32x4 (&acc)[2][2][4][2], const Unit& u, int wr, int wc, int fr, int fq) const {
        bf16_t* base = (bf16_t*)O + (size_t)u.pm * BM * ldc + (size_t)u.pn * BM;
        const int row0 = wr * 64 + fr, col0 = wc * 32 + 8 * fq;
        float cs[16];
#pragma unroll
        for (int i = 0; i < 16; ++i) cs[i] = 0.f;
#pragma unroll
        for (int ai = 0; ai < 2; ++ai)
#pragma unroll
            for (int m = 0; m < 4; ++m) { bf16_t* rowp = base + (size_t)(row0 + ai * HALF + m * 16) * ldc + col0;
#pragma unroll
                for (int bj = 0; bj < 2; ++bj) { const f32x4 v0 = gelu4(acc[ai][bj][m][0]), v1 = gelu4(acc[ai][bj][m][1]);
#pragma unroll
                    for (int e = 0; e < 4; ++e) { cs[bj * 8 + e] += v0[e] * v0[e]; cs[bj * 8 + 4 + e] += v1[e] * v1[e]; }
                    u32x4 w; w.x = cvt_pk_bf16(v0[0], v0[1]); w.y = cvt_pk_bf16(v0[2], v0[3]); w.z = cvt_pk_bf16(v1[0], v1[1]); w.w = cvt_pk_bf16(v1[2], v1[3]);
                    *(u32x4*)(rowp + bj * HALF) = w; } }
        const bool b3 = fr & 8, b2 = fr & 4, b1 = fr & 2, b0 = fr & 1;
        float d[8], e4[4], f2[2];
#pragma unroll
        for (int i = 0; i < 8; ++i) { const float mine = b3 ? cs[8 + i] : cs[i], send = b3 ? cs[i] : cs[8 + i]; d[i] = mine + shx<8>(send); }
#pragma unroll
        for (int i = 0; i < 4; ++i) { const float mine = b2 ? d[4 + i] : d[i], send = b2 ? d[i] : d[4 + i]; e4[i] = mine + shx<4>(send); }
#pragma unroll
        for (int i = 0; i < 2; ++i) { const float mine = b1 ? e4[2 + i] : e4[i], send = b1 ? e4[i] : e4[2 + i]; f2[i] = mine + shx<2>(send); }
        const float tot = (b0 ? f2[1] : f2[0]) + shx<1>(b0 ? f2[0] : f2[1]);
        const int ci = fr;
        const int col = u.pn * BM + (ci >> 3) * HALF + wc * 32 + 8 * fq + (ci & 7);
        SS[(size_t)(u.pm * 2 + wr) * ldc + col] = tot;
    }
    __device__ __forceinline__ void operator()(const f32x4 (&acc)[2][2][4][2], const Unit& u, int wr, int wc, int fr, int fq) const {
        if (type == 0) bf16_store(acc, u, wr, wc, fr, fq);
        else if (type == 1) f32_store(acc, u, wr, wc, fr, fq);
        else if (type == 2) resid(acc, u, wr, wc, fr, fq);
        else swapv(acc, u, wr, wc, fr, fq);
    }
};

template <bool ALIGN_EPI = true>
__device__ __forceinline__ void gemm_phase(PG8_LAS unsigned char* lds, const Gemm g, const StaticOrder& S, const EpiAny& E, const int tid) {
    const int wid = __builtin_amdgcn_readfirstlane(tid >> 6), lane = tid & 63, wr = wid >> 2, wc = wid & 3, fr = lane & 15, fq = lane >> 4;
    const int nt = g.K / BK;
    unsigned voffA[2], voffB[2];
#pragma unroll
    for (int i = 0; i < 2; ++i) { int R, C; stage_rc(tid * 16 + i * 8192, R, C); const int Rb = E.perm ? ((R & ~31) + perm32(R & 31)) : R;
        voffA[i] = (unsigned)(R * g.lda + C) * 2u; voffB[i] = (unsigned)(Rb * g.ldb + C) * 2u; }
    const size_t kstep = (size_t)(BK * 2);
    const size_t hA = (size_t)HALF * g.lda * 2, hB = (size_t)HALF * g.ldb * 2;
    const unsigned ldsw = (unsigned)wid * 1024u;
    const int aoff = lds_byte(wr * 64 + fr, fq * 8), boff = lds_byte(wc * 32 + fr, fq * 8);
#define PG8_SA(b, h) (((b) * 2 + (h)) * HTB)
#define PG8_SB(b, h) ((4 + (b) * 2 + (h)) * HTB)
#define PG8_STAGE(bufoff, gbase, voff) do { _Pragma("unroll") for (int _i = 0; _i < 2; ++_i) \
        __builtin_amdgcn_global_load_lds((const unsigned*)((const char*)(gbase) + (voff)[_i]), (PG8_LAS unsigned*)(lds + (bufoff) + ldsw + _i * 8192), 16, 0, 0); } while (0)
#define PG8_LDA(dst, b, h) do { _Pragma("unroll") for (int m = 0; m < 4; ++m) _Pragma("unroll") for (int k = 0; k < 2; ++k) dst[m][k] = *(const PG8_LAS bf16x8*)(lds + PG8_SA(b, h) + aoff + m * 2048 + k * 1024); } while (0)
#define PG8_LDB(dst, b, h) do { _Pragma("unroll") for (int n = 0; n < 2; ++n) _Pragma("unroll") for (int k = 0; k < 2; ++k) dst[n][k] = *(const PG8_LAS bf16x8*)(lds + PG8_SB(b, h) + boff + n * 2048 + k * 1024); } while (0)
#define PG8_MMA(ai, bj, At, Bt) do { __builtin_amdgcn_s_setprio(1); _Pragma("unroll") for (int m = 0; m < 4; ++m) _Pragma("unroll") for (int n = 0; n < 2; ++n) _Pragma("unroll") for (int k = 0; k < 2; ++k) \
        acc[ai][bj][m][n] = __builtin_amdgcn_mfma_f32_16x16x32_bf16(Bt[n][k], At[m][k], acc[ai][bj][m][n], 0, 0, 0); __builtin_amdgcn_s_setprio(0); } while (0)
#define PG8_WAIT_V(n) asm volatile("s_waitcnt vmcnt(" #n ")" ::: "memory")
#define PG8_WAIT_L(n) asm volatile("s_waitcnt lgkmcnt(" #n ")" ::: "memory")
#define PG8_BAR __builtin_amdgcn_s_barrier()
#define PG8_SCHED __builtin_amdgcn_sched_barrier(0)
#define PG8_PA(u) ((const char*)g.A + 2 * ((long)(u).pm * g.a_pm + (long)(u).pn * g.a_pn))
#define PG8_PB(u) ((const char*)g.Bt + 2 * ((long)(u).pm * g.b_pm + (long)(u).pn * g.b_pn))
    Unit cur, nxt; int ui = 0;
    if (!S.next(0, cur)) return;
    f32x4 acc[2][2][4][2];
#pragma unroll
    for (int a = 0; a < 2; ++a)
#pragma unroll
        for (int b = 0; b < 2; ++b)
#pragma unroll
            for (int m = 0; m < 4; ++m)
#pragma unroll
                for (int n = 0; n < 2; ++n) acc[a][b][m][n] = (f32x4){0.f, 0.f, 0.f, 0.f};
    bf16x8 At[4][2], B0[2][2], B1[2][2];
    const char* cA = PG8_PA(cur); const char* cB = PG8_PB(cur);
    PG8_STAGE(PG8_SB(0, 0), cB, voffB); PG8_STAGE(PG8_SB(0, 1), cB + hB, voffB); PG8_STAGE(PG8_SA(0, 0), cA, voffA); PG8_STAGE(PG8_SA(0, 1), cA + hA, voffA);
    if (wr == 1) PG8_BAR;
    PG8_WAIT_V(2); PG8_BAR;
    PG8_STAGE(PG8_SB(1, 0), cB + kstep, voffB); PG8_STAGE(PG8_SA(1, 0), cA + kstep, voffA); PG8_STAGE(PG8_SB(1, 1), cB + hB + kstep, voffB);
    PG8_WAIT_V(6); PG8_BAR;
    for (;;) {
        const bool has_next = S.next(ui + 1, nxt);
        const char* nA = has_next ? PG8_PA(nxt) : cA; const char* nB = has_next ? PG8_PB(nxt) : cB;
        for (int t = 0; t < nt; t += 2) {
            const bool last = (t == nt - 2);
            const char* a1 = cA + (size_t)(t + 1) * kstep;
            const char* a2 = last ? nA : cA + (size_t)(t + 2) * kstep; const char* b2 = last ? nB : cB + (size_t)(t + 2) * kstep;
            const char* a3 = a2 + kstep; const char* b3 = b2 + kstep;
            PG8_LDB(B0, 0, 0); PG8_LDB(B1, 0, 1); PG8_SCHED; PG8_LDA(At, 0, 0); PG8_STAGE(PG8_SA(1, 1), a1 + hA, voffA);
            PG8_WAIT_V(8); PG8_WAIT_L(0); PG8_BAR; PG8_MMA(0, 0, At, B0); PG8_MMA(0, 1, At, B1); PG8_BAR; PG8_SCHED;
            PG8_LDA(At, 0, 1); PG8_STAGE(PG8_SB(0, 0), b2, voffB); PG8_STAGE(PG8_SB(0, 1), b2 + hB, voffB); PG8_STAGE(PG8_SA(0, 0), a2, voffA);
            PG8_WAIT_V(8); PG8_WAIT_L(0); PG8_BAR; PG8_MMA(1, 0, At, B0); PG8_MMA(1, 1, At, B1); PG8_BAR; PG8_SCHED;
            PG8_LDB(B0, 1, 0); PG8_LDB(B1, 1, 1); PG8_SCHED; PG8_LDA(At, 1, 0); PG8_STAGE(PG8_SA(0, 1), a2 + hA, voffA);
            PG8_WAIT_V(8); PG8_WAIT_L(0); PG8_BAR; PG8_MMA(0, 0, At, B0); PG8_MMA(0, 1, At, B1); PG8_BAR; PG8_SCHED;
            PG8_LDA(At, 1, 1); PG8_STAGE(PG8_SB(1, 0), b3, voffB); PG8_STAGE(PG8_SB(1, 1), b3 + hB, voffB); PG8_STAGE(PG8_SA(1, 0), a3, voffA);
            PG8_WAIT_V(8); PG8_WAIT_L(0); PG8_BAR; PG8_MMA(1, 0, At, B0); PG8_MMA(1, 1, At, B1); PG8_BAR; PG8_SCHED;
        }
        if constexpr (ALIGN_EPI) { if (wr == 0) PG8_BAR; }
        { int el = (int)__builtin_amdgcn_mbcnt_hi(~0u, __builtin_amdgcn_mbcnt_lo(~0u, 0u)); asm volatile("" : "+v"(el));
          E(acc, cur, wr, wc, el & 15, el >> 4); }
        if (!has_next) break;
#pragma unroll
        for (int a = 0; a < 2; ++a)
#pragma unroll
            for (int b = 0; b < 2; ++b)
#pragma unroll
                for (int m = 0; m < 4; ++m)
#pragma unroll
                    for (int n = 0; n < 2; ++n) acc[a][b][m][n] = (f32x4){0.f, 0.f, 0.f, 0.f};
        cur = nxt; cA = nA; cB = nB; ++ui;
        if constexpr (ALIGN_EPI) { if (wr == 1) PG8_BAR; }
    }
    PG8_WAIT_V(0);
    if constexpr (!ALIGN_EPI) { if (wr == 0) PG8_BAR; }
    PG8_BAR;
#undef PG8_SA
#undef PG8_SB
#undef PG8_STAGE
#undef PG8_LDA
#undef PG8_LDB
#undef PG8_MMA
#undef PG8_WAIT_V
#undef PG8_WAIT_L
#undef PG8_BAR
#undef PG8_SCHED
#undef PG8_PA
#undef PG8_PB
}
}

namespace attn {
using bf16 = __hip_bfloat16;
constexpr int D = 128, NW = 8, QBLK = 32, KVBLK = 64;
constexpr float SCALE = 0.088388347648318440f;
constexpr float THR = 8.f;
constexpr int LDQ = 1024, LDK = 256, LDO = 1024;
constexpr size_t SHM_V = KVBLK * D * 2, SHM_K = KVBLK * D * 2, SHM_ATTN = 2 * SHM_V + 2 * SHM_K + NW * 64 * 4;
using bf16x8 = __attribute__((ext_vector_type(8))) short;
using s16x4  = __attribute__((ext_vector_type(4))) short;
using f32x16 = __attribute__((ext_vector_type(16))) float;
using u32x4  = __attribute__((ext_vector_type(4))) unsigned;
#define KSWZ(row, colB) ((row) * 256 + ((colB) ^ (((row) & 7) << 4)))
#define SBAR() __builtin_amdgcn_sched_barrier(0)
__device__ __forceinline__ int crow(int r, int hi) { return (r & 3) + 8 * (r >> 2) + 4 * hi; }
__device__ __forceinline__ unsigned cvtpk(float lo, float hi) { unsigned r; asm volatile("v_cvt_pk_bf16_f32 %0, %1, %2" : "=v"(r) : "v"(lo), "v"(hi)); return r; }
__device__ __forceinline__ void partialSM(f32x16& p0, f32x16& p1, float& m_reg, float& mn, float& alpha) {
  constexpr float C = SCALE * 1.4426950408889634f;
  float pmax = p0[0]; for (int r = 1; r < 16; ++r) pmax = fmaxf(pmax, p0[r]); for (int r = 0; r < 16; ++r) pmax = fmaxf(pmax, p1[r]);
  { auto rr = __builtin_amdgcn_permlane32_swap(__float_as_uint(pmax), __float_as_uint(pmax), false, false);
    pmax = fmaxf(__uint_as_float(rr[0]), __uint_as_float(rr[1])); }
  if (__builtin_expect(__all(pmax - m_reg <= THR / SCALE), 1)) { mn = m_reg; alpha = 1.f; }
  else { mn = fmaxf(m_reg, pmax); alpha = __builtin_amdgcn_exp2f((m_reg - mn) * C); m_reg = mn; }
  float mnC = -mn * C;
  for (int r = 0; r < 16; ++r) p0[r] = fmaf(p0[r], C, mnC); for (int r = 0; r < 16; ++r) p1[r] = fmaf(p1[r], C, mnC);
  for (int r = 0; r < 16; ++r) p0[r] = __builtin_amdgcn_exp2f(p0[r]);
}
__device__ __forceinline__ void finishSM(f32x16& p0, f32x16& p1, float alpha, float& l_reg, bf16x8& pa0, bf16x8& pa1, bf16x8& pa2, bf16x8& pa3) {
  for (int r = 0; r < 16; ++r) p1[r] = __builtin_amdgcn_exp2f(p1[r]);
  float ps = 0; for (int r = 0; r < 16; ++r) ps += p0[r]; for (int r = 0; r < 16; ++r) ps += p1[r];
  { auto rr = __builtin_amdgcn_permlane32_swap(__float_as_uint(ps), __float_as_uint(ps), false, false);
    ps = __uint_as_float(rr[0]) + __uint_as_float(rr[1]); }
  l_reg = l_reg * alpha + ps;
#define PK4(P, BASE, OUT) do { unsigned a0 = cvtpk(P[BASE + 0], P[BASE + 1]), a1 = cvtpk(P[BASE + 2], P[BASE + 3]);   \
    unsigned b0 = cvtpk(P[BASE + 4], P[BASE + 5]), b1 = cvtpk(P[BASE + 6], P[BASE + 7]);                              \
    auto r0 = __builtin_amdgcn_permlane32_swap(a0, b0, false, false); auto r1 = __builtin_amdgcn_permlane32_swap(a1, b1, false, false); \
    u32x4 w = {r0[0], r1[0], r0[1], r1[1]}; OUT = *reinterpret_cast<bf16x8*>(&w); } while (0)
  PK4(p0, 0, pa0); PK4(p0, 8, pa1); PK4(p1, 0, pa2); PK4(p1, 8, pa3);
#undef PK4
}
__device__ __forceinline__ void qkt(f32x16& p0, f32x16& p1, const bf16* Ks, const bf16x8* qr, int r32, int hi) {
  p0 = f32x16{}; p1 = f32x16{};
  for (int d0 = 0; d0 < 8; ++d0) { int cb = (d0 * 16 + hi * 8) * 2;
    bf16x8 b0 = *reinterpret_cast<const bf16x8*>((const char*)Ks + KSWZ(r32, cb));
    bf16x8 b1 = *reinterpret_cast<const bf16x8*>((const char*)Ks + KSWZ(32 + r32, cb));
    p0 = __builtin_amdgcn_mfma_f32_32x32x16_bf16(b0, qr[d0], p0, 0, 0, 0);
    p1 = __builtin_amdgcn_mfma_f32_32x32x16_bf16(b1, qr[d0], p1, 0, 0, 0); }
}
__device__ __forceinline__ int v_st(int k, int c) { const int kk = (k & ~0xC) | ((k & 4) << 1) | ((k & 8) >> 1); return ((kk >> 3) * 4 + (c >> 5)) * 512 + ((kk & 7) * 32 + (c & 31)) * 2; }
__device__ __forceinline__ int v_rd_base(int lane) { return ((lane & 3) << 3) | (((lane >> 2) & 3) << 6) | (((lane >> 4) & 1) << 5) | (((lane >> 5) & 1) << 8); }
constexpr int v_rd_off(int d0, int ks, int half) { return d0 * 512 + ks * 4096 + half * 2048; }
template <int OFF> __device__ __forceinline__ s16x4 tr_read(int vb) {
  s16x4 r; asm volatile("ds_read_b64_tr_b16 %0, %1 offset:%2" : "=&v"(r) : "v"(vb), "i"(OFF) : "memory"); return r;
}
template <int D0> __device__ __forceinline__ void pv_one(f32x16& od, int vb, bf16x8 pa0, bf16x8 pa1, bf16x8 pa2, bf16x8 pa3) {
  const s16x4 l0 = tr_read<v_rd_off(D0, 0, 0)>(vb), h0 = tr_read<v_rd_off(D0, 0, 1)>(vb), l1 = tr_read<v_rd_off(D0, 1, 0)>(vb), h1 = tr_read<v_rd_off(D0, 1, 1)>(vb);
  const s16x4 l2 = tr_read<v_rd_off(D0, 2, 0)>(vb), h2 = tr_read<v_rd_off(D0, 2, 1)>(vb), l3 = tr_read<v_rd_off(D0, 3, 0)>(vb), h3 = tr_read<v_rd_off(D0, 3, 1)>(vb);
  asm volatile("s_waitcnt lgkmcnt(0)" ::: "memory"); SBAR();
#define PK(L, H) (bf16x8){L[0], L[1], L[2], L[3], H[0], H[1], H[2], H[3]}
  od = __builtin_amdgcn_mfma_f32_32x32x16_bf16(pa0, PK(l0, h0), od, 0, 0, 0);
  od = __builtin_amdgcn_mfma_f32_32x32x16_bf16(pa1, PK(l1, h1), od, 0, 0, 0);
  od = __builtin_amdgcn_mfma_f32_32x32x16_bf16(pa2, PK(l2, h2), od, 0, 0, 0);
  od = __builtin_amdgcn_mfma_f32_32x32x16_bf16(pa3, PK(l3, h3), od, 0, 0, 0);
#undef PK
}
__device__ __forceinline__ void pv_d0(f32x16* o, int vb, bf16x8 pa0, bf16x8 pa1, bf16x8 pa2, bf16x8 pa3) {
  pv_one<0>(o[0], vb, pa0, pa1, pa2, pa3); pv_one<1>(o[1], vb, pa0, pa1, pa2, pa3); pv_one<2>(o[2], vb, pa0, pa1, pa2, pa3); pv_one<3>(o[3], vb, pa0, pa1, pa2, pa3);
}
__device__ __forceinline__ void attn_dense_body(const bf16* __restrict__ Qb, const bf16* __restrict__ Kh, const bf16* __restrict__ Vh,
                                                bf16* __restrict__ Ob, int seq, char* lds, const int tid) {
  const int wid = tid >> 6, lane = tid & 63, r32 = lane & 31, hi = lane >> 5;
  bf16* V_lds = (bf16*)lds; bf16* K_lds = (bf16*)(lds + 2 * SHM_V);
  float* ws = (float*)(lds + 2 * SHM_V + 2 * SHM_K) + wid * 64; float* li_l = ws; float* al_l = ws + 32;
  float m_reg = -1e30f, l_reg = 0; f32x16 o[4] = {}; bf16x8 qr[8];
  const bf16* Qw = Qb + (long)(wid * QBLK + r32) * LDQ + hi * 8;
#pragma unroll
  for (int d0 = 0; d0 < 8; ++d0) qr[d0] = *reinterpret_cast<const bf16x8*>(Qw + d0 * 16);
  const int sr = tid >> 4, sc = (tid & 15) * 8, vst0 = v_st(sr, sc), vst1 = v_st(32 + sr, sc);
  const int vb0 = (int)(uintptr_t)V_lds + v_rd_base(lane);
  struct { bf16x8 vs0, vs1, ks0, ks1; } sr_[1];
#define SLOAD(i, k0) do { sr_[i].vs0 = *reinterpret_cast<const bf16x8*>(&Vh[(long)((k0) + sr) * LDK + sc]); sr_[i].vs1 = *reinterpret_cast<const bf16x8*>(&Vh[(long)((k0) + 32 + sr) * LDK + sc]); \
    sr_[i].ks0 = *reinterpret_cast<const bf16x8*>(&Kh[(long)((k0) + sr) * LDK + sc]); sr_[i].ks1 = *reinterpret_cast<const bf16x8*>(&Kh[(long)((k0) + 32 + sr) * LDK + sc]); } while (0)
#define SWRITE(b, i) do { *(bf16x8*)((char*)V_lds + (b) * SHM_V + vst0) = sr_[i].vs0;          \
    *(bf16x8*)((char*)V_lds + (b) * SHM_V + vst1) = sr_[i].vs1; int kc = sc * 2;               \
    *(bf16x8*)((char*)K_lds + (b) * SHM_K + KSWZ(sr, kc)) = sr_[i].ks0;                       \
    *(bf16x8*)((char*)K_lds + (b) * SHM_K + KSWZ(32 + sr, kc)) = sr_[i].ks1; } while (0)
#define SWAIT() asm volatile("s_waitcnt vmcnt(0)" ::: "memory")
#define RESC(a) do { if (__any((a) < 1.f)) { if (hi == 0) al_l[r32] = (a); asm volatile("s_waitcnt lgkmcnt(0)" ::: "memory"); \
    for (int d = 0; d < 4; ++d) for (int r = 0; r < 16; ++r) o[d][r] *= al_l[crow(r, hi)]; } } while (0)
  f32x16 pA0, pA1, pB0, pB1; float mnA, mnB, alA, alB; bf16x8 pa0, pa1, pa2, pa3; const int NT = seq / KVBLK;
  constexpr int SE = 0, SO = 0;
  SLOAD(SE, 0); asm volatile("s_waitcnt vmcnt(0)" ::: "memory"); SWRITE(0, SE); __syncthreads();
  qkt(pA0, pA1, K_lds, qr, r32, hi); partialSM(pA0, pA1, m_reg, mnA, alA);
  SLOAD(SO, KVBLK);
  SWAIT(); SWRITE(1, SO); __syncthreads();
  for (int j = 1; j + 1 < NT; j += 2) {
    SBAR(); qkt(pB0, pB1, (bf16*)((char*)K_lds + SHM_K), qr, r32, hi);
    finishSM(pA0, pA1, alA, l_reg, pa0, pa1, pa2, pa3); SBAR();
    SLOAD(SO, (j + 1) * KVBLK); SBAR();
    pv_d0(o, vb0, pa0, pa1, pa2, pa3); partialSM(pB0, pB1, m_reg, mnB, alB);
    __syncthreads(); SWAIT(); SWRITE(0, SE);
    RESC(alB); __syncthreads();
    SBAR(); qkt(pA0, pA1, K_lds, qr, r32, hi);
    finishSM(pB0, pB1, alB, l_reg, pa0, pa1, pa2, pa3); SBAR();
    SLOAD(SE, (j + 2) * KVBLK); SBAR();
    pv_d0(o, vb0 + (int)SHM_V, pa0, pa1, pa2, pa3); partialSM(pA0, pA1, m_reg, mnA, alA);
    __syncthreads(); SWAIT(); SWRITE(1, SO);
    RESC(alA); __syncthreads();
  }
  SBAR(); qkt(pB0, pB1, (bf16*)((char*)K_lds + SHM_K), qr, r32, hi);
  finishSM(pA0, pA1, alA, l_reg, pa0, pa1, pa2, pa3); SBAR();
  pv_d0(o, vb0, pa0, pa1, pa2, pa3); partialSM(pB0, pB1, m_reg, mnB, alB);
  __syncthreads(); RESC(alB);
  finishSM(pB0, pB1, alB, l_reg, pa0, pa1, pa2, pa3); SBAR();
  pv_d0(o, vb0 + (int)SHM_V, pa0, pa1, pa2, pa3);
  if (hi == 0) li_l[r32] = l_reg; asm volatile("s_waitcnt lgkmcnt(0)" ::: "memory");
  float rli[16];
#pragma unroll
  for (int r = 0; r < 16; ++r) rli[r] = __builtin_amdgcn_rcpf(li_l[crow(r, hi)]);
  unsigned short* Ow = (unsigned short*)Ob + (long)(wid * QBLK) * LDO;
#pragma unroll
  for (int r = 0; r < 16; ++r) { int orow = crow(r, hi);
    for (int d0 = 0; d0 < 4; ++d0) { const unsigned pk = cvtpk(o[d0][r] * rli[r], 0.f); Ow[(long)orow * LDO + d0 * 32 + r32] = (unsigned short)(pk & 0xffffu); } }
  __syncthreads();
#undef SLOAD
#undef SWRITE
#undef SWAIT
#undef RESC
}
#undef KSWZ
#undef SBAR
}

constexpr int NWAVES = 8;
constexpr int DM = 1024, NB = 8, SEQ = 2048, CTXL = 256, NLAT = NB * SEQ, NCTX = NB * CTXL, NTOK = NLAT + NCTX;
constexpr int DEPTH = 4, MODW = 6 * DM;
constexpr float EPS = 1e-6f;
constexpr int SGUW = 2048, NEXP = 16384, KVROWS = SEQ + CTXL;

constexpr size_t MiB = 1u << 20;
constexpr size_t WS_CTL = 0, CTL_ZERO_BYTES = 1 * MiB;
constexpr size_t WS_MOD = 1 * MiB;
constexpr size_t WS_SS = 2 * MiB;
constexpr size_t WS_X = 4 * MiB;
constexpr size_t WS_H = 76 * MiB;
constexpr size_t WS_Z = 112 * MiB;
constexpr size_t WS_G = 256 * MiB;
constexpr size_t WS_SG = 328 * MiB;
constexpr size_t WS_WSGUIN = 346 * MiB;
constexpr size_t WS_WSGUOUT = 362 * MiB;
constexpr size_t WS_WPOOLIN = 370 * MiB, WS_WPOOLOUT = 372 * MiB, WS_WGRP = 374 * MiB, WS_WQKV = 375 * MiB, WS_WO = 378 * MiB;
constexpr size_t WS_WPQ = 380 * MiB;
constexpr size_t WS_KB = 396 * MiB;
constexpr size_t WS_TU = 400 * MiB;
constexpr size_t WS_TV = 464 * MiB;
constexpr size_t WS_SU = 528 * MiB, WS_SV = 529 * MiB;
constexpr size_t WS_IDX = 530 * MiB;
constexpr size_t WS_SHQ = 539 * MiB;
constexpr size_t WS_H8 = 540 * MiB;
constexpr size_t WS_END = 558 * MiB;
constexpr int CW_BAR = 4096;

constexpr int RING_BYTES = 131072;
constexpr int LDSCTL_OFF = RING_BYTES, MISC_OFF = LDSCTL_OFF + 320, WSLOT_OFF = LDSCTL_OFF + 1024;
constexpr int LDS_BYTES = 147456;

#define GAS __attribute__((address_space(1)))
#define LAS __attribute__((address_space(3)))
typedef unsigned short bf16;
typedef unsigned v4u __attribute__((ext_vector_type(4)));
typedef unsigned v2u __attribute__((ext_vector_type(2)));
typedef float f32x4 __attribute__((ext_vector_type(4)));
typedef short bf16x8 __attribute__((ext_vector_type(8)));
typedef __bf16 bf2 __attribute__((ext_vector_type(2)));
#define LDS_WAIT() asm volatile("s_waitcnt lgkmcnt(0)" ::: "memory")
__device__ __forceinline__ unsigned f2bf(float f) { unsigned u = __builtin_bit_cast(unsigned, f); return (u + 0x7fffu + ((u >> 16) & 1u)) >> 16; }
__device__ __forceinline__ unsigned pk2(float lo, float hi) { return pg8::cvt_pk_bf16(lo, hi); }
__device__ __forceinline__ float dot2bf(unsigned a, unsigned b, float c) { asm("v_dot2c_f32_bf16 %0, %1, %2" : "+v"(c) : "v"(a), "v"(b)); return c; }
typedef _Float16 h2_t __attribute__((ext_vector_type(2)));
__device__ __forceinline__ unsigned h2u(h2_t v) { return __builtin_bit_cast(unsigned, v); }
__device__ __forceinline__ h2_t u2h(unsigned v) { return __builtin_bit_cast(h2_t, v); }
__device__ __forceinline__ float bflo(unsigned u) { return __uint_as_float(u << 16); }
__device__ __forceinline__ float bfhi(unsigned u) { return __uint_as_float(u & 0xffff0000u); }

#define XB_TMO      128
#define XB_XCNT(j)  (256  + 64 * (j))
#define XB_XSUB(j)  (1280 + 64 * (j))
#define XB_XGEN(j)  (2304 + 64 * (j))
#define XB_TOP      3328
#define XB_TOPGEN   3392
#define XCD_BAR_WORDS 3456
#define XB_SPIN_CAP (1u << 22)
__device__ __forceinline__ unsigned xb_ld(unsigned* p)              { return __hip_atomic_load(p, __ATOMIC_RELAXED, __HIP_MEMORY_SCOPE_AGENT); }
__device__ __forceinline__ unsigned xb_add(unsigned* p, unsigned v) { return __hip_atomic_fetch_add(p, v, __ATOMIC_RELAXED, __HIP_MEMORY_SCOPE_AGENT); }
__device__ __forceinline__ unsigned xb_xcc_id() { return (unsigned)__builtin_amdgcn_s_getreg((3 << 11) | 20) & 0xFu; }
#define XB_SPIN(cond, bar) do { unsigned _sp = 0; while (cond) { __builtin_amdgcn_s_sleep(1); \
    if ((++_sp & 255u) == 0u) { if (xb_ld(&(bar)[XB_TMO])) break; if (_sp > XB_SPIN_CAP) { atomicAdd(&(bar)[XB_TMO], 1u); break; } } } } while (0)
struct XcdBarrier { unsigned* bar; unsigned x; volatile LAS unsigned* st; };
__device__ __forceinline__ XcdBarrier xcd_barrier_post(unsigned* bar, volatile LAS unsigned* st) {
    XcdBarrier b; b.bar = bar; b.x = xb_xcc_id(); b.st = st;
    if (threadIdx.x == 0) (void)xb_add(&bar[XB_XCNT(b.x)], 1u);
    return b;
}
__device__ __forceinline__ void xcd_barrier_complete(unsigned* bar, unsigned x, unsigned& nloc, unsigned& nx) {
    const unsigned G = gridDim.x * gridDim.y * gridDim.z;
    unsigned sum, cnt, mine, sp = 0u;
    for (;;) {
        sum = 0u; cnt = 0u; mine = 0u;
#pragma unroll
        for (unsigned j = 0; j < 16; ++j) { const unsigned c = xb_ld(&bar[XB_XCNT(j)]); sum += c; cnt += (c > 0u) ? 1u : 0u; mine = (j == x) ? c : mine; }
        if (sum == G) break;
        __builtin_amdgcn_s_sleep(1);
        if ((++sp & 255u) == 0u) { if (xb_ld(&bar[XB_TMO])) break; if (sp > XB_SPIN_CAP) { atomicAdd(&bar[XB_TMO], 1u); break; } }
    }
    nloc = mine > 0u ? mine : 1u; nx = cnt > 0u ? cnt : 1u;
}
__device__ __forceinline__ void xcd_barrier(const XcdBarrier& b, const int tid) {
    asm volatile("s_waitcnt vmcnt(0)" ::: "memory");
    __syncthreads();
    if (tid == 0) {
        unsigned* bar = b.bar;
        __builtin_amdgcn_s_waitcnt(0);
        unsigned nloc = b.st[0], nx = b.st[1];
        if (nloc == 0u) { xcd_barrier_complete(bar, b.x, nloc, nx); b.st[0] = nloc; b.st[1] = nx; }
        const unsigned old = xb_add(&bar[XB_XSUB(b.x)], 1u);
        const unsigned gen = old / nloc;
        if (old + 1u == (gen + 1u) * nloc) {
            __builtin_amdgcn_fence(__ATOMIC_RELEASE, "agent");
            asm volatile("s_waitcnt vmcnt(0)" ::: "memory");
            const unsigned og = xb_add(&bar[XB_TOP], 1u);
            const unsigned tg = og / nx;
            if (og + 1u == (tg + 1u) * nx) xb_add(&bar[XB_TOPGEN], 1u);
            else XB_SPIN(xb_ld(&bar[XB_TOPGEN]) == tg, bar);
            __builtin_amdgcn_fence(__ATOMIC_ACQUIRE, "agent");
            xb_add(&bar[XB_XGEN(b.x)], 1u);
            asm volatile("s_waitcnt vmcnt(0)" ::: "memory");
        } else {
            XB_SPIN(xb_ld(&bar[XB_XGEN(b.x)]) == gen, bar);
            __builtin_amdgcn_fence(__ATOMIC_ACQUIRE, "agent");
            asm volatile("s_waitcnt vmcnt(0)" ::: "memory");
        }
    }
    __syncthreads();
}

enum { I_X = 0, I_C, I_CTX, I_CCTX, I_ADAW, I_ADAB, I_N1G, I_N2G, I_SGU_WIN, I_SGU_VG, I_SGU_WS, I_SGU_BS, I_SGU_WOUT, I_POOL_WIN, I_POOL_WGRP, I_POOL_SCALE, I_POOL_WOUT,
       I_ATT_WQKV, I_ATT_QG, I_ATT_KG, I_ATT_WO, I_PEER_WQ, I_PEER_K1, I_PEER_K2, I_PEER_U, I_PEER_V, I_FINAL_G, N_IN };
struct Args { const float* in[N_IN]; float* out; unsigned char* ws; int lo, hi; };
typedef const __attribute__((address_space(4))) Args* KArgs;
#define ws_ (A->ws)

struct Frame {
    LAS unsigned char* lds;
    int tid, lane, wave, vcu, G, bx;
};

__device__ __forceinline__ float wave_sum(float v) {
    v += shx<1>(v); v += shx<2>(v); v += shx<4>(v); v += shx<8>(v); v += shx<16>(v);
    { auto r = __builtin_amdgcn_permlane32_swap(__float_as_uint(v), __float_as_uint(v), false, false); v = __uint_as_float(r[0]) + __uint_as_float(r[1]); }
    return v;
}

__device__ __forceinline__ void p0_transpose_item(const float* W, int K, int N, bf16* WT, LAS float* scr, int item, int lane) {
    const int nblk = N / 32, kb = item / nblk, nb = item % nblk, k0 = 64 * kb, n0 = 32 * nb;
#pragma unroll 8
    for (int i = 0; i < 32; ++i) { const int kk = 2 * i + (lane >> 5); scr[kk * 33 + (lane & 31)] = W[(size_t)(k0 + kk) * N + n0 + (lane & 31)]; }
    LDS_WAIT(); asm volatile("" ::: "memory");
    const int c = lane & 7;
#pragma unroll
    for (int j = 0; j < 4; ++j) { const int n = (lane >> 3) + 8 * j; const LAS float* s = scr + (8 * c) * 33 + n;
        v4u o; o.x = pk2(s[0 * 33], s[1 * 33]); o.y = pk2(s[2 * 33], s[3 * 33]); o.z = pk2(s[4 * 33], s[5 * 33]); o.w = pk2(s[6 * 33], s[7 * 33]);
        *(v4u*)(WT + (size_t)(n0 + n) * K + k0 + 8 * c) = o; }
    LDS_WAIT(); asm volatile("" ::: "memory");
}
__device__ __forceinline__ float silu(float v) { return v / (1.f + __expf(-v)); }

__device__ __forceinline__ void op_prep(Frame& F, KArgs A) {
    unsigned char* ws = ws_;
    for (int rep_ = 0; rep_ < 1 + ((PREPREP >> 0) & 1); ++rep_) {
        LAS float* S = (LAS float*)F.lds;
        LAS float* Pp = (LAS float*)(F.lds + 40960);
        for (int e = F.tid; e < 9 * 1024; e += NWAVES * 64) { const int r = e >> 10, k = e & 1023; S[e] = silu(r < 8 ? A->in[I_C][r * 1024 + k] : A->in[I_CCTX][k]); }
        __syncthreads();
        for (int task = F.vcu; task < DEPTH * 48; task += F.G) {
            const int i = task / 48, cg = task % 48, col = cg * 128 + 2 * F.lane;
            const float* W = A->in[I_ADAW] + (size_t)i * 1024 * MODW + col;
            float acc[9][2];
#pragma unroll
            for (int r = 0; r < 9; ++r) { acc[r][0] = 0.f; acc[r][1] = 0.f; }
            const int k0 = F.wave * 128;
#pragma unroll 8
            for (int k = k0; k < k0 + 128; ++k) { const pg8::f32x2 w = __builtin_nontemporal_load((const pg8::f32x2*)(W + (size_t)k * MODW));
#pragma unroll
                for (int r = 0; r < 9; ++r) { const float sv = S[r * 1024 + k]; acc[r][0] += sv * w.x; acc[r][1] += sv * w.y; } }
#pragma unroll
            for (int r = 0; r < 9; ++r) *(LAS pg8::f32x2*)(Pp + (F.wave * 9 + r) * 128 + 2 * F.lane) = (pg8::f32x2){acc[r][0], acc[r][1]};
            __syncthreads();
            for (int e = F.tid; e < 9 * 128; e += NWAVES * 64) { const int r = e >> 7, l = e & 127; float sacc = 0.f;
#pragma unroll
                for (int w = 0; w < 8; ++w) sacc += Pp[(w * 9 + r) * 128 + l];
                const int c2 = cg * 128 + l;
                ((float*)(ws + WS_MOD))[((size_t)i * 9 + r) * MODW + c2] = sacc + A->in[I_ADAB][(size_t)i * MODW + c2]; }
            __syncthreads();
        }
    }
    __syncthreads();
    const int gw = F.vcu * NWAVES + F.wave, NGW = F.G * NWAVES;
    const long gt = (long)F.vcu * (NWAVES * 64) + F.tid, NGT = (long)F.G * NWAVES * 64;
    for (int rep_ = 0; rep_ < 1 + ((PREPREP >> 1) & 1); ++rep_) {
        LAS float* scr = (LAS float*)(F.lds + F.wave * 16384);
        constexpr int IT_SIN = (1024 / 64) * (4096 / 32), IT_SOUT = (2048 / 64) * (1024 / 32), IT_SQ = (1024 / 64) * (1024 / 32), IT_GRP = (256 / 64) * (256 / 32),
                      IT_QKV = (1024 / 64) * (1536 / 32);
        constexpr int NITEMS = 2 * IT_SIN + 2 * IT_SOUT + IT_SQ + 4 * IT_GRP + IT_QKV + IT_SQ;
        for (int it = gw; it < NITEMS; it += NGW) {
            int r = it;
            if (r < 2 * IT_SIN) { const int j = r / IT_SIN; p0_transpose_item(A->in[I_SGU_WIN] + (size_t)j * 1024 * 4096, 1024, 4096, (bf16*)(ws + WS_WSGUIN) + (size_t)j * 4096 * 1024, scr, r % IT_SIN, F.lane); continue; } r -= 2 * IT_SIN;
            if (r < 2 * IT_SOUT) { const int j = r / IT_SOUT; p0_transpose_item(A->in[I_SGU_WOUT] + (size_t)j * 2048 * 1024, 2048, 1024, (bf16*)(ws + WS_WSGUOUT) + (size_t)j * 1024 * 2048, scr, r % IT_SOUT, F.lane); continue; } r -= 2 * IT_SOUT;
            if (r < IT_SQ) { p0_transpose_item(A->in[I_POOL_WOUT], 1024, 1024, (bf16*)(ws + WS_WPOOLOUT), scr, r, F.lane); continue; } r -= IT_SQ;
            if (r < 4 * IT_GRP) { const int j = r / IT_GRP; p0_transpose_item(A->in[I_POOL_WGRP] + (size_t)j * 65536, 256, 256, (bf16*)(ws + WS_WGRP) + (size_t)j * 65536, scr, r % IT_GRP, F.lane); continue; } r -= 4 * IT_GRP;
            if (r < IT_QKV) { p0_transpose_item(A->in[I_ATT_WQKV], 1024, 1536, (bf16*)(ws + WS_WQKV), scr, r, F.lane); continue; } r -= IT_QKV;
            { p0_transpose_item(A->in[I_ATT_WO], 1024, 1024, (bf16*)(ws + WS_WO), scr, r, F.lane); }
        }
        for (long ch = gt; ch < (long)1024 * 1024 / 8; ch += NGT) {
            const int d8 = (int)(ch & 31), gq = (int)(ch >> 5) & 3, kk = (int)(ch >> 7);
            const float* src = A->in[I_POOL_WIN] + (size_t)kk * 1024 + gq * 256 + d8 * 8;
            const f32x4 a = *(const f32x4*)src, b = *(const f32x4*)(src + 4);
            v4u o; o.x = pk2(a[0], a[1]); o.y = pk2(a[2], a[3]); o.z = pk2(b[0], b[1]); o.w = pk2(b[2], b[3]);
            *(v4u*)((bf16*)(ws + WS_G + 16 * MiB) + (((size_t)gq * 1024 + kk) * 256 + d8 * 8)) = o;
        }
        for (long ch = gt; ch < (long)DEPTH * 1024 * 2048 / 8; ch += NGT) {
            const int d8 = (int)(ch & 31), h = (int)(ch >> 5) & 7, kk = (int)(ch >> 8) & 1023, i = (int)(ch >> 18);
            const float* src = A->in[I_PEER_WQ] + ((size_t)i * 1024 + kk) * 2048 + h * 256 + d8 * 8;
            const f32x4 a = *(const f32x4*)src, b = *(const f32x4*)(src + 4);
            v4u o; o.x = pk2(a[0], a[1]); o.y = pk2(a[2], a[3]); o.z = pk2(b[0], b[1]); o.w = pk2(b[2], b[3]);
            *(v4u*)((bf16*)(ws + WS_G) + (((size_t)(i * 8 + h) * 1024 + kk) * 256 + d8 * 8)) = o;
        }
    }
    for (long ch = gt; ch < (long)DEPTH * 8 * 256 * 32; ch += NGT) {
        const int d0 = (int)(ch & 31) * 8, n = (int)(ch >> 5) & 255, ih = (int)(ch >> 13);
        v4u o = {0u, 0u, 0u, 0u};
        const float* src = nullptr;
        if (n < 128 && d0 < 128) src = A->in[I_PEER_K1] + ((size_t)ih * 128 + n) * 128 + d0;
        else if (n >= 128 && d0 >= 128) src = A->in[I_PEER_K2] + ((size_t)ih * 128 + (n - 128)) * 128 + (d0 - 128);
        if (src) { const f32x4 a = *(const f32x4*)src, b = *(const f32x4*)(src + 4); o.x = pk2(a[0], a[1]); o.y = pk2(a[2], a[3]); o.z = pk2(b[0], b[1]); o.w = pk2(b[2], b[3]); }
        *(v4u*)((bf16*)(ws + WS_KB) + ch * 8) = o;
    }
    for (int rep_ = 0; rep_ < 1 + ((PREPREP >> 3) & 1); ++rep_)
    for (int row0 = gw * 4; row0 < 2 * DEPTH * NEXP; row0 += NGW * 4) {
        const bool isU = row0 < DEPTH * NEXP; const int r0 = isU ? row0 : row0 - DEPTH * NEXP;
        const float* sp = (isU ? A->in[I_PEER_U] : A->in[I_PEER_V]) + (size_t)r0 * DM;
        f32x4 v[4][4]; float am[4];
#pragma unroll
        for (int q = 0; q < 4; ++q)
#pragma unroll
            for (int j = 0; j < 4; ++j) v[q][j] = __builtin_nontemporal_load((const f32x4*)(sp + (size_t)q * DM) + F.lane + 64 * j);
#pragma unroll
        for (int q = 0; q < 4; ++q) { float m = 0.f;
#pragma unroll
            for (int j = 0; j < 4; ++j) m = fmaxf(m, fmaxf(fmaxf(fabsf(v[q][j].x), fabsf(v[q][j].y)), fmaxf(fabsf(v[q][j].z), fabsf(v[q][j].w))));
            am[q] = m; }
#pragma unroll
        for (int q = 0; q < 4; ++q) { float m = am[q]; m = fmaxf(m, shx<1>(m)); m = fmaxf(m, shx<2>(m)); m = fmaxf(m, shx<4>(m)); m = fmaxf(m, shx<8>(m)); m = fmaxf(m, shx<16>(m));
            auto r = __builtin_amdgcn_permlane32_swap(__float_as_uint(m), __float_as_uint(m), false, false); am[q] = fmaxf(__uint_as_float(r[0]), __uint_as_float(r[1])); }
        {
            const int lyr = r0 >> 14;
            unsigned char* tb4 = ws + (isU ? WS_TU : WS_TV) + (size_t)lyr * NEXP * 512;
            const unsigned bias = isU ? 0u : 0x0808u;
#pragma unroll
            for (int q = 0; q < 4; ++q) { const int e = (r0 + q) & (NEXP - 1);
                float ss = 0.f;
#pragma unroll
                for (int j = 0; j < 4; ++j) ss += (v[q][j].x * v[q][j].x + v[q][j].y * v[q][j].y) + (v[q][j].z * v[q][j].z + v[q][j].w * v[q][j].w);
                ss = wave_sum(ss);
                float sc = fmaxf(0.3352f * __builtin_sqrtf(ss * (1.f / DM)), am[q] * (1.f / 16.f)); if (!(sc > 0.f)) sc = 1.f;
                const float inv = 1.f / sc;
#pragma unroll
                for (int j = 0; j < 4; ++j) { unsigned w = 0u;
#pragma unroll
                    for (int i = 0; i < 4; ++i) { int n = (int)__builtin_floorf(v[q][j][i] * inv); n = n > 7 ? 7 : (n < -8 ? -8 : n); w |= ((unsigned)n & 15u) << (4 * i); }
                    *(unsigned short*)(tb4 + (size_t)j * (NEXP * 128) + (size_t)e * 128 + 2 * F.lane) = (unsigned short)(w ^ bias); }
                if (F.lane == 0) ((float*)(ws + (isU ? WS_SU : WS_SV)))[r0 + q] = sc; }
        }
    }
}

__device__ __forceinline__ float wave_max(float v) {
    v = fmaxf(v, shx<1>(v)); v = fmaxf(v, shx<2>(v)); v = fmaxf(v, shx<4>(v)); v = fmaxf(v, shx<8>(v)); v = fmaxf(v, shx<16>(v));
    { auto r = __builtin_amdgcn_permlane32_swap(__float_as_uint(v), __float_as_uint(v), false, false); v = fmaxf(__uint_as_float(r[0]), __uint_as_float(r[1])); }
    return v;
}
__device__ __forceinline__ void op_modulate(Frame& F, KArgs A, const float* srcLat, const float* srcCtx, const bf16* srcX, const float* gain, const float* modl, int ch_shift, int nrows, bool fin, bool hq = false) {
    const int gw = F.vcu * NWAVES + F.wave, NGW = F.G * NWAVES;
    bf16* H = (bf16*)(ws_ + WS_H);
    for (int row = gw; row < nrows; row += NGW) {
        const int mr = row < NLAT ? (row >> 11) : 8;
        const float* sh = modl + mr * MODW + ch_shift * DM; const float* sc = sh + DM;
        f32x4 v[4]; float s = 0.f;
        if (srcX) { const v2u* xr = (const v2u*)(srcX + (size_t)row * DM);
#pragma unroll
            for (int j = 0; j < 4; ++j) { const v2u q = xr[F.lane + 64 * j]; v[j] = (f32x4){bflo(q.x), bfhi(q.x), bflo(q.y), bfhi(q.y)}; }
        } else { const float* xr = row < NLAT ? srcLat + (size_t)row * DM : srcCtx + (size_t)(row - NLAT) * DM;
#pragma unroll
            for (int j = 0; j < 4; ++j) v[j] = *((const f32x4*)xr + F.lane + 64 * j); }
#pragma unroll
        for (int j = 0; j < 4; ++j) s += (v[j].x * v[j].x + v[j].y * v[j].y) + (v[j].z * v[j].z + v[j].w * v[j].w);
        const float rstd = __builtin_amdgcn_rsqf(wave_sum(s) * (1.f / DM) + EPS);
        if (fin) {
            f32x4* o16 = (f32x4*)(A->out + (size_t)row * DM) + F.lane;
#pragma unroll
            for (int j = 0; j < 4; ++j) { const f32x4 g = *((const f32x4*)gain + F.lane + 64 * j); o16[64 * j] = v[j] * rstd * g; }
            continue;
        }
        v2u* o8 = (v2u*)(H + (size_t)row * DM) + F.lane;
        float m = 0.f;
#pragma unroll
        for (int j = 0; j < 4; ++j) { const f32x4 g = *((const f32x4*)gain + F.lane + 64 * j), a = *((const f32x4*)sc + F.lane + 64 * j), b = *((const f32x4*)sh + F.lane + 64 * j);
            const f32x4 y = v[j] * rstd * g * (a + 1.f) + b; v2u w; w.x = pk2(y[0], y[1]); w.y = pk2(y[2], y[3]); o8[64 * j] = w;
            if (hq) { v[j] = y; m = fmaxf(m, fmaxf(fmaxf(fabsf(y[0]), fabsf(y[1])), fmaxf(fabsf(y[2]), fabsf(y[3])))); } }
        if (hq) {
            m = wave_max(m);
            const float inv = m > 0.f ? 119.f / m : 0.f;
            unsigned short* hp = (unsigned short*)(ws_ + WS_H8) + (size_t)row * 512 + F.lane;
#pragma unroll
            for (int j = 0; j < 4; ++j) { unsigned pa = 0u, pb = 0u;
#pragma unroll
                for (int i = 0; i < 4; ++i) { int q = (int)__builtin_rintf(v[j][i] * inv); q = q > 119 ? 119 : (q < -119 ? -119 : q);
                    const int b = ((q + 8) & 15) - 8, a = (q - b) >> 4; pa |= ((unsigned)a & 15u) << (4 * i); pb |= ((unsigned)b & 15u) << (4 * i); }
                hp[j * 128] = (unsigned short)pa; hp[j * 128 + 64] = (unsigned short)pb; }
            if (F.lane == 0) ((float*)(ws_ + WS_SHQ))[row] = m * (1.f / 119.f);
        }
    }
}

__device__ __forceinline__ void op_spatial(Frame& F, KArgs A, int j, int nrows) {
    const float* Ws = A->in[I_SGU_WS] + (size_t)j * 8 * 128 * 128; const float* vgain = A->in[I_SGU_VG] + (size_t)j * SGUW; const float* bs = A->in[I_SGU_BS] + (size_t)j * 8 * 128;
    const bf16* ZU = (const bf16*)(ws_ + WS_Z); const bf16* VT = ZU + (size_t)NTOK * SGUW; bf16* GT = (bf16*)(ws_ + WS_G); const float* SS = (const float*)(ws_ + WS_SS);
    LAS unsigned char* lA = F.lds;
    LAS unsigned char* lB = F.lds + 34816;
    LAS float* lR = (LAS float*)(F.lds + 34816 + 69632);
    const int nunits = (nrows / 128) * 8;
    const int wr = F.wave >> 2, wc = F.wave & 3, fr = F.lane & 15, fq = F.lane >> 4;
    int u = F.vcu;
    if (u >= nunits) return;
    const int g = u & 7;
    if ((F.G & 7) != 0) {
    }
    const unsigned tid = (unsigned)F.tid;
    f32x4 wsr[4][2];
#pragma unroll
    for (int it = 0; it < 4; ++it) { const unsigned e = it * 512u + tid, p = e >> 4, q0 = (e & 15u) * 8u; const float* sp = Ws + ((size_t)g * 128 + p) * 128 + q0; wsr[it][0] = *(const f32x4*)sp; wsr[it][1] = *(const f32x4*)(sp + 4); }
    const unsigned erow = tid >> 5, d0 = (tid & 31u) * 8u;
    const f32x4 vg0 = *(const f32x4*)(vgain + g * 256 + d0), vg1 = *(const f32x4*)(vgain + g * 256 + d0 + 4);
    float bsr[8];
#pragma unroll
    for (int ps = 0; ps < 8; ++ps) bsr[ps] = bs[g * 128 + ps * 16 + erow];
    v4u breg[8];
#define SP_PREFETCH(uu) do { const int _c = (uu) >> 3, _g = (uu) & 7; \
        _Pragma("unroll") for (int it = 0; it < 8; ++it) { const unsigned e = it * 512u + tl, d = e >> 4, q0 = (e & 15u) * 8u; breg[it] = *(const v4u*)(VT + (size_t)(_g * 256 + d) * NTOK + _c * 128 + q0); } } while (0)
    unsigned tl = tid; asm volatile("" : "+v"(tl));
    SP_PREFETCH(u);
    for (; u < nunits; u += F.G) {
        const int c = u >> 3;
        tl = tid; asm volatile("" : "+v"(tl));
        if (tid < 128u) { float sq = 0.f;
#pragma unroll
            for (int sl = 0; sl < 16; ++sl) sq += SS[(size_t)sl * NTOK + c * 128 + tid];
            lR[tid] = __builtin_amdgcn_rsqf(sq * (1.f / SGUW) + EPS); }
        __syncthreads();
#pragma unroll
        for (int it = 0; it < 4; ++it) { const unsigned e = it * 512u + tid, p = e >> 4, q0 = (e & 15u) * 8u; const f32x4 a = wsr[it][0], bq = wsr[it][1];
            v4u o; o.x = pk2(a[0] * lR[q0], a[1] * lR[q0 + 1]); o.y = pk2(a[2] * lR[q0 + 2], a[3] * lR[q0 + 3]); o.z = pk2(bq[0] * lR[q0 + 4], bq[1] * lR[q0 + 5]); o.w = pk2(bq[2] * lR[q0 + 6], bq[3] * lR[q0 + 7]);
            *(LAS v4u*)(lA + p * 272 + q0 * 2) = o; }
#pragma unroll
        for (int it = 0; it < 8; ++it) { const unsigned e = it * 512u + tid, d = e >> 4, q0 = (e & 15u) * 8u; *(LAS v4u*)(lB + d * 272 + q0 * 2) = breg[it]; }
        __syncthreads();
        { const int un = (u + F.G < nunits) ? u + F.G : u; SP_PREFETCH(un); }
        v4u zu[8];
        const size_t rowbase = (size_t)(c * 128) * SGUW + g * 256 + d0;
#pragma unroll
        for (int ps = 0; ps < 8; ++ps) zu[ps] = *(const v4u*)(ZU + rowbase + (size_t)(ps * 16 + erow) * SGUW);
        f32x4 acc[4][4];
#pragma unroll
        for (int m = 0; m < 4; ++m)
#pragma unroll
            for (int n = 0; n < 4; ++n) acc[m][n] = (f32x4){0.f, 0.f, 0.f, 0.f};
#pragma unroll
        for (int k = 0; k < 4; ++k) {
            bf16x8 af[4], bfr[4];
#pragma unroll
            for (int m = 0; m < 4; ++m) af[m] = *(const LAS bf16x8*)(lA + (wr * 64 + m * 16 + fr) * 272 + (k * 32 + fq * 8) * 2);
#pragma unroll
            for (int n = 0; n < 4; ++n) bfr[n] = *(const LAS bf16x8*)(lB + (wc * 64 + n * 16 + fr) * 272 + (k * 32 + fq * 8) * 2);
#pragma unroll
            for (int m = 0; m < 4; ++m)
#pragma unroll
                for (int n = 0; n < 4; ++n) acc[m][n] = __builtin_amdgcn_mfma_f32_16x16x32_bf16(bfr[n], af[m], acc[m][n], 0, 0, 0);
        }
        __syncthreads();
#pragma unroll
        for (int m = 0; m < 4; ++m)
#pragma unroll
            for (int n = 0; n < 4; ++n) { v2u w; w.x = pk2(acc[m][n][0], acc[m][n][1]); w.y = pk2(acc[m][n][2], acc[m][n][3]);
                *(LAS v2u*)(lB + (wr * 64 + m * 16 + fr) * 528 + (wc * 64 + n * 16 + 4 * fq) * 2) = w; }
        __syncthreads();
#pragma unroll
        for (int ps = 0; ps < 8; ++ps) { const unsigned p = ps * 16u + erow; const v4u sv = *(const LAS v4u*)(lB + p * 528 + d0 * 2); const v4u z = zu[ps]; const float bsv = bsr[ps];
            v4u o;
            o.x = pk2(bflo(z.x) * (bflo(sv.x) * vg0[0] + bsv), bfhi(z.x) * (bfhi(sv.x) * vg0[1] + bsv)); o.y = pk2(bflo(z.y) * (bflo(sv.y) * vg0[2] + bsv), bfhi(z.y) * (bfhi(sv.y) * vg0[3] + bsv));
            o.z = pk2(bflo(z.z) * (bflo(sv.z) * vg1[0] + bsv), bfhi(z.z) * (bfhi(sv.z) * vg1[1] + bsv)); o.w = pk2(bflo(z.w) * (bflo(sv.w) * vg1[2] + bsv), bfhi(z.w) * (bfhi(sv.w) * vg1[3] + bsv));
            *(v4u*)(GT + rowbase + (size_t)p * SGUW) = o; }
    }
#undef SP_PREFETCH
}

__device__ __forceinline__ void op_pool(Frame& F, KArgs A, int nrows) {
    const bf16* ZP = (const bf16*)(ws_ + WS_Z); bf16* P = (bf16*)(ws_ + WS_H);
    const long gt = (long)F.vcu * (NWAVES * 64) + F.tid, NGT = (long)F.G * NWAVES * 64;
    constexpr int RUN = 32;
    for (long e = gt; e < (long)(nrows / RUN) * 128; e += NGT) {
        const int run = (int)(e >> 7), c0 = (int)(e & 127) * 8, g = c0 >> 8, half = 1 << g;
        const int row0 = run * RUN;
        int pos0, L; if (row0 < NLAT) { pos0 = row0 & (SEQ - 1); L = SEQ; } else { pos0 = (row0 - NLAT) & (CTXL - 1); L = CTXL; }
        const bf16* zb = ZP + (size_t)(row0 - pos0) * DM + c0;
        float s[8];
#pragma unroll
        for (int i = 0; i < 8; ++i) s[i] = 0.f;
        const f32x4 sc0 = *(const f32x4*)(A->in[I_POOL_SCALE] + c0), sc1 = *(const f32x4*)(A->in[I_POOL_SCALE] + c0 + 4);
#define POOL_ACC(sgn, vv) do { const v4u _v = (vv); s[0] += (sgn) * bflo(_v.x); s[1] += (sgn) * bfhi(_v.x); s[2] += (sgn) * bflo(_v.y); s[3] += (sgn) * bfhi(_v.y); \
        s[4] += (sgn) * bflo(_v.z); s[5] += (sgn) * bfhi(_v.z); s[6] += (sgn) * bflo(_v.w); s[7] += (sgn) * bfhi(_v.w); } while (0)
#pragma unroll
        for (int w = 0; w < 16; ++w) { const int t = pos0 - half + w; const bool in = (w < 2 * half) && t >= 0 && t < L; const int tc = min(max(t, 0), L - 1);
            const v4u v = *(const v4u*)(zb + (size_t)tc * DM); const float f = in ? 1.f : 0.f; POOL_ACC(f, v); }
#pragma unroll 8
        for (int i = 0; i < RUN; ++i) {
            const int pos = pos0 + i;
            const int lo = max(pos - half, 0), hi = min(pos + half, L);
            const v4u z = *(const v4u*)(zb + (size_t)pos * DM); const float ic = 1.f / (float)(hi - lo);
            v4u o; o.x = pk2((s[0] * ic - bflo(z.x)) * sc0[0], (s[1] * ic - bfhi(z.x)) * sc0[1]); o.y = pk2((s[2] * ic - bflo(z.y)) * sc0[2], (s[3] * ic - bfhi(z.y)) * sc0[3]);
            o.z = pk2((s[4] * ic - bflo(z.z)) * sc1[0], (s[5] * ic - bfhi(z.z)) * sc1[1]); o.w = pk2((s[6] * ic - bflo(z.w)) * sc1[2], (s[7] * ic - bfhi(z.w)) * sc1[3]);
            *(v4u*)(P + (size_t)(row0 + i) * DM + c0) = o;
            const int tin = pos + half, tout = pos - half;
            const v4u vin = *(const v4u*)(zb + (size_t)min(tin, L - 1) * DM), vout = *(const v4u*)(zb + (size_t)max(tout, 0) * DM);
            POOL_ACC(tin < L ? 1.f : 0.f, vin); POOL_ACC(tout >= 0 ? -1.f : 0.f, vout);
        }
#undef POOL_ACC
    }
}

__device__ __forceinline__ void op_qknorm(Frame& F, KArgs A, int nrows) {
    const bf16* R = (const bf16*)(ws_ + WS_Z);
    bf16* QB = (bf16*)(ws_ + WS_G); bf16* KBUF = QB + (size_t)NTOK * DM; bf16* VBUF = KBUF + (size_t)NB * KVROWS * 256;
    const float* qg = A->in[I_ATT_QG]; const float* kg = A->in[I_ATT_KG];
    LAS float* tab = (LAS float*)F.lds;
    for (int e = F.tid; e < 64 * 32; e += NWAVES * 64) { const int pos = e >> 5, f = e & 31; const float fr = __expf(-(float)f * (9.210340371976184f / 32.f)); float sn, cs; sincosf((float)pos * fr, &sn, &cs); tab[e * 2] = cs; tab[e * 2 + 1] = sn; }
    __syncthreads();
    const int gw = F.vcu * NWAVES + F.wave, NGW = F.G * NWAVES;
    const int hl = F.lane >> 4, j = F.lane & 15;
    for (int row = gw; row < nrows; row += NGW) {
        const bool lat = row < NLAT; int b, pos; if (lat) { b = row >> 11; pos = row & (SEQ - 1); } else { b = (row - NLAT) >> 8; pos = (row - NLAT) & (CTXL - 1); }
        const int krow = b * KVROWS + (lat ? pos : SEQ + pos);
        const bf16* rr = R + (size_t)row * 1536;
#pragma unroll
        for (int pass = 0; pass < 3; ++pass) {
            const int head = pass * 4 + hl;
            const bool act = head < 10;
            float x[8];
            { v4u v = {0u, 0u, 0u, 0u}; if (act) v = *(const v4u*)(rr + head * 128 + j * 8);
              x[0] = bflo(v.x); x[1] = bfhi(v.x); x[2] = bflo(v.y); x[3] = bfhi(v.y); x[4] = bflo(v.z); x[5] = bfhi(v.z); x[6] = bflo(v.w); x[7] = bfhi(v.w); }
            float ss = 0.f;
#pragma unroll
            for (int i = 0; i < 8; ++i) ss += x[i] * x[i];
            ss += shx<1>(ss); ss += shx<2>(ss); ss += shx<4>(ss); ss += shx<8>(ss);
            const float rstd = __builtin_amdgcn_rsqf(ss * (1.f / 128.f) + EPS);
            const float* gn = (head < 8 ? qg : kg) + j * 8;
#pragma unroll
            for (int i = 0; i < 8; ++i) x[i] = x[i] * rstd * gn[i];
            float y[8];
#pragma unroll
            for (int i = 0; i < 8; ++i) { const float other = shx<4>(x[i]);
                const int dd = j * 8 + i, f = dd & 31, axis = dd >> 6, second = (dd >> 5) & 1;
                const int p = axis ? (pos & 63) : (pos >> 6);
                const float cs = tab[(p * 32 + f) * 2], sn = tab[(p * 32 + f) * 2 + 1];
                y[i] = lat ? (second ? x[i] * cs + other * sn : x[i] * cs - other * sn) : x[i]; }
            if (act) { v4u o; o.x = pk2(y[0], y[1]); o.y = pk2(y[2], y[3]); o.z = pk2(y[4], y[5]); o.w = pk2(y[6], y[7]);
                if (head < 8) *(v4u*)(QB + (size_t)row * DM + head * 128 + j * 8) = o;
                else *(v4u*)(KBUF + (size_t)krow * 256 + (head - 8) * 128 + j * 8) = o; }
        }
        if (F.lane < 32) *(v4u*)(VBUF + (size_t)krow * 256 + F.lane * 8) = *(const v4u*)(rr + 1280 + F.lane * 8);
    }
}

__device__ __forceinline__ void op_attn(Frame& F, KArgs A) {
    const attn::bf16* QB = (const attn::bf16*)(ws_ + WS_G); const attn::bf16* KBUF = QB + (size_t)NTOK * DM; const attn::bf16* VBUF = KBUF + (size_t)NB * KVROWS * 256;
    attn::bf16* OB = (attn::bf16*)(ws_ + WS_H);
    for (int u = F.vcu; u < 576; u += F.G) {
        int b, hq, rowbase, kbase, seq;
        if (u < 512) { b = u >> 6; hq = (u >> 3) & 7; rowbase = b * SEQ + (u & 7) * 256; kbase = b * KVROWS; seq = KVROWS; }
        else { const int v = u - 512; b = v >> 3; hq = v & 7; rowbase = NLAT + b * CTXL; kbase = b * KVROWS + SEQ; seq = CTXL; }
        const size_t qo = (size_t)rowbase * DM + hq * 128, ko = (size_t)kbase * 256 + (hq >> 2) * 128;
        attn::attn_dense_body(QB + qo, KBUF + ko, VBUF + ko, OB + qo, seq, (char*)F.lds, F.tid);
    }
}

__device__ __forceinline__ unsigned fkey(float v) { const unsigned u = __float_as_uint(v); return (u & 0x80000000u) ? ~u : (u | 0x80000000u); }
__device__ __forceinline__ float keyf(unsigned k) { return __uint_as_float((k & 0x80000000u) ? (k & 0x7fffffffu) : ~k); }
#define ROR_MAX(m, n) m = max(m, (unsigned)__builtin_amdgcn_update_dpp(0, (int)(m), 0x120 + (n), 0xf, 0xf, false))
__device__ __forceinline__ unsigned row_max16(unsigned m) { ROR_MAX(m, 1); ROR_MAX(m, 2); ROR_MAX(m, 4); ROR_MAX(m, 8); return m; }
__device__ __forceinline__ float row_sum16(float v) {
    v += __uint_as_float((unsigned)__builtin_amdgcn_update_dpp(0, (int)__float_as_uint(v), 0x121, 0xf, 0xf, false));
    v += __uint_as_float((unsigned)__builtin_amdgcn_update_dpp(0, (int)__float_as_uint(v), 0x122, 0xf, 0xf, false));
    v += __uint_as_float((unsigned)__builtin_amdgcn_update_dpp(0, (int)__float_as_uint(v), 0x124, 0xf, 0xf, false));
    v += __uint_as_float((unsigned)__builtin_amdgcn_update_dpp(0, (int)__float_as_uint(v), 0x128, 0xf, 0xf, false));
    return v;
}
#define CE(a, b) do { const unsigned _x = max(a, b), _y = min(a, b); a = _x; b = _y; } while (0)
__device__ __forceinline__ void op_topk(Frame& F, KArgs A, int layer, int nrows) {
    const unsigned short* SC = (const unsigned short*)(ws_ + WS_Z);   int* IDX = (int*)(ws_ + WS_IDX); pg8::f32x2* SG = (pg8::f32x2*)(ws_ + WS_SG); const float* SHQ = (const float*)(ws_ + WS_SHQ);
    const float* SU = (const float*)(ws_ + WS_SU) + (size_t)layer * NEXP; const float* SV = (const float*)(ws_ + WS_SV) + (size_t)layer * NEXP;
    const int gw = F.vcu * NWAVES + F.wave, NGW = F.G * NWAVES;
    const int rowi = F.lane >> 4, l16 = F.lane & 15, half = rowi & 1, pr = rowi >> 1;
    const int npairs = nrows * 8;
    const int base1 = (rowi & ~1) * 16, base2 = base1 + 16;
    v4u va[2];
    { const int pb = gw * 4;
#pragma unroll
      for (int u = 0; u < 2; ++u) { const int th = min(pb + 2 * u + pr, npairs - 1); const unsigned short* sp = SC + (size_t)th * 256 + half * 128;
          va[u] = *(const v4u*)(sp + 8 * l16); } }
    for (int pb = gw * 4; pb < npairs; pb += NGW * 4) {
        unsigned k[2][8];
#pragma unroll
        for (int u = 0; u < 2; ++u)
#pragma unroll
            for (int i = 0; i < 4; ++i) { const h2_t hv = u2h(va[u][i]);
                k[u][2 * i] = (fkey((float)hv.x) & ~127u) | (unsigned)(8 * l16 + 2 * i); k[u][2 * i + 1] = (fkey((float)hv.y) & ~127u) | (unsigned)(8 * l16 + 2 * i + 1); }
        { const int pn = pb + NGW * 4;
#pragma unroll
          for (int u = 0; u < 2; ++u) { const int th = min(pn + 2 * u + pr, npairs - 1); const unsigned short* sp = SC + (size_t)th * 256 + half * 128;
              va[u] = *(const v4u*)(sp + 8 * l16); } }
#pragma unroll
        for (int u = 0; u < 2; ++u) {
            CE(k[u][0], k[u][1]); CE(k[u][2], k[u][3]); CE(k[u][4], k[u][5]); CE(k[u][6], k[u][7]);
            CE(k[u][0], k[u][2]); CE(k[u][1], k[u][3]); CE(k[u][4], k[u][6]); CE(k[u][5], k[u][7]);
            CE(k[u][1], k[u][2]); CE(k[u][5], k[u][6]); CE(k[u][0], k[u][4]); CE(k[u][3], k[u][7]);
            CE(k[u][1], k[u][5]); CE(k[u][2], k[u][6]);
            CE(k[u][1], k[u][4]); CE(k[u][3], k[u][6]);
            CE(k[u][2], k[u][4]); CE(k[u][3], k[u][5]);
            CE(k[u][3], k[u][4]); }
        unsigned res[2] = {0u, 0u};
#pragma unroll
        for (int it = 0; it < 16; ++it) {
#pragma unroll
            for (int u = 0; u < 2; ++u) {
                const unsigned m = row_max16(k[u][0]);
                res[u] = (l16 == it) ? m : res[u];
                const bool win = (k[u][0] == m);
#pragma unroll
                for (int i = 0; i < 7; ++i) k[u][i] = win ? k[u][i + 1] : k[u][i];
                k[u][7] = win ? 0u : k[u][7];
            }
        }
        float val[2]; int kid[2];
#pragma unroll
        for (int u = 0; u < 2; ++u) { val[u] = keyf(res[u] & ~127u); kid[u] = (int)(res[u] & 127u); }
        const int rowbase = rowi * 16, src1 = half ? rowbase - 16 : rowbase, src2 = half ? rowbase : rowbase + 16;
        const float v1o = bperm(src1 + l16, val[1]); const float v1 = half ? v1o : val[0];
        int p = 0;
        const float v2a0 = bperm(src2, val[0]), v2b0 = bperm(src2, val[1]);
        float v2p = half ? v2b0 : v2a0;
        unsigned ck = (fkey(v1 + v2p) & ~255u) | (unsigned)(l16 * 16), best = 0u;
#pragma unroll
        for (int it = 0; it < 16; ++it) {
            const unsigned m = row_max16(ck);
            best = (l16 == it) ? m : best;
            const bool win = (ck == m);
            p += win ? 1 : 0;
            const int pc = min(p, 15);
            const float va = bperm(src2 + pc, val[0]), vb = bperm(src2 + pc, val[1]);
            v2p = half ? vb : va;
            const unsigned nk = (p > 15) ? 0u : ((fkey(v1 + v2p) & ~255u) | (unsigned)(l16 * 16 + pc));
            ck = win ? nk : ck;
        }
        {
            const int th = pb + 2 * half + pr;
            const int cid = (int)(best & 255u); const float bsum = keyf(best & ~255u);
            const int e1a = bperm_i(src1 + (cid >> 4), kid[0]), e1b = bperm_i(src1 + (cid >> 4), kid[1]);
            const int e2a = bperm_i(src2 + (cid & 15), kid[0]), e2b = bperm_i(src2 + (cid & 15), kid[1]);
            const int e1 = half ? e1b : e1a, e2 = half ? e2b : e2a;
            const float mx = bperm(rowbase, bsum);
            const float ex = __expf(bsum - mx);
            const float den = row_sum16(ex);
            if (th < npairs) { const int eid = e1 * 128 + e2; IDX[(size_t)th * 16 + l16] = eid;
                SG[(size_t)th * 16 + l16] = (pg8::f32x2){SU[eid] * (SHQ[th >> 3] * 16.f), (ex / den) * SV[eid]}; }
        }
    }
}

__device__ __forceinline__ void fmac(float& d, float a, float b) { asm("v_fmac_f32 %0, %1, %2" : "+v"(d) : "v"(a), "v"(b)); }
#define FP8_LO(w) __builtin_amdgcn_cvt_pk_f32_fp8((int)(w), false)
#define FP8_HI(w) __builtin_amdgcn_cvt_pk_f32_fp8((int)(w), true)
#define DOT16(a, r) do { pg8::f32x2 _f; \
    _f = FP8_LO((r).x); a += _f.x * hf[0] + _f.y * hf[1];   _f = FP8_HI((r).x); a += _f.x * hf[2] + _f.y * hf[3]; \
    _f = FP8_LO((r).y); a += _f.x * hf[4] + _f.y * hf[5];   _f = FP8_HI((r).y); a += _f.x * hf[6] + _f.y * hf[7]; \
    _f = FP8_LO((r).z); a += _f.x * hf[8] + _f.y * hf[9];   _f = FP8_HI((r).z); a += _f.x * hf[10] + _f.y * hf[11]; \
    _f = FP8_LO((r).w); a += _f.x * hf[12] + _f.y * hf[13]; _f = FP8_HI((r).w); a += _f.x * hf[14] + _f.y * hf[15]; } while (0)
#define AXPY16(w, r) do { pg8::f32x2 _f; \
    _f = FP8_LO((r).x); fmac(fo[0], (w), _f.x); fmac(fo[1], (w), _f.y);   _f = FP8_HI((r).x); fmac(fo[2], (w), _f.x); fmac(fo[3], (w), _f.y); \
    _f = FP8_LO((r).y); fmac(fo[4], (w), _f.x); fmac(fo[5], (w), _f.y);   _f = FP8_HI((r).y); fmac(fo[6], (w), _f.x); fmac(fo[7], (w), _f.y); \
    _f = FP8_LO((r).z); fmac(fo[8], (w), _f.x); fmac(fo[9], (w), _f.y);   _f = FP8_HI((r).z); fmac(fo[10], (w), _f.x); fmac(fo[11], (w), _f.y); \
    _f = FP8_LO((r).w); fmac(fo[12], (w), _f.x); fmac(fo[13], (w), _f.y); _f = FP8_HI((r).w); fmac(fo[14], (w), _f.x); fmac(fo[15], (w), _f.y); } while (0)
#define DOT16V(a, r, H_) do { pg8::f32x2 _f; \
    _f = FP8_LO((r).x); fmac(a, _f.x, H_[0]); fmac(a, _f.y, H_[1]);   _f = FP8_HI((r).x); fmac(a, _f.x, H_[2]); fmac(a, _f.y, H_[3]); \
    _f = FP8_LO((r).y); fmac(a, _f.x, H_[4]); fmac(a, _f.y, H_[5]);   _f = FP8_HI((r).y); fmac(a, _f.x, H_[6]); fmac(a, _f.y, H_[7]); \
    _f = FP8_LO((r).z); fmac(a, _f.x, H_[8]); fmac(a, _f.y, H_[9]);   _f = FP8_HI((r).z); fmac(a, _f.x, H_[10]); fmac(a, _f.y, H_[11]); \
    _f = FP8_LO((r).w); fmac(a, _f.x, H_[12]); fmac(a, _f.y, H_[13]); _f = FP8_HI((r).w); fmac(a, _f.x, H_[14]); fmac(a, _f.y, H_[15]); } while (0)
#define CVH_LO(w) __builtin_bit_cast(h2_t, __builtin_amdgcn_cvt_scalef32_pk_f16_fp8((w), 1.0f, false))
#define CVH_HI(w) __builtin_bit_cast(h2_t, __builtin_amdgcn_cvt_scalef32_pk_f16_fp8((w), 1.0f, true))
#define DOT16H(a, r, Hh) do { \
    a = __builtin_amdgcn_fdot2(CVH_LO((r).x), Hh[0], a, false); a = __builtin_amdgcn_fdot2(CVH_HI((r).x), Hh[1], a, false); \
    a = __builtin_amdgcn_fdot2(CVH_LO((r).y), Hh[2], a, false); a = __builtin_amdgcn_fdot2(CVH_HI((r).y), Hh[3], a, false); \
    a = __builtin_amdgcn_fdot2(CVH_LO((r).z), Hh[4], a, false); a = __builtin_amdgcn_fdot2(CVH_HI((r).z), Hh[5], a, false); \
    a = __builtin_amdgcn_fdot2(CVH_LO((r).w), Hh[6], a, false); a = __builtin_amdgcn_fdot2(CVH_HI((r).w), Hh[7], a, false); } while (0)
#define AXPY16H(wh, r) do { \
    fo[0] = __builtin_elementwise_fma(CVH_LO((r).x), (wh), fo[0]); fo[1] = __builtin_elementwise_fma(CVH_HI((r).x), (wh), fo[1]); \
    fo[2] = __builtin_elementwise_fma(CVH_LO((r).y), (wh), fo[2]); fo[3] = __builtin_elementwise_fma(CVH_HI((r).y), (wh), fo[3]); \
    fo[4] = __builtin_elementwise_fma(CVH_LO((r).z), (wh), fo[4]); fo[5] = __builtin_elementwise_fma(CVH_HI((r).z), (wh), fo[5]); \
    fo[6] = __builtin_elementwise_fma(CVH_LO((r).w), (wh), fo[6]); fo[7] = __builtin_elementwise_fma(CVH_HI((r).w), (wh), fo[7]); } while (0)
__device__ __forceinline__ h2_t pkh(float a, float b) { return __builtin_bit_cast(h2_t, __builtin_amdgcn_cvt_pkrtz(a, b)); }
#define CVL(d, w) asm volatile("v_cvt_scalef32_pk_f16_fp8 %0, %1, 1.0" : "=v"(d) : "v"(w))
#define CVU(d, w) asm volatile("v_cvt_scalef32_pk_f16_fp8 %0, %1, 1.0 op_sel:[1,0,0]" : "=v"(d) : "v"(w))
#define D2H(a, x, h) asm volatile("v_dot2c_f32_f16 %0, %1, %2" : "+v"(a) : "v"(x), "v"(h))
#define PKF(f, x, w) asm volatile("v_pk_fma_f16 %0, %1, %2, %0" : "+v"(f) : "v"(x), "v"(w))
#define DOT2ROWS(accA, accB, ra, rb, hu) do { unsigned _t0, _t1, _t2, _t3, _t4, _t5, _t6, _t7, _s0, _s1, _s2, _s3, _s4, _s5, _s6, _s7; float _a2 = 0.f, _b2 = 0.f; \
    CVL(_t0, (ra).x); CVU(_t1, (ra).x); CVL(_t2, (ra).y); CVU(_t3, (ra).y); CVL(_t4, (ra).z); CVU(_t5, (ra).z); CVL(_t6, (ra).w); CVU(_t7, (ra).w); \
    CVL(_s0, (rb).x); CVU(_s1, (rb).x); CVL(_s2, (rb).y); CVU(_s3, (rb).y); CVL(_s4, (rb).z); CVU(_s5, (rb).z); CVL(_s6, (rb).w); CVU(_s7, (rb).w); \
    D2H(accA, _t0, hu[0]); D2H(accB, _s0, hu[0]); D2H(_a2, _t1, hu[1]); D2H(_b2, _s1, hu[1]); D2H(accA, _t2, hu[2]); D2H(accB, _s2, hu[2]); D2H(_a2, _t3, hu[3]); D2H(_b2, _s3, hu[3]); \
    D2H(accA, _t4, hu[4]); D2H(accB, _s4, hu[4]); D2H(_a2, _t5, hu[5]); D2H(_b2, _s5, hu[5]); D2H(accA, _t6, hu[6]); D2H(accB, _s6, hu[6]); \
      \
    asm volatile("v_dot2c_f32_f16 %2, %4, %6\n\tv_dot2c_f32_f16 %3, %5, %6\n\ts_nop 2\n\tv_add_f32 %0, %0, %2\n\tv_add_f32 %1, %1, %3" \
        : "+v"(accA), "+v"(accB), "+v"(_a2), "+v"(_b2) : "v"(_t7), "v"(_s7), "v"(hu[7])); } while (0)
#define AXPYROW(fu, wu, r) do { unsigned _t0, _t1, _t2, _t3, _t4, _t5, _t6, _t7; \
    CVL(_t0, (r).x); CVU(_t1, (r).x); CVL(_t2, (r).y); CVU(_t3, (r).y); CVL(_t4, (r).z); CVU(_t5, (r).z); CVL(_t6, (r).w); CVU(_t7, (r).w); \
    PKF(fu[0], _t0, wu); PKF(fu[1], _t1, wu); PKF(fu[2], _t2, wu); PKF(fu[3], _t3, wu); PKF(fu[4], _t4, wu); PKF(fu[5], _t5, wu); PKF(fu[6], _t6, wu); PKF(fu[7], _t7, wu); } while (0)
#define C4B0(d, w) asm volatile("v_cvt_scalef32_pk_f16_fp4 %0, %1, 1.0" : "=v"(d) : "v"(w))
#define C4B1(d, w) asm volatile("v_cvt_scalef32_pk_f16_fp4 %0, %1, 1.0 op_sel:[1,0,0]" : "=v"(d) : "v"(w))
#define C4B2(d, w) asm volatile("v_cvt_scalef32_pk_f16_fp4 %0, %1, 1.0 op_sel:[0,1,0]" : "=v"(d) : "v"(w))
#define C4B3(d, w) asm volatile("v_cvt_scalef32_pk_f16_fp4 %0, %1, 1.0 op_sel:[1,1,0]" : "=v"(d) : "v"(w))
#define C4ROW(T, r) do { C4B0(T[0], (r).x); C4B1(T[1], (r).x); C4B2(T[2], (r).x); C4B3(T[3], (r).x); C4B0(T[4], (r).y); C4B1(T[5], (r).y); C4B2(T[6], (r).y); C4B3(T[7], (r).y); \
    C4B0(T[8], (r).z); C4B1(T[9], (r).z); C4B2(T[10], (r).z); C4B3(T[11], (r).z); C4B0(T[12], (r).w); C4B1(T[13], (r).w); C4B2(T[14], (r).w); C4B3(T[15], (r).w); } while (0)
#define DOT2ROWS4(accA, accB, ra, rb, hu) do { unsigned _t[16], _s[16]; float _a2 = 0.f, _b2 = 0.f; C4ROW(_t, ra); C4ROW(_s, rb); \
    _Pragma("unroll") for (int _i = 0; _i < 14; _i += 2) { D2H(accA, _t[_i], hu[_i]); D2H(accB, _s[_i], hu[_i]); D2H(_a2, _t[_i + 1], hu[_i + 1]); D2H(_b2, _s[_i + 1], hu[_i + 1]); } \
    D2H(accA, _t[14], hu[14]); D2H(accB, _s[14], hu[14]); \
    asm volatile("v_dot2c_f32_f16 %2, %4, %6\n\tv_dot2c_f32_f16 %3, %5, %6\n\ts_nop 2\n\tv_add_f32 %0, %0, %2\n\tv_add_f32 %1, %1, %3" \
        : "+v"(accA), "+v"(accB), "+v"(_a2), "+v"(_b2) : "v"(_t[15]), "v"(_s[15]), "v"(hu[15])); } while (0)
#define AXPYROW4(fu, wu, r) do { unsigned _t[16]; C4ROW(_t, r); _Pragma("unroll") for (int _i = 0; _i < 16; ++_i) PKF(fu[_i], _t[_i], wu); } while (0)
__device__ __forceinline__ void slice_map(Frame& F, KArgs A, int& x0, int& nsl, int& w0, int& NW_) {
    if ((F.G % 8) != 0) { x0 = 0; nsl = 8; w0 = F.vcu * NWAVES + F.wave; NW_ = F.G * NWAVES; return; }
    unsigned* bar = (unsigned*)(ws_ + WS_CTL) + CW_BAR; bool even = true;
#pragma unroll
    for (int j = 0; j < 8; ++j) even = even && (xb_ld(&bar[XB_XCNT(j)]) == (unsigned)(F.G >> 3));
    const unsigned rk = ((volatile LAS unsigned*)(F.lds + MISC_OFF))[12], xcc = ((volatile LAS unsigned*)(F.lds + MISC_OFF))[13];
    const int sl = even ? (int)__builtin_amdgcn_readfirstlane(xcc) : (F.bx & 7), sub = even ? (int)__builtin_amdgcn_readfirstlane(rk) : (F.bx >> 3);
    x0 = sl; nsl = 1; w0 = sub * NWAVES + F.wave; NW_ = (F.G >> 3) * NWAVES;
}
__device__ __forceinline__ void slice_map4(Frame& F, KArgs A, int& x0, int& nsl, int& w0, int& NW_) {
    slice_map(F, A, x0, nsl, w0, NW_);
    if (nsl == 8) { nsl = 4; return; }
    const int sl = x0; x0 = sl >> 1; w0 += (sl & 1) * NW_; NW_ *= 2;
}
#define G_LOAD_E(E_, tt) do { const int* _ip = IDX + (size_t)(tt) * 128; _Pragma("unroll") for (int q = 0; q < 4; ++q) E_[q] = *(const v4u*)(_ip + 16u * gg + 4u * q); } while (0)
#define G_LOAD_R8(R_, Ea, Eb, tsl_) do { \
    R_[0] = *(const v4u*)((tsl_) + ((Ea).x * 128u + 16u * pp)); R_[1] = *(const v4u*)((tsl_) + ((Ea).y * 128u + 16u * pp)); \
    R_[2] = *(const v4u*)((tsl_) + ((Ea).z * 128u + 16u * pp)); R_[3] = *(const v4u*)((tsl_) + ((Ea).w * 128u + 16u * pp)); \
    R_[4] = *(const v4u*)((tsl_) + ((Eb).x * 128u + 16u * pp)); R_[5] = *(const v4u*)((tsl_) + ((Eb).y * 128u + 16u * pp)); \
    R_[6] = *(const v4u*)((tsl_) + ((Eb).z * 128u + 16u * pp)); R_[7] = *(const v4u*)((tsl_) + ((Eb).w * 128u + 16u * pp)); } while (0)
#define G_RING(r_, n_) ((r_) + (n_) >= 3 ? (r_) + (n_) - 3 : (r_) + (n_))
#define G_LOAD_R8L(R_, Ea, Eb, tsl_) do { \
    R_[0] = *(const v4u*)((tsl_) + ((Ea).x * 128u + 16u * pp)); R_[1] = *(const v4u*)((tsl_) + ((Ea).y * 128u + 16u * pp)); \
    R_[2] = *(const v4u*)((tsl_) + ((Ea).z * 128u + 16u * pp)); R_[3] = *(const v4u*)((tsl_) + ((Ea).w * 128u + 16u * pp)); \
    R_[4] = *(const v4u*)((tsl_) + ((Eb).x * 128u + 16u * pp)); R_[5] = *(const v4u*)((tsl_) + ((Eb).y * 128u + 16u * pp)); \
    R_[6] = *(const v4u*)((tsl_) + ((Eb).z * 128u + 16u * pp)); R_[7] = *(const v4u*)((tsl_) + ((Eb).w * 128u + 16u * pp)); } while (0)
__device__ __forceinline__ void op_gather_u(Frame& F, KArgs A, int layer, int nrows, bool dry) {
    const unsigned char* TU = ws_ + WS_TU + (size_t)layer * NEXP * 512;
    const int* IDX = (const int*)(ws_ + WS_IDX); const unsigned* HQ = (const unsigned*)(ws_ + WS_H8);
    unsigned* PACT = (unsigned*)(ws_ + (dry ? WS_G : WS_Z));
    int x0, nsl, w0, NW_; slice_map4(F, A, x0, nsl, w0, NW_);
    const unsigned pp0 = (unsigned)F.lane & 7u, gg0 = (unsigned)F.lane >> 3, ll0 = (unsigned)F.lane;
    const bool b0 = F.lane & 1, b1 = F.lane & 2, b2 = F.lane & 4;
    LAS unsigned* lE = (LAS unsigned*)(F.lds + F.wave * 4096 + 1024);
    LAS unsigned* lH = (LAS unsigned*)(F.lds + F.wave * 4096 + 2560);
    for (int xs = 0; xs < nsl; ++xs) {
        const int x = x0 + xs;
        const unsigned char* tsl = TU + (size_t)x * (NEXP * 128);
        const unsigned* Hx = HQ + x * 64;
        int t = w0;
        if (t >= nrows) continue;
        const int tlast = t + ((nrows - 1 - t) / NW_) * NW_;
        unsigned pp = pp0, gg = gg0, ll = ll0; asm volatile("" : "+v"(pp), "+v"(gg), "+v"(ll));
        v4u R0[8], R1[8]; v2u eraw; unsigned hraw;
#define G1_GLOAD(tt) do { const int _t = (tt) < tlast ? (tt) : tlast; eraw = *(const v2u*)(IDX + (size_t)_t * 128 + 2u * ll); hraw = Hx[(size_t)_t * 256 + ll]; } while (0)
#define G1_LWRITE(r_) do { *(LAS v2u*)(lE + (r_) * 128 + 2u * ll) = eraw; lH[(r_) * 64 + ll] = hraw; } while (0)
        G1_GLOAD(t); G1_LWRITE(0); G1_GLOAD(t + NW_); G1_LWRITE(1); G1_GLOAD(t + 2 * NW_);
        { const v4u e0 = *(const LAS v4u*)(lE + 16u * gg), e1 = *(const LAS v4u*)(lE + 16u * gg + 4u); G_LOAD_R8L(R0, e0, e1, tsl); }
        int r = 0;
        while (t < nrows) {
            const int tn = t + NW_;
            pp = pp0; gg = gg0; ll = ll0; asm volatile("" : "+v"(pp), "+v"(gg), "+v"(ll));
            const unsigned k0 = 16u * gg + ((pp & 1u) << 3) + ((pp & 2u) << 1) + ((pp & 4u) >> 1);
            const int r1 = G_RING(r, 1), r2 = G_RING(r, 2);
            G1_LWRITE(r2);
            G1_GLOAD(t + 3 * NW_);
            const v4u ea0 = *(const LAS v4u*)(lE + r * 128 + 16u * gg + 8u), ea1 = *(const LAS v4u*)(lE + r * 128 + 16u * gg + 12u);
            const v4u eb0 = *(const LAS v4u*)(lE + r1 * 128 + 16u * gg), eb1 = *(const LAS v4u*)(lE + r1 * 128 + 16u * gg + 4u);
            const v4u ha = *(const LAS v4u*)(lH + r * 64 + 4u * pp), hb = *(const LAS v4u*)(lH + r * 64 + 32u + 4u * pp);
            G_LOAD_R8L(R1, ea0, ea1, tsl);
            int hs;
            { int sa = __builtin_amdgcn_sdot8((int)ha.x, 0x11111111, 0, false); sa = __builtin_amdgcn_sdot8((int)ha.y, 0x11111111, sa, false); sa = __builtin_amdgcn_sdot8((int)ha.z, 0x11111111, sa, false); sa = __builtin_amdgcn_sdot8((int)ha.w, 0x11111111, sa, false);
              int sb = __builtin_amdgcn_sdot8((int)hb.x, 0x11111111, 0, false); sb = __builtin_amdgcn_sdot8((int)hb.y, 0x11111111, sb, false); sb = __builtin_amdgcn_sdot8((int)hb.z, 0x11111111, sb, false); sb = __builtin_amdgcn_sdot8((int)hb.w, 0x11111111, sb, false);
              hs = (sa << 4) + sb; }
            unsigned a[16];
#define G1_ROW(R_) ({ int _a = __builtin_amdgcn_sdot8((int)(R_).x, (int)ha.x, 0, false), _b = __builtin_amdgcn_sdot8((int)(R_).x, (int)hb.x, 0, false); \
            _a = __builtin_amdgcn_sdot8((int)(R_).y, (int)ha.y, _a, false); _b = __builtin_amdgcn_sdot8((int)(R_).y, (int)hb.y, _b, false); \
            _a = __builtin_amdgcn_sdot8((int)(R_).z, (int)ha.z, _a, false); _b = __builtin_amdgcn_sdot8((int)(R_).z, (int)hb.z, _b, false); \
            _a = __builtin_amdgcn_sdot8((int)(R_).w, (int)ha.w, _a, false); _b = __builtin_amdgcn_sdot8((int)(R_).w, (int)hb.w, _b, false); \
            (unsigned)((((_a << 4) + _b) << 1) + hs); })
#pragma unroll
            for (int i = 0; i < 8; ++i) a[i] = G1_ROW(R0[i]);
            G_LOAD_R8L(R0, eb0, eb1, tsl);
#pragma unroll
            for (int i = 0; i < 8; ++i) a[8 + i] = G1_ROW(R1[i]);
#undef G1_ROW
            unsigned a8[8], a4[4], a2[2];
#pragma unroll
            for (int i = 0; i < 8; ++i) { const unsigned mine = b0 ? a[8 + i] : a[i], send = b0 ? a[i] : a[8 + i]; a8[i] = mine + shx_u<1>(send); }
#pragma unroll
            for (int i = 0; i < 4; ++i) { const unsigned mine = b1 ? a8[4 + i] : a8[i], send = b1 ? a8[i] : a8[4 + i]; a4[i] = mine + shx_u<2>(send); }
#pragma unroll
            for (int i = 0; i < 2; ++i) { const unsigned mine = b2 ? a4[2 + i] : a4[i], send = b2 ? a4[i] : a4[2 + i]; a2[i] = mine + shx_u<4>(send); }
            PACT[((size_t)x * NTOK + t) * 64 + (k0 >> 1)] = h2u(pkh((float)(int)a2[0] * (1.f / 32.f), (float)(int)a2[1] * (1.f / 32.f)));
            r = r1; t = tn;
        }
#undef G1_GLOAD
#undef G1_LWRITE
        LDS_WAIT(); asm volatile("" ::: "memory");
    }
}
#define G2_TR4(y0, y1, y2, y3, x0, x1, x2, x3) do { const unsigned _t0 = __builtin_amdgcn_perm(x1, x0, 0x05010400u), _t1 = __builtin_amdgcn_perm(x1, x0, 0x07030602u), \
    _t2 = __builtin_amdgcn_perm(x3, x2, 0x05010400u), _t3 = __builtin_amdgcn_perm(x3, x2, 0x07030602u); \
    y0 = __builtin_amdgcn_perm(_t2, _t0, 0x05040100u); y1 = __builtin_amdgcn_perm(_t2, _t0, 0x07060302u); y2 = __builtin_amdgcn_perm(_t3, _t1, 0x05040100u); y3 = __builtin_amdgcn_perm(_t3, _t1, 0x07060302u); } while (0)
#define G2_QUAD(Ra, Rb, Rc, Rd, W_) do { _Pragma("unroll") for (int _d = 0; _d < 4; ++_d) { unsigned _y0, _y1, _y2, _y3; G2_TR4(_y0, _y1, _y2, _y3, (Ra)[_d], (Rb)[_d], (Rc)[_d], (Rd)[_d]); \
    aT[4 * _d] = __builtin_amdgcn_sdot4((int)_y0, (int)(W_), aT[4 * _d], false); aL[4 * _d] = __builtin_amdgcn_sdot4((int)(_y0 & 0x0f0f0f0fu), (int)(W_), aL[4 * _d], false); \
    aT[4 * _d + 1] = __builtin_amdgcn_sdot4((int)_y1, (int)(W_), aT[4 * _d + 1], false); aL[4 * _d + 1] = __builtin_amdgcn_sdot4((int)(_y1 & 0x0f0f0f0fu), (int)(W_), aL[4 * _d + 1], false); \
    aT[4 * _d + 2] = __builtin_amdgcn_sdot4((int)_y2, (int)(W_), aT[4 * _d + 2], false); aL[4 * _d + 2] = __builtin_amdgcn_sdot4((int)(_y2 & 0x0f0f0f0fu), (int)(W_), aL[4 * _d + 2], false); \
    aT[4 * _d + 3] = __builtin_amdgcn_sdot4((int)_y3, (int)(W_), aT[4 * _d + 3], false); aL[4 * _d + 3] = __builtin_amdgcn_sdot4((int)(_y3 & 0x0f0f0f0fu), (int)(W_), aL[4 * _d + 3], false); } } while (0)
#define G2_D0(d, y, w) asm volatile("v_dot4_i32_i8 %0, %1, %2, 0" : "=v"(d) : "v"(y), "v"(w))
#define G2_QUAD0(Ra, Rb, Rc, Rd, W_) do { _Pragma("unroll") for (int _d = 0; _d < 4; ++_d) { unsigned _y0, _y1, _y2, _y3; G2_TR4(_y0, _y1, _y2, _y3, (Ra)[_d], (Rb)[_d], (Rc)[_d], (Rd)[_d]); \
    const unsigned _m0 = _y0 & 0x0f0f0f0fu, _m1 = _y1 & 0x0f0f0f0fu, _m2 = _y2 & 0x0f0f0f0fu, _m3 = _y3 & 0x0f0f0f0fu; \
    G2_D0(aT[4 * _d], _y0, W_); G2_D0(aL[4 * _d], _m0, W_); G2_D0(aT[4 * _d + 1], _y1, W_); G2_D0(aL[4 * _d + 1], _m1, W_); \
    G2_D0(aT[4 * _d + 2], _y2, W_); G2_D0(aL[4 * _d + 2], _m2, W_); G2_D0(aT[4 * _d + 3], _y3, W_); G2_D0(aL[4 * _d + 3], _m3, W_); } } while (0)
__device__ __forceinline__ void op_gather_v(Frame& F, KArgs A, int layer, int nrows, bool dry) {
    const unsigned char* TV = ws_ + WS_TV + (size_t)layer * NEXP * 512;
    const int* IDX = (const int*)(ws_ + WS_IDX); const f32x4* SG = (const f32x4*)(ws_ + WS_SG); const unsigned* PACT = (const unsigned*)(ws_ + WS_Z);
    unsigned* X = (unsigned*)(ws_ + WS_X); unsigned* Xw = dry ? (unsigned*)(ws_ + WS_Z + 80 * MiB) : X;
    const float* modl = (const float*)(ws_ + WS_MOD) + (size_t)layer * 9 * MODW;
    LAS unsigned* wl = (LAS unsigned*)(F.lds + F.wave * 4096);
    LAS unsigned* lE = (LAS unsigned*)(F.lds + F.wave * 4096 + 1024);
    int x0, nsl, w0, NW_; slice_map4(F, A, x0, nsl, w0, NW_);
    const unsigned pp0 = (unsigned)F.lane & 7u, gg0 = (unsigned)F.lane >> 3, ll0 = (unsigned)F.lane;
    const bool b3 = F.lane & 8, b4 = F.lane & 16, b5 = F.lane & 32;
    for (int xs = 0; xs < nsl; ++xs) {
        const int x = x0 + xs;
        const unsigned char* tsl = TV + (size_t)x * (NEXP * 128);
        int t = w0;
        if (t >= nrows) continue;
        const int tlast = t + ((nrows - 1 - t) / NW_) * NW_;
        v4u R0[8], R1[8]; v2u eraw;
        unsigned pp = pp0, gg = gg0, ll = ll0; asm volatile("" : "+v"(pp), "+v"(gg), "+v"(ll));
        unsigned pw[4]; f32x4 psg;
        float swc, swn;
#define G2_LOAD_W(tt) do { const int _t = (tt) < tlast ? (tt) : tlast; const unsigned* _pa = PACT + (size_t)_t * 64; \
        _Pragma("unroll") for (int xx = 0; xx < 4; ++xx) pw[xx] = _pa[(size_t)xx * NTOK * 64 + ll]; \
        psg = SG[(size_t)_t * 64 + ll]; } while (0)
#define G2_MAKE_W(buf, sw_) do { float s0 = 0.f, s1 = 0.f; _Pragma("unroll") for (int xx = 0; xx < 4; ++xx) { const h2_t _h = u2h(pw[xx]); s0 += (float)_h.x; s1 += (float)_h.y; } \
        const float _w0 = pg8::gelu1(s0 * psg.x) * psg.y, _w1 = pg8::gelu1(s1 * psg.z) * psg.w; \
        const float _m = wave_max(fmaxf(fabsf(_w0), fabsf(_w1))), _inv = _m > 0.f ? 127.f / _m : 0.f; \
        const int _q0 = (int)__builtin_rintf(_w0 * _inv), _q1 = (int)__builtin_rintf(_w1 * _inv); \
        *((LAS unsigned short*)(wl + (buf) * 32) + ll) = (unsigned short)(((unsigned)_q0 & 255u) | (((unsigned)_q1 & 255u) << 8)); sw_ = _m * (1.f / 127.f); } while (0)
#define G2_GLOAD(tt) do { const int _t = (tt) < tlast ? (tt) : tlast; eraw = *(const v2u*)(IDX + (size_t)_t * 128 + 2u * ll); } while (0)
#define G2_LWRITE(r_) do { *(LAS v2u*)(lE + (r_) * 128 + 2u * ll) = eraw; } while (0)
        G2_GLOAD(t); G2_LWRITE(0); G2_GLOAD(t + NW_); G2_LWRITE(1); G2_GLOAD(t + 2 * NW_);
        G2_LOAD_W(t);
        { const v4u e0 = *(const LAS v4u*)(lE + 16u * gg), e1 = *(const LAS v4u*)(lE + 16u * gg + 4u); G_LOAD_R8L(R0, e0, e1, tsl); }
        G2_MAKE_W(0, swc);
        int buf = 0, r = 0;
        while (t < nrows) {
            const int tn = t + NW_; const int mr = t < NLAT ? (t >> 11) : 8;
            pp = pp0; gg = gg0; ll = ll0; asm volatile("" : "+v"(pp), "+v"(gg), "+v"(ll));
            const unsigned colb = (unsigned)x * 256u + 32u * pp + ((gg & 1u) << 4) + ((gg & 2u) << 2) + (gg & 4u);
            const int r1 = G_RING(r, 1), r2 = G_RING(r, 2);
            G2_LWRITE(r2);
            G2_GLOAD(t + 3 * NW_);
            const v4u ea0 = *(const LAS v4u*)(lE + r * 128 + 16u * gg + 8u), ea1 = *(const LAS v4u*)(lE + r * 128 + 16u * gg + 12u);
            const v4u eb0 = *(const LAS v4u*)(lE + r1 * 128 + 16u * gg), eb1 = *(const LAS v4u*)(lE + r1 * 128 + 16u * gg + 4u);
            G_LOAD_R8L(R1, ea0, ea1, tsl);
            G2_LOAD_W(tn);
            const f32x4 gt2 = *(const f32x4*)(modl + mr * MODW + 5 * DM + colb);
            const v2u xo = *(const v2u*)(X + (((size_t)t * DM + colb) >> 1));
            LDS_WAIT(); asm volatile("" ::: "memory");
            const v4u wq = *(const LAS v4u*)(wl + buf * 32 + 4u * gg);
            int aT[16], aL[16];
            G2_QUAD0(R0[0], R0[1], R0[2], R0[3], wq.x); G2_QUAD(R0[4], R0[5], R0[6], R0[7], wq.y);
            G_LOAD_R8L(R0, eb0, eb1, tsl);
            G2_QUAD(R1[0], R1[1], R1[2], R1[3], wq.z); G2_QUAD(R1[4], R1[5], R1[6], R1[7], wq.w);
            int sw = __builtin_amdgcn_sdot4((int)wq.x, 0x01010101, 0, false); sw = __builtin_amdgcn_sdot4((int)wq.y, 0x01010101, sw, false);
            sw = __builtin_amdgcn_sdot4((int)wq.z, 0x01010101, sw, false); sw = __builtin_amdgcn_sdot4((int)wq.w, 0x01010101, sw, false);
            sw += (int)shx_u<8>((unsigned)sw); sw += (int)shx_u<16>((unsigned)sw); sw += (int)shx32_u((unsigned)sw, b5);
            unsigned T8[8], T4[4], T2[2], L8[8], L4[4], L2[2];
#pragma unroll
            for (int i = 0; i < 8; ++i) { const unsigned mt = (unsigned)(b3 ? aT[8 + i] : aT[i]), st = (unsigned)(b3 ? aT[i] : aT[8 + i]); T8[i] = mt + shx_u<8>(st);
                                          const unsigned ml = (unsigned)(b3 ? aL[8 + i] : aL[i]), sl = (unsigned)(b3 ? aL[i] : aL[8 + i]); L8[i] = ml + shx_u<8>(sl); }
#pragma unroll
            for (int i = 0; i < 4; ++i) { const unsigned mt = b4 ? T8[4 + i] : T8[i], st = b4 ? T8[i] : T8[4 + i]; T4[i] = mt + shx_u<16>(st);
                                          const unsigned ml = b4 ? L8[4 + i] : L8[i], sl = b4 ? L8[i] : L8[4 + i]; L4[i] = ml + shx_u<16>(sl); }
#pragma unroll
            for (int i = 0; i < 2; ++i) { const unsigned mt = b5 ? T4[2 + i] : T4[i], st = b5 ? T4[i] : T4[2 + i]; T2[i] = mt + shx32_u(st, b5);
                                          const unsigned ml = b5 ? L4[2 + i] : L4[i], sl = b5 ? L4[i] : L4[2 + i]; L2[i] = ml + shx32_u(sl, b5); }
            const float hsc = 0.5f * swc;
            const float o0 = (float)(2 * (int)L2[0] - 15 * sw) * hsc, o1 = (float)((((int)T2[0] - (int)L2[0]) >> 3) + sw) * hsc;
            const float o2 = (float)(2 * (int)L2[1] - 15 * sw) * hsc, o3 = (float)((((int)T2[1] - (int)L2[1]) >> 3) + sw) * hsc;
            { v2u xn; xn.x = pk2(bflo(xo.x) + gt2[0] * o0, bfhi(xo.x) + gt2[1] * o1); xn.y = pk2(bflo(xo.y) + gt2[2] * o2, bfhi(xo.y) + gt2[3] * o3);
              *(v2u*)(Xw + (((size_t)t * DM + colb) >> 1)) = xn; }
            G2_MAKE_W(1 - buf, swn);
            swc = swn;
            buf = 1 - buf; r = r1; t = tn;
        }
#undef G2_LOAD_W
#undef G2_MAKE_W
#undef G2_GLOAD
#undef G2_LWRITE
        LDS_WAIT(); asm volatile("" ::: "memory");
    }
}

constexpr int SPL = 11;
constexpr int NSTEPS = 2 + SPL * DEPTH;
#ifndef DIS
#define DIS 0
#endif
#ifndef ZB
#define ZB 0
#endif
#define EN(n) (!((DIS >> (n)) & 1))
__device__ __forceinline__ bool run_step(Frame& F, KArgs A, int step, bool dry) {
    unsigned char* ws = ws_;
    bf16* X = (bf16*)(ws + WS_X); const float* MOD = (const float*)(ws + WS_MOD);
    bf16* H = (bf16*)(ws + WS_H);
    if (step == 0) { if (EN(0)) op_prep(F, A); return true; }
    if (step == 1) { if (EN(1)) op_modulate(F, A, A->in[I_X], A->in[I_CTX], nullptr, A->in[I_N1G], MOD, 0, NTOK, false); }
    const int layer = (step - 2) / SPL, k = (step - 2) % SPL, kind = layer % 3, jj = layer / 3;
    const int nrows = (layer == DEPTH - 1) ? NLAT : NTOK, nM = nrows / 256;
    const float* modl = MOD + (size_t)layer * 9 * MODW;
    if (k == 1) { if (kind == 0) { if (EN(4)) op_spatial(F, A, jj, nrows); } else if (kind == 1) { if (EN(5)) op_pool(F, A, nrows); } else { if (EN(6)) op_qknorm(F, A, nrows); } return true; }
    if (k == 2 && kind != 2) return false;
    if (k == 2 && kind == 2) { if (EN(8)) op_attn(F, A); return true; }
    if (k == 4) { if (EN(10)) op_modulate(F, A, nullptr, nullptr, X, A->in[I_N2G] + layer * DM, modl, 3, nrows, false, true); return true; }
    if (k == 7) { if (EN(13)) op_topk(F, A, layer, nrows); return true; }
    if (k == 8) { if (EN(14)) op_gather_u(F, A, layer, nrows, dry); return true; }
    if (k == 9) { if (EN(14)) op_gather_v(F, A, layer, nrows, dry); return true; }
    if (k == 10) {
        if (layer == DEPTH - 1) op_modulate(F, A, nullptr, nullptr, X, A->in[I_FINAL_G], modl, 0, NLAT, true);
        else op_modulate(F, A, nullptr, nullptr, X, A->in[I_N1G] + (layer + 1) * DM, modl + 9 * MODW, 0, (layer == DEPTH - 2) ? NLAT : NTOK, false);
        return true; }
    if (k == 6) return false;
    const int nrep = ((k == 0 && kind == 0) || k < 0) ? 2 : 1;
    for (int rep = 0; rep < nrep; ++rep) {
        pg8::Gemm g; pg8::EpiAny E;
        g.A = H; g.lda = DM; g.K = DM; g.nM = nM; g.nN = 4; g.a_pm = 256 * DM; g.a_pn = 0; g.Bt = H; g.ldb = DM; g.b_pm = 0; g.b_pn = 256 * DM;
        E.type = 0; E.perm = true; E.O = (void*)(ws + WS_Z); E.ldc = DM; E.act = 0; E.mul = nullptr; E.o_pm = 0; E.o_pn = 256;
        E.srcLat = nullptr; E.srcCtx = nullptr; E.X = (void*)X; E.Xsrc = (const void*)X; E.modl = modl; E.nlat = NLAT; E.chunk = 2; E.SS = (float*)(ws + WS_SS); if (dry) E.X = (void*)(ws + WS_Z); E.gs = ((ZB >> kind) & 1) ? 0.f : 1.f;
        if (k < 0) {
            g.A = (const bf16*)(ws + WS_KB); g.lda = 256; g.K = 256; g.nM = DEPTH * 8; g.nN = 4; g.a_pm = 65536; g.a_pn = 0;
            g.Bt = (const bf16*)(ws + WS_G); g.ldb = 256; g.b_pm = 1024 * 256; g.b_pn = 65536;
            E.O = (void*)(ws + WS_WPQ); E.ldc = DM;
            if (rep) {
                g.A = (const bf16*)(ws + WS_WGRP); g.nM = 4; g.Bt = (const bf16*)(ws + WS_G + 16 * MiB); E.O = (void*)(ws + WS_WPOOLIN); }
        } else if (k == 0) {
            if (kind == 0 && rep == 0) { g.Bt = (const bf16*)(ws + WS_WSGUIN) + (size_t)jj * 4096 * 1024; g.nN = 8; E.ldc = SGUW; E.act = 1; }
            else if (kind == 0) {
                g.A = (const bf16*)(ws + WS_WSGUIN) + (size_t)jj * 4096 * 1024 + (size_t)2048 * 1024; g.nM = 8; g.nN = nM; g.Bt = H;
                E.type = 3; E.O = (void*)((bf16*)(ws + WS_Z) + (size_t)NTOK * SGUW); E.ldc = NTOK; }
            else if (kind == 1) { g.Bt = (const bf16*)(ws + WS_WPOOLIN); g.nN = 4; E.ldc = DM; }
            else { g.Bt = (const bf16*)(ws + WS_WQKV); g.nN = 6; E.ldc = 1536; }
        } else if (k == 2) {
            g.A = (const bf16*)(ws + WS_G); g.K = 256; g.a_pn = 256; g.Bt = (const bf16*)(ws + WS_WGRP); g.ldb = 256; g.b_pn = 65536;
            E.O = (void*)H; E.ldc = DM; E.mul = A->in[I_POOL_SCALE];
        } else if (k == 3) {
            if (kind == 0) { g.A = (const bf16*)(ws + WS_G); g.lda = SGUW; g.K = SGUW; g.Bt = (const bf16*)(ws + WS_WSGUOUT) + (size_t)jj * 1024 * 2048; }
            else if (kind == 1) { g.Bt = (const bf16*)(ws + WS_WPOOLOUT); }
            else { g.Bt = (const bf16*)(ws + WS_WO); }
            g.ldb = g.K; g.a_pm = 256 * (long)g.lda; g.b_pn = 256 * (long)g.ldb;
            E.type = 2; E.perm = true; E.srcLat = layer == 0 ? A->in[I_X] : nullptr; E.srcCtx = layer == 0 ? A->in[I_CTX] : nullptr;
        } else {
            g.nN = 8; g.Bt = (const bf16*)(ws + WS_WPQ) + (size_t)layer * 2048 * 1024; E.act = 2; E.O = (void*)(ws + WS_Z); E.ldc = 2048;
        }
        E.o_pm = 256 * (long)E.ldc;
        pg8::StaticOrder S; S.init(g.nM, g.nN, F.G, F.bx);
        if (EN(2)) pg8::gemm_phase<true>(F.lds, g, S, E, F.tid);
    }
    return true;
}

__global__ void __launch_bounds__(NWAVES * 64, 2) mega_fwd(Args args) {
    extern __shared__ __attribute__((aligned(16))) unsigned char lds[];
    for (int u = threadIdx.x; u < (LDS_BYTES - LDSCTL_OFF) / 4; u += NWAVES * 64) ((LAS unsigned*)((LAS unsigned char*)lds + LDSCTL_OFF))[u] = 0u;
    __syncthreads();
    { const unsigned hw = (unsigned)__builtin_amdgcn_s_getreg((5 << 11) | 4) & 63u;
      if ((threadIdx.x & 63) == 0) ((LAS unsigned*)((LAS unsigned char*)lds + WSLOT_OFF))[hw] = threadIdx.x >> 6; }
    const int lo = args.lo, hi = args.hi;
    if (hi - lo > 1 && threadIdx.x == 0) {
        const unsigned xcc = xb_xcc_id(); const unsigned rk = xb_add((unsigned*)(args.ws + WS_CTL) + CW_BAR + XB_XCNT(xcc), 1u);
        ((LAS unsigned*)((LAS unsigned char*)lds + MISC_OFF))[12] = rk; ((LAS unsigned*)((LAS unsigned char*)lds + MISC_OFF))[13] = xcc; }
    __syncthreads();
    for (int step = lo; step < hi; ++step) {
        KArgs kp = (KArgs)__builtin_amdgcn_kernarg_segment_ptr();
        asm volatile("" : "+s"(kp));
        int g_ = gridDim.x, bx_ = blockIdx.x; unsigned lo_ = 0;
        asm volatile("" : "+s"(g_), "+s"(bx_), "+s"(lo_));
        Frame F;
        F.lds = (LAS unsigned char*)lds + lo_;
        const unsigned hw = (unsigned)__builtin_amdgcn_s_getreg((5 << 11) | 4) & 63u;
        F.wave = __builtin_amdgcn_readfirstlane(((volatile LAS unsigned*)(F.lds + WSLOT_OFF))[hw]);
        F.lane = (int)__builtin_amdgcn_mbcnt_hi(~0u, __builtin_amdgcn_mbcnt_lo(~0u, 0u)); asm volatile("" : "+v"(F.lane));
        F.tid = F.wave * 64 + F.lane;
        F.G = g_; F.bx = bx_; F.vcu = (g_ % 8 == 0) ? (bx_ % 8) * (g_ / 8) + bx_ / 8 : bx_;
        const int kcls = step < 2 ? 11 + step : (step - 2) % SPL;
        bool dry = ((REPK >> kcls) & 1) != 0 && (step < 2 || ((REPL >> ((step - 2) / SPL)) & 1));
        bool did = run_step(F, kp, step, dry);
        if (dry) {
            XcdBarrier bar; bar.bar = (unsigned*)(kp->ws + WS_CTL) + CW_BAR; bar.x = xb_xcc_id(); bar.st = (volatile LAS unsigned*)(F.lds + MISC_OFF) + 8;
            if (did) xcd_barrier(bar, F.tid);
            did = run_step(F, kp, step, false);
        }
        if (did && step + 1 < hi) {
            XcdBarrier bar; bar.bar = (unsigned*)(kp->ws + WS_CTL) + CW_BAR; bar.x = xb_xcc_id(); bar.st = (volatile LAS unsigned*)(F.lds + MISC_OFF) + 8;
            xcd_barrier(bar, F.tid);
        }
    }
}

extern "C" void kernel_launch(void* const* d_in, const int* in_sizes, int n_in, void* d_out, int out_size, void* d_ws, size_t ws_size, hipStream_t stream) {
    static int grid = 0;
    if (grid == 0) {
        if (n_in != N_IN || out_size != NLAT * DM || ws_size < WS_END) { fprintf(stderr, "kernel_launch: unexpected shapes: n_in %d out %d ws %zu (need >= %zu)\n", n_in, out_size, ws_size, (size_t)WS_END); grid = -1; return; }
        int dev = 0, cus = 0, per_cu = 0;
        if (hipGetDevice(&dev) != hipSuccess || hipDeviceGetAttribute(&cus, hipDeviceAttributeMultiprocessorCount, dev) != hipSuccess) { grid = -1; return; }
        if (hipFuncSetAttribute((const void*)mega_fwd, hipFuncAttributeMaxDynamicSharedMemorySize, LDS_BYTES) != hipSuccess) { fprintf(stderr, "kernel_launch: hipFuncSetAttribute failed\n"); grid = -1; return; }
        if (hipOccupancyMaxActiveBlocksPerMultiprocessor(&per_cu, (const void*)mega_fwd, NWAVES * 64, LDS_BYTES) != hipSuccess || per_cu < 1) { fprintf(stderr, "kernel_launch: occupancy query says %d\n", per_cu); (void)hipGetLastError(); grid = -1; return; }
        grid = cus;
    }
    if (grid < 0) return;
    (void)hipMemsetAsync((char*)d_ws + WS_CTL, 0, CTL_ZERO_BYTES, stream);
    Args a{};
    for (int i = 0; i < N_IN; ++i) a.in[i] = (const float*)d_in[i];
    a.out = (float*)d_out; a.ws = (unsigned char*)d_ws;
#if MK_MULTI
    for (int s = 0; s < NSTEPS; ++s) { a.lo = s; a.hi = s + 1; hipLaunchKernelGGL(mega_fwd, dim3(grid), dim3(NWAVES * 64), LDS_BYTES, stream, a); }
#else
    a.lo = 0; a.hi = NSTEPS;
    void* kargs[] = {&a};
    hipError_t e = hipLaunchCooperativeKernel((const void*)mega_fwd, dim3(grid), dim3(NWAVES * 64), kargs, LDS_BYTES, stream);
    if (e != hipSuccess) { fprintf(stderr, "kernel_launch: cooperative launch failed: %s\n", hipGetErrorString(e)); (void)hipGetLastError();
        hipLaunchKernelGGL(mega_fwd, dim3(grid), dim3(NWAVES * 64), LDS_BYTES, stream, a); }
#endif
}
```

```cpp
#include <hip/hip_runtime.h>
#include <hip/hip_bf16.h>
#include <cstdio>
#include <cstdint>

#ifndef MK_MULTI
#define MK_MULTI 0
#endif
#ifndef PEER_SCALE
#define PEER_SCALE 1.0f
#endif
#ifndef REPL
#define REPL 15
#endif
#ifndef PREPREP
#define PREPREP 0
#endif
#ifndef GVAR
#define GVAR 0
#endif
#ifndef EMASK
#define EMASK 0xffffffff
#endif
#ifndef REPK
#define REPK 0
#endif
#ifndef TOPK_REF
#define TOPK_REF 0
#endif
#ifndef GATHER_REF
#define GATHER_REF 0
#endif
#ifndef ZB
#define ZB 0
#endif

template <int M> __device__ __forceinline__ unsigned shx_u(unsigned v) {
    if (M == 1) return (unsigned)__builtin_amdgcn_mov_dpp((int)v, 0xB1, 0xf, 0xf, true);
    if (M == 2) return (unsigned)__builtin_amdgcn_mov_dpp((int)v, 0x4E, 0xf, 0xf, true);
    if (M == 8) return (unsigned)__builtin_amdgcn_mov_dpp((int)v, 0x128, 0xf, 0xf, true);
    return (unsigned)__builtin_amdgcn_ds_swizzle((int)v, (M << 10) | 0x1f);
}
template <int M> __device__ __forceinline__ float shx(float v) { return __uint_as_float(shx_u<M>(__float_as_uint(v))); }
__device__ __forceinline__ unsigned shx32_u(unsigned v, bool upper) {
    auto r = __builtin_amdgcn_permlane32_swap(v, v, false, false); return upper ? r[0] : r[1]; }
__device__ __forceinline__ float shx32(float v, bool upper) { return __uint_as_float(shx32_u(__float_as_uint(v), upper)); }
__device__ __forceinline__ float bperm(int srcLane, float v) { return __uint_as_float((unsigned)__builtin_amdgcn_ds_bpermute(srcLane << 2, (int)__float_as_uint(v))); }
__device__ __forceinline__ int bperm_i(int srcLane, int v) { return __builtin_amdgcn_ds_bpermute(srcLane << 2, v); }
namespace pg8 {
#define PG8_LAS __attribute__((address_space(3)))
typedef unsigned short bf16_t;
typedef short bf16x8 __attribute__((ext_vector_type(8)));
typedef float f32x4 __attribute__((ext_vector_type(4)));
typedef float f32x2 __attribute__((ext_vector_type(2)));
typedef unsigned u32x4 __attribute__((ext_vector_type(4)));
typedef unsigned u32x2 __attribute__((ext_vector_type(2)));
constexpr int BM = 256, BK = 64, HALF = 128, HTB = HALF * BK * 2, STAGE_BYTES = 8 * HTB, NXCD = 8, WGM = 8;

__host__ __device__ __forceinline__ int lds_byte(int r, int c) { const int st = (r >> 4) * 2 + (c >> 5), rr = r & 15, cc = c & 31, ob = rr * 64 + cc * 2; return st * 1024 + (ob ^ (((ob >> 9) & 1) << 5)); }
__host__ __device__ __forceinline__ void stage_rc(int b, int& R, int& C) { const int st = b / 1024, sb = b % 1024, swz = sb ^ (((sb >> 9) & 1) << 5); R = (st >> 1) * 16 + swz / 64; C = (st & 1) * 32 + (swz % 64) / 2; }
__host__ __device__ __forceinline__ int perm32(int rho) { const int n = rho >> 4, i = rho & 15; return 8 * (i >> 2) + 4 * n + (i & 3); }

struct Unit { int pm, pn; };
struct Gemm { const bf16_t* A; const bf16_t* Bt; int lda, ldb, K, nM, nN; long a_pm, a_pn, b_pm, b_pn; };

struct StaticOrder {
    int nM, nN, nwg, G, c;
    __host__ __device__ void init(int nM_, int nN_, int G_, int c_) { nM = nM_; nN = nN_; nwg = nM * nN; G = G_; c = c_; }
    __host__ __device__ bool next(int i, Unit& u) const {
        const long L = (long)i * G + c; if (L >= nwg) return false;
        int wgid = (int)L; { const int q = nwg / NXCD, r = nwg % NXCD, xcd = wgid % NXCD, off = wgid / NXCD; wgid = (xcd < r ? xcd * (q + 1) : r * (q + 1) + (xcd - r) * q) + off; }
        const int nig = WGM * nN, gid = wgid / nig, fm = gid * WGM, gsz = (nM - fm) < WGM ? (nM - fm) : WGM;
        u.pm = fm + ((wgid % nig) % gsz); u.pn = (wgid % nig) / gsz; return true;
    }
};

__device__ __forceinline__ unsigned cvt_pk_bf16(float lo, float hi) { unsigned r; asm volatile("v_cvt_pk_bf16_f32 %0, %1, %2" : "=v"(r) : "v"(lo), "v"(hi)); return r; }
__device__ __forceinline__ f32x2 gelu_pk(f32x2 v) {
    const f32x2 av = __builtin_elementwise_abs(v), d = av * 0.2316418882f + 1.0f;
    f32x2 t; t.x = __builtin_amdgcn_rcpf(d.x); t.y = __builtin_amdgcn_rcpf(d.y);
    f32x2 q = t * 0.5307027145f + (-0.7265760135f); q = q * t + 0.7107068705f; q = q * t + (-0.142248368f); q = q * t + 0.127414796f; q = q * t;
    const f32x2 s = (v * v) * (-0.72134752044f);
    f32x2 e; e.x = __builtin_amdgcn_exp2f(s.x); e.y = __builtin_amdgcn_exp2f(s.y);
    const f32x2 m = v * (q * e), r = v - m;
    f32x2 o; o.x = v.x < 0.f ? m.x : r.x; o.y = v.y < 0.f ? m.y : r.y; return o;
}
__device__ __forceinline__ float gelu1(float v) { f32x2 r = gelu_pk((f32x2){v, v}); return r.x; }
__device__ __forceinline__ f32x4 gelu4(f32x4 v) { f32x2 a = gelu_pk((f32x2){v[0], v[1]}), b = gelu_pk((f32x2){v[2], v[3]}); return (f32x4){a.x, a.y, b.x, b.y}; }

struct EpiAny {
    int type;
    bool perm;
    void* O; int ldc; int act; const float* mul; long o_pm, o_pn;
    const float* srcLat; const float* srcCtx; void* X; const void* Xsrc; const float* modl; int nlat; int chunk;
    float* SS;
    float gs;
    __device__ __forceinline__ void bf16_store(const f32x4 (&acc)[2][2][4][2], const Unit& u, int wr, int wc, int fr, int fq) const {
        bf16_t* base = (bf16_t*)O + u.pm * o_pm + u.pn * o_pn;
        const int row0 = wr * 64 + fr, col0 = wc * 32 + 8 * fq;
        f32x4 mv[2][2];
#pragma unroll
        for (int bj = 0; bj < 2; ++bj)
#pragma unroll
            for (int n = 0; n < 2; ++n) mv[bj][n] = mul ? *(const f32x4*)(mul + u.pn * BM + col0 + bj * HALF + 4 * n) : (f32x4){1.f, 1.f, 1.f, 1.f};
#pragma unroll
        for (int ai = 0; ai < 2; ++ai)
#pragma unroll
            for (int m = 0; m < 4; ++m) { bf16_t* rowp = base + (size_t)(row0 + ai * HALF + m * 16) * ldc + col0;
#pragma unroll
                for (int bj = 0; bj < 2; ++bj) { f32x4 v0 = acc[ai][bj][m][0], v1 = acc[ai][bj][m][1];
                    if (act == 1) { v0 = gelu4(v0); v1 = gelu4(v1); }
                    v0 = v0 * mv[bj][0]; v1 = v1 * mv[bj][1];
                    u32x4 w;
                    if (act == 2) {
                        w.x = __builtin_bit_cast(unsigned, __builtin_amdgcn_cvt_pkrtz(v0[0], v0[1])); w.y = __builtin_bit_cast(unsigned, __builtin_amdgcn_cvt_pkrtz(v0[2], v0[3]));
                        w.z = __builtin_bit_cast(unsigned, __builtin_amdgcn_cvt_pkrtz(v1[0], v1[1])); w.w = __builtin_bit_cast(unsigned, __builtin_amdgcn_cvt_pkrtz(v1[2], v1[3]));
                    } else { w.x = cvt_pk_bf16(v0[0], v0[1]); w.y = cvt_pk_bf16(v0[2], v0[3]); w.z = cvt_pk_bf16(v1[0], v1[1]); w.w = cvt_pk_bf16(v1[2], v1[3]); }
                    *(u32x4*)(rowp + bj * HALF) = w; } }
    }
    __device__ __forceinline__ void f32_store(const f32x4 (&acc)[2][2][4][2], const Unit& u, int wr, int wc, int fr, int fq) const {
        float* C = (float*)O;
        const int row0 = u.pm * BM + wr * 64 + fr, col0 = u.pn * BM + wc * 32 + 4 * fq;
#pragma unroll
        for (int ai = 0; ai < 2; ++ai)
#pragma unroll
            for (int m = 0; m < 4; ++m) { float* rowp = C + (size_t)(row0 + ai * HALF + m * 16) * ldc + col0;
#pragma unroll
                for (int bj = 0; bj < 2; ++bj)
#pragma unroll
                    for (int n = 0; n < 2; ++n) *(f32x4*)(rowp + bj * HALF + n * 16) = acc[ai][bj][m][n]; }
    }
    __device__ __forceinline__ void resid(const f32x4 (&acc)[2][2][4][2], const Unit& u, int wr, int wc, int fr, int fq) const {
        const int rowt = u.pm * BM; const int mr = rowt < nlat ? (rowt >> 11) : 8;
        const float* gp = modl + mr * 6144 + chunk * 1024;
        bf16_t* xp = (bf16_t*)X + (size_t)rowt * 1024;
        const int row0 = wr * 64 + fr, col0 = u.pn * BM + wc * 32 + 8 * fq;
        f32x4 gv[2][2];
#pragma unroll
        for (int bj = 0; bj < 2; ++bj)
#pragma unroll
            for (int n = 0; n < 2; ++n) gv[bj][n] = *(const f32x4*)(gp + col0 + bj * HALF + n * 4) * gs;
        if (srcLat) {
            const float* sp = rowt < nlat ? srcLat + (size_t)rowt * 1024 : srcCtx + (size_t)(rowt - nlat) * 1024;
#pragma unroll
            for (int ai = 0; ai < 2; ++ai)
#pragma unroll
                for (int m = 0; m < 4; ++m) { const size_t off = (size_t)(row0 + ai * HALF + m * 16) * 1024 + col0;
#pragma unroll
                    for (int bj = 0; bj < 2; ++bj) { const f32x4 s0 = *(const f32x4*)(sp + off + bj * HALF), s1 = *(const f32x4*)(sp + off + bj * HALF + 4);
                        const f32x4 y0 = s0 + gv[bj][0] * acc[ai][bj][m][0], y1 = s1 + gv[bj][1] * acc[ai][bj][m][1];
                        u32x4 w; w.x = cvt_pk_bf16(y0[0], y0[1]); w.y = cvt_pk_bf16(y0[2], y0[3]); w.z = cvt_pk_bf16(y1[0], y1[1]); w.w = cvt_pk_bf16(y1[2], y1[3]);
                        *(u32x4*)(xp + off + bj * HALF) = w; }
                    if (m & 1) asm volatile("" ::: "memory"); }
        } else {
            const bf16_t* sp = (const bf16_t*)Xsrc + (size_t)rowt * 1024;
#pragma unroll
            for (int ai = 0; ai < 2; ++ai)
#pragma unroll
                for (int m = 0; m < 4; ++m) { const size_t off = (size_t)(row0 + ai * HALF + m * 16) * 1024 + col0;
#pragma unroll
                    for (int bj = 0; bj < 2; ++bj) { const u32x4 sv = *(const u32x4*)(sp + off + bj * HALF);
                        const f32x4 s0 = {__uint_as_float(sv.x << 16), __uint_as_float(sv.x & 0xffff0000u), __uint_as_float(sv.y << 16), __uint_as_float(sv.y & 0xffff0000u)};
                        const f32x4 s1 = {__uint_as_float(sv.z << 16), __uint_as_float(sv.z & 0xffff0000u), __uint_as_float(sv.w << 16), __uint_as_float(sv.w & 0xffff0000u)};
                        const f32x4 y0 = s0 + gv[bj][0] * acc[ai][bj][m][0], y1 = s1 + gv[bj][1] * acc[ai][bj][m][1];
                        u32x4 w; w.x = cvt_pk_bf16(y0[0], y0[1]); w.y = cvt_pk_bf16(y0[2], y0[3]); w.z = cvt_pk_bf16(y1[0], y1[1]); w.w = cvt_pk_bf16(y1[2], y1[3]);
                        *(u32x4*)(xp + off + bj * HALF) = w; }
                    if (m & 1) asm volatile("" ::: "memory"); }
        }
    }
    __device__ __forceinline__ void swapv(const f32x4 (&acc)[2][2][4][2], const Unit& u, int wr, int wc, int fr, int fq) const {
        bf16_t* base = (bf16_t*)O + (size_t)u.pm * BM * ldc + (size_t)u.pn * BM;
        const int row0 = wr * 64 + fr, col0 = wc * 32 + 8 * fq;
        float cs[16];
#pragma unroll
        for (int i = 0; i < 16; ++i) cs[i] = 0.f;
#pragma unroll
        for (int ai = 0; ai < 2; ++ai)
#pragma unroll
            for (int m = 0; m < 4; ++m) { bf16_t* rowp = base + (size_t)(row0 + ai * HALF + m * 16) * ldc + col0;
#pragma unroll
                for (int bj = 0; bj < 2; ++bj) { const f32x4 v0 = gelu4(acc[ai][bj][m][0]), v1 = gelu4(acc[ai][bj][m][1]);
#pragma unroll
                    for (int e = 0; e < 4; ++e) { cs[bj * 8 + e] += v0[e] * v0[e]; cs[bj * 8 + 4 + e] += v1[e] * v1[e]; }
                    u32x4 w; w.x = cvt_pk_bf16(v0[0], v0[1]); w.y = cvt_pk_bf16(v0[2], v0[3]); w.z = cvt_pk_bf16(v1[0], v1[1]); w.w = cvt_pk_bf16(v1[2], v1[3]);
                    *(u32x4*)(rowp + bj * HALF) = w; } }
        const bool b3 = fr & 8, b2 = fr & 4, b1 = fr & 2, b0 = fr & 1;
        float d[8], e4[4], f2[2];
#pragma unroll
        for (int i = 0; i < 8; ++i) { const float mine = b3 ? cs[8 + i] : cs[i], send = b3 ? cs[i] : cs[8 + i]; d[i] = mine + shx<8>(send); }
#pragma unroll
        for (int i = 0; i < 4; ++i) { const float mine = b2 ? d[4 + i] : d[i], send = b2 ? d[i] : d[4 + i]; e4[i] = mine + shx<4>(send); }
#pragma unroll
        for (int i = 0; i < 2; ++i) { const float mine = b1 ? e4[2 + i] : e4[i], send = b1 ? e4[i] : e4[2 + i]; f2[i] = mine + shx<2>(send); }
        const float tot = (b0 ? f2[1] : f2[0]) + shx<1>(b0 ? f2[0] : f2[1]);
        const int ci = fr;
        const int col = u.pn * BM + (ci >> 3) * HALF + wc * 32 + 8 * fq + (ci & 7);
        SS[(size_t)(u.pm * 2 + wr) * ldc + col] = tot;
    }
    __device__ __forceinline__ void operator()(const f32x4 (&acc)[2][2][4][2], const Unit& u, int wr, int wc, int fr, int fq) const {
        if (type == 0) bf16_store(acc, u, wr, wc, fr, fq);
        else if (type == 1) f32_store(acc, u, wr, wc, fr, fq);
        else if (type == 2) resid(acc, u, wr, wc, fr, fq);
        else swapv(acc, u, wr, wc, fr, fq);
    }
};

template <bool ALIGN_EPI = true>
__device__ __forceinline__ void gemm_phase(PG8_LAS unsigned char* lds, const Gemm g, const StaticOrder& S, const EpiAny& E, const int tid) {
    const int wid = __builtin_amdgcn_readfirstlane(tid >> 6), lane = tid & 63, wr = wid >> 2, wc = wid & 3, fr = lane & 15, fq = lane >> 4;
    const int nt = g.K / BK;
    unsigned voffA[2], voffB[2];
#pragma unroll
    for (int i = 0; i < 2; ++i) { int R, C; stage_rc(tid * 16 + i * 8192, R, C); const int Rb = E.perm ? ((R & ~31) + perm32(R & 31)) : R;
        voffA[i] = (unsigned)(R * g.lda + C) * 2u; voffB[i] = (unsigned)(Rb * g.ldb + C) * 2u; }
    const size_t kstep = (size_t)(BK * 2);
    const size_t hA = (size_t)HALF * g.lda * 2, hB = (size_t)HALF * g.ldb * 2;
    const unsigned ldsw = (unsigned)wid * 1024u;
    const int aoff = lds_byte(wr * 64 + fr, fq * 8), boff = lds_byte(wc * 32 + fr, fq * 8);
#define PG8_SA(b, h) (((b) * 2 + (h)) * HTB)
#define PG8_SB(b, h) ((4 + (b) * 2 + (h)) * HTB)
#define PG8_STAGE(bufoff, gbase, voff) do { _Pragma("unroll") for (int _i = 0; _i < 2; ++_i) \
        __builtin_amdgcn_global_load_lds((const unsigned*)((const char*)(gbase) + (voff)[_i]), (PG8_LAS unsigned*)(lds + (bufoff) + ldsw + _i * 8192), 16, 0, 0); } while (0)
#define PG8_LDA(dst, b, h) do { _Pragma("unroll") for (int m = 0; m < 4; ++m) _Pragma("unroll") for (int k = 0; k < 2; ++k) dst[m][k] = *(const PG8_LAS bf16x8*)(lds + PG8_SA(b, h) + aoff + m * 2048 + k * 1024); } while (0)
#define PG8_LDB(dst, b, h) do { _Pragma("unroll") for (int n = 0; n < 2; ++n) _Pragma("unroll") for (int k = 0; k < 2; ++k) dst[n][k] = *(const PG8_LAS bf16x8*)(lds + PG8_SB(b, h) + boff + n * 2048 + k * 1024); } while (0)
#define PG8_MMA(ai, bj, At, Bt) do { __builtin_amdgcn_s_setprio(1); _Pragma("unroll") for (int m = 0; m < 4; ++m) _Pragma("unroll") for (int n = 0; n < 2; ++n) _Pragma("unroll") for (int k = 0; k < 2; ++k) \
        acc[ai][bj][m][n] = __builtin_amdgcn_mfma_f32_16x16x32_bf16(Bt[n][k], At[m][k], acc[ai][bj][m][n], 0, 0, 0); __builtin_amdgcn_s_setprio(0); } while (0)
#define PG8_WAIT_V(n) asm volatile("s_waitcnt vmcnt(" #n ")" ::: "memory")
#define PG8_WAIT_L(n) asm volatile("s_waitcnt lgkmcnt(" #n ")" ::: "memory")
#define PG8_BAR __builtin_amdgcn_s_barrier()
#define PG8_SCHED __builtin_amdgcn_sched_barrier(0)
#define PG8_PA(u) ((const char*)g.A + 2 * ((long)(u).pm * g.a_pm + (long)(u).pn * g.a_pn))
#define PG8_PB(u) ((const char*)g.Bt + 2 * ((long)(u).pm * g.b_pm + (long)(u).pn * g.b_pn))
    Unit cur, nxt; int ui = 0;
    if (!S.next(0, cur)) return;
    f32x4 acc[2][2][4][2];
#pragma unroll
    for (int a = 0; a < 2; ++a)
#pragma unroll
        for (int b = 0; b < 2; ++b)
#pragma unroll
            for (int m = 0; m < 4; ++m)
#pragma unroll
                for (int n = 0; n < 2; ++n) acc[a][b][m][n] = (f32x4){0.f, 0.f, 0.f, 0.f};
    bf16x8 At[4][2], B0[2][2], B1[2][2];
    const char* cA = PG8_PA(cur); const char* cB = PG8_PB(cur);
    PG8_STAGE(PG8_SB(0, 0), cB, voffB); PG8_STAGE(PG8_SB(0, 1), cB + hB, voffB); PG8_STAGE(PG8_SA(0, 0), cA, voffA); PG8_STAGE(PG8_SA(0, 1), cA + hA, voffA);
    if (wr == 1) PG8_BAR;
    PG8_WAIT_V(2); PG8_BAR;
    PG8_STAGE(PG8_SB(1, 0), cB + kstep, voffB); PG8_STAGE(PG8_SA(1, 0), cA + kstep, voffA); PG8_STAGE(PG8_SB(1, 1), cB + hB + kstep, voffB);
    PG8_WAIT_V(6); PG8_BAR;
    for (;;) {
        const bool has_next = S.next(ui + 1, nxt);
        const char* nA = has_next ? PG8_PA(nxt) : cA; const char* nB = has_next ? PG8_PB(nxt) : cB;
        for (int t = 0; t < nt; t += 2) {
            const bool last = (t == nt - 2);
            const char* a1 = cA + (size_t)(t + 1) * kstep;
            const char* a2 = last ? nA : cA + (size_t)(t + 2) * kstep; const char* b2 = last ? nB : cB + (size_t)(t + 2) * kstep;
            const char* a3 = a2 + kstep; const char* b3 = b2 + kstep;
            PG8_LDB(B0, 0, 0); PG8_LDB(B1, 0, 1); PG8_SCHED; PG8_LDA(At, 0, 0); PG8_STAGE(PG8_SA(1, 1), a1 + hA, voffA);
            PG8_WAIT_V(8); PG8_WAIT_L(0); PG8_BAR; PG8_MMA(0, 0, At, B0); PG8_MMA(0, 1, At, B1); PG8_BAR; PG8_SCHED;
            PG8_LDA(At, 0, 1); PG8_STAGE(PG8_SB(0, 0), b2, voffB); PG8_STAGE(PG8_SB(0, 1), b2 + hB, voffB); PG8_STAGE(PG8_SA(0, 0), a2, voffA);
            PG8_WAIT_V(8); PG8_WAIT_L(0); PG8_BAR; PG8_MMA(1, 0, At, B0); PG8_MMA(1, 1, At, B1); PG8_BAR; PG8_SCHED;
            PG8_LDB(B0, 1, 0); PG8_LDB(B1, 1, 1); PG8_SCHED; PG8_LDA(At, 1, 0); PG8_STAGE(PG8_SA(0, 1), a2 + hA, voffA);
            PG8_WAIT_V(8); PG8_WAIT_L(0); PG8_BAR; PG8_MMA(0, 0, At, B0); PG8_MMA(0, 1, At, B1); PG8_BAR; PG8_SCHED;
            PG8_LDA(At, 1, 1); PG8_STAGE(PG8_SB(1, 0), b3, voffB); PG8_STAGE(PG8_SB(1, 1), b3 + hB, voffB); PG8_STAGE(PG8_SA(1, 0), a3, voffA);
            PG8_WAIT_V(8); PG8_WAIT_L(0); PG8_BAR; PG8_MMA(1, 0, At, B0); PG8_MMA(1, 1, At, B1); PG8_BAR; PG8_SCHED;
        }
        if constexpr (ALIGN_EPI) { if (wr == 0) PG8_BAR; }
        { int el = (int)__builtin_amdgcn_mbcnt_hi(~0u, __builtin_amdgcn_mbcnt_lo(~0u, 0u)); asm volatile("" : "+v"(el));
          E(acc, cur, wr, wc, el & 15, el >> 4); }
        if (!has_next) break;
#pragma unroll
        for (int a = 0; a < 2; ++a)
#pragma unroll
            for (int b = 0; b < 2; ++b)
#pragma unroll
                for (int m = 0; m < 4; ++m)
#pragma unroll
                    for (int n = 0; n < 2; ++n) acc[a][b][m][n] = (f32x4){0.f, 0.f, 0.f, 0.f};
        cur = nxt; cA = nA; cB = nB; ++ui;
        if constexpr (ALIGN_EPI) { if (wr == 1) PG8_BAR; }
    }
    PG8_WAIT_V(0);
    if constexpr (!ALIGN_EPI) { if (wr == 0) PG8_BAR; }
    PG8_BAR;
#undef PG8_SA
#undef PG8_SB
#undef PG8_STAGE
#undef PG8_LDA
#undef PG8_LDB
#undef PG8_MMA
#undef PG8_WAIT_V
#undef PG8_WAIT_L
#undef PG8_BAR
#undef PG8_SCHED
#undef PG8_PA
#undef PG8_PB
}
}

namespace attn {
using bf16 = __hip_bfloat16;
constexpr int D = 128, NW = 8, QBLK = 32, KVBLK = 64;
constexpr float SCALE = 0.088388347648318440f;
constexpr float THR = 8.f;
constexpr int LDQ = 1024, LDK = 256, LDO = 1024;
constexpr size_t SHM_V = KVBLK * D * 2, SHM_K = KVBLK * D * 2, SHM_ATTN = 2 * SHM_V + 2 * SHM_K + NW * 64 * 4;
using bf16x8 = __attribute__((ext_vector_type(8))) short;
using s16x4  = __attribute__((ext_vector_type(4))) short;
using f32x16 = __attribute__((ext_vector_type(16))) float;
using u32x4  = __attribute__((ext_vector_type(4))) unsigned;
#define KSWZ(row, colB) ((row) * 256 + ((colB) ^ (((row) & 7) << 4)))
#define SBAR() __builtin_amdgcn_sched_barrier(0)
__device__ __forceinline__ int crow(int r, int hi) { return (r & 3) + 8 * (r >> 2) + 4 * hi; }
__device__ __forceinline__ unsigned cvtpk(float lo, float hi) { unsigned r; asm volatile("v_cvt_pk_bf16_f32 %0, %1, %2" : "=v"(r) : "v"(lo), "v"(hi)); return r; }
__device__ __forceinline__ void partialSM(f32x16& p0, f32x16& p1, float& m_reg, float& mn, float& alpha) {
  constexpr float C = SCALE * 1.4426950408889634f;
  float pmax = p0[0]; for (int r = 1; r < 16; ++r) pmax = fmaxf(pmax, p0[r]); for (int r = 0; r < 16; ++r) pmax = fmaxf(pmax, p1[r]);
  { auto rr = __builtin_amdgcn_permlane32_swap(__float_as_uint(pmax), __float_as_uint(pmax), false, false);
    pmax = fmaxf(__uint_as_float(rr[0]), __uint_as_float(rr[1])); }
  if (__builtin_expect(__all(pmax - m_reg <= THR / SCALE), 1)) { mn = m_reg; alpha = 1.f; }
  else { mn = fmaxf(m_reg, pmax); alpha = __builtin_amdgcn_exp2f((m_reg - mn) * C); m_reg = mn; }
  float mnC = -mn * C;
  for (int r = 0; r < 16; ++r) p0[r] = fmaf(p0[r], C, mnC); for (int r = 0; r < 16; ++r) p1[r] = fmaf(p1[r], C, mnC);
  for (int r = 0; r < 16; ++r) p0[r] = __builtin_amdgcn_exp2f(p0[r]);
}
__device__ __forceinline__ void finishSM(f32x16& p0, f32x16& p1, float alpha, float& l_reg, bf16x8& pa0, bf16x8& pa1, bf16x8& pa2, bf16x8& pa3) {
  for (int r = 0; r < 16; ++r) p1[r] = __builtin_amdgcn_exp2f(p1[r]);
  float ps = 0; for (int r = 0; r < 16; ++r) ps += p0[r]; for (int r = 0; r < 16; ++r) ps += p1[r];
  { auto rr = __builtin_amdgcn_permlane32_swap(__float_as_uint(ps), __float_as_uint(ps), false, false);
    ps = __uint_as_float(rr[0]) + __uint_as_float(rr[1]); }
  l_reg = l_reg * alpha + ps;
#define PK4(P, BASE, OUT) do { unsigned a0 = cvtpk(P[BASE + 0], P[BASE + 1]), a1 = cvtpk(P[BASE + 2], P[BASE + 3]);   \
    unsigned b0 = cvtpk(P[BASE + 4], P[BASE + 5]), b1 = cvtpk(P[BASE + 6], P[BASE + 7]);                              \
    auto r0 = __builtin_amdgcn_permlane32_swap(a0, b0, false, false); auto r1 = __builtin_amdgcn_permlane32_swap(a1, b1, false, false); \
    u32x4 w = {r0[0], r1[0], r0[1], r1[1]}; OUT = *reinterpret_cast<bf16x8*>(&w); } while (0)
  PK4(p0, 0, pa0); PK4(p0, 8, pa1); PK4(p1, 0, pa2); PK4(p1, 8, pa3);
#undef PK4
}
__device__ __forceinline__ void qkt(f32x16& p0, f32x16& p1, const bf16* Ks, const bf16x8* qr, int r32, int hi) {
  p0 = f32x16{}; p1 = f32x16{};
  for (int d0 = 0; d0 < 8; ++d0) { int cb = (d0 * 16 + hi * 8) * 2;
    bf16x8 b0 = *reinterpret_cast<const bf16x8*>((const char*)Ks + KSWZ(r32, cb));
    bf16x8 b1 = *reinterpret_cast<const bf16x8*>((const char*)Ks + KSWZ(32 + r32, cb));
    p0 = __builtin_amdgcn_mfma_f32_32x32x16_bf16(b0, qr[d0], p0, 0, 0, 0);
    p1 = __builtin_amdgcn_mfma_f32_32x32x16_bf16(b1, qr[d0], p1, 0, 0, 0); }
}
__device__ __forceinline__ int v_st(int k, int c) { const int kk = (k & ~0xC) | ((k & 4) << 1) | ((k & 8) >> 1); return ((kk >> 3) * 4 + (c >> 5)) * 512 + ((kk & 7) * 32 + (c & 31)) * 2; }
__device__ __forceinline__ int v_rd_base(int lane) { return ((lane & 3) << 3) | (((lane >> 2) & 3) << 6) | (((lane >> 4) & 1) << 5) | (((lane >> 5) & 1) << 8); }
constexpr int v_rd_off(int d0, int ks, int half) { return d0 * 512 + ks * 4096 + half * 2048; }
template <int OFF> __device__ __forceinline__ s16x4 tr_read(int vb) {
  s16x4 r; asm volatile("ds_read_b64_tr_b16 %0, %1 offset:%2" : "=&v"(r) : "v"(vb), "i"(OFF) : "memory"); return r;
}
template <int D0> __device__ __forceinline__ void pv_one(f32x16& od, int vb, bf16x8 pa0, bf16x8 pa1, bf16x8 pa2, bf16x8 pa3) {
  const s16x4 l0 = tr_read<v_rd_off(D0, 0, 0)>(vb), h0 = tr_read<v_rd_off(D0, 0, 1)>(vb), l1 = tr_read<v_rd_off(D0, 1, 0)>(vb), h1 = tr_read<v_rd_off(D0, 1, 1)>(vb);
  const s16x4 l2 = tr_read<v_rd_off(D0, 2, 0)>(vb), h2 = tr_read<v_rd_off(D0, 2, 1)>(vb), l3 = tr_read<v_rd_off(D0, 3, 0)>(vb), h3 = tr_read<v_rd_off(D0, 3, 1)>(vb);
  asm volatile("s_waitcnt lgkmcnt(0)" ::: "memory"); SBAR();
#define PK(L, H) (bf16x8){L[0], L[1], L[2], L[3], H[0], H[1], H[2], H[3]}
  od = __builtin_amdgcn_mfma_f32_32x32x16_bf16(pa0, PK(l0, h0), od, 0, 0, 0);
  od = __builtin_amdgcn_mfma_f32_32x32x16_bf16(pa1, PK(l1, h1), od, 0, 0, 0);
  od = __builtin_amdgcn_mfma_f32_32x32x16_bf16(pa2, PK(l2, h2), od, 0, 0, 0);
  od = __builtin_amdgcn_mfma_f32_32x32x16_bf16(pa3, PK(l3, h3), od, 0, 0, 0);
#undef PK
}
__device__ __forceinline__ void pv_d0(f32x16* o, int vb, bf16x8 pa0, bf16x8 pa1, bf16x8 pa2, bf16x8 pa3) {
  pv_one<0>(o[0], vb, pa0, pa1, pa2, pa3); pv_one<1>(o[1], vb, pa0, pa1, pa2, pa3); pv_one<2>(o[2], vb, pa0, pa1, pa2, pa3); pv_one<3>(o[3], vb, pa0, pa1, pa2, pa3);
}
__device__ __forceinline__ void attn_dense_body(const bf16* __restrict__ Qb, const bf16* __restrict__ Kh, const bf16* __restrict__ Vh,
                                                bf16* __restrict__ Ob, int seq, char* lds, const int tid) {
  const int wid = tid >> 6, lane = tid & 63, r32 = lane & 31, hi = lane >> 5;
  bf16* V_lds = (bf16*)lds; bf16* K_lds = (bf16*)(lds + 2 * SHM_V);
  float* ws = (float*)(lds + 2 * SHM_V + 2 * SHM_K) + wid * 64; float* li_l = ws; float* al_l = ws + 32;
  float m_reg = -1e30f, l_reg = 0; f32x16 o[4] = {}; bf16x8 qr[8];
  const bf16* Qw = Qb + (long)(wid * QBLK + r32) * LDQ + hi * 8;
#pragma unroll
  for (int d0 = 0; d0 < 8; ++d0) qr[d0] = *reinterpret_cast<const bf16x8*>(Qw + d0 * 16);
  const int sr = tid >> 4, sc = (tid & 15) * 8, vst0 = v_st(sr, sc), vst1 = v_st(32 + sr, sc);
  const int vb0 = (int)(uintptr_t)V_lds + v_rd_base(lane);
  struct { bf16x8 vs0, vs1, ks0, ks1; } sr_[1];
#define SLOAD(i, k0) do { sr_[i].vs0 = *reinterpret_cast<const bf16x8*>(&Vh[(long)((k0) + sr) * LDK + sc]); sr_[i].vs1 = *reinterpret_cast<const bf16x8*>(&Vh[(long)((k0) + 32 + sr) * LDK + sc]); \
    sr_[i].ks0 = *reinterpret_cast<const bf16x8*>(&Kh[(long)((k0) + sr) * LDK + sc]); sr_[i].ks1 = *reinterpret_cast<const bf16x8*>(&Kh[(long)((k0) + 32 + sr) * LDK + sc]); } while (0)
#define SWRITE(b, i) do { *(bf16x8*)((char*)V_lds + (b) * SHM_V + vst0) = sr_[i].vs0;          \
    *(bf16x8*)((char*)V_lds + (b) * SHM_V + vst1) = sr_[i].vs1; int kc = sc * 2;               \
    *(bf16x8*)((char*)K_lds + (b) * SHM_K + KSWZ(sr, kc)) = sr_[i].ks0;                       \
    *(bf16x8*)((char*)K_lds + (b) * SHM_K + KSWZ(32 + sr, kc)) = sr_[i].ks1; } while (0)
#define SWAIT() asm volatile("s_waitcnt vmcnt(0)" ::: "memory")
#define RESC(a) do { if (__any((a) < 1.f)) { if (hi == 0) al_l[r32] = (a); asm volatile("s_waitcnt lgkmcnt(0)" ::: "memory"); \
    for (int d = 0; d < 4; ++d) for (int r = 0; r < 16; ++r) o[d][r] *= al_l[crow(r, hi)]; } } while (0)
  f32x16 pA0, pA1, pB0, pB1; float mnA, mnB, alA, alB; bf16x8 pa0, pa1, pa2, pa3; const int NT = seq / KVBLK;
  constexpr int SE = 0, SO = 0;
  SLOAD(SE, 0); asm volatile("s_waitcnt vmcnt(0)" ::: "memory"); SWRITE(0, SE); __syncthreads();
  qkt(pA0, pA1, K_lds, qr, r32, hi); partialSM(pA0, pA1, m_reg, mnA, alA);
  SLOAD(SO, KVBLK);
  SWAIT(); SWRITE(1, SO); __syncthreads();
  for (int j = 1; j + 1 < NT; j += 2) {
    SBAR(); qkt(pB0, pB1, (bf16*)((char*)K_lds + SHM_K), qr, r32, hi);
    finishSM(pA0, pA1, alA, l_reg, pa0, pa1, pa2, pa3); SBAR();
    SLOAD(SO, (j + 1) * KVBLK); SBAR();
    pv_d0(o, vb0, pa0, pa1, pa2, pa3); partialSM(pB0, pB1, m_reg, mnB, alB);
    __syncthreads(); SWAIT(); SWRITE(0, SE);
    RESC(alB); __syncthreads();
    SBAR(); qkt(pA0, pA1, K_lds, qr, r32, hi);
    finishSM(pB0, pB1, alB, l_reg, pa0, pa1, pa2, pa3); SBAR();
    SLOAD(SE, (j + 2) * KVBLK); SBAR();
    pv_d0(o, vb0 + (int)SHM_V, pa0, pa1, pa2, pa3); partialSM(pA0, pA1, m_reg, mnA, alA);
    __syncthreads(); SWAIT(); SWRITE(1, SO);
    RESC(alA); __syncthreads();
  }
  SBAR(); qkt(pB0, pB1, (bf16*)((char*)K_lds + SHM_K), qr, r32, hi);
  finishSM(pA0, pA1, alA, l_reg, pa0, pa1, pa2, pa3); SBAR();
  pv_d0(o, vb0, pa0, pa1, pa2, pa3); partialSM(pB0, pB1, m_reg, mnB, alB);
  __syncthreads(); RESC(alB);
  finishSM(pB0, pB1, alB, l_reg, pa0, pa1, pa2, pa3); SBAR();
  pv_d0(o, vb0 + (int)SHM_V, pa0, pa1, pa2, pa3);
  if (hi == 0) li_l[r32] = l_reg; asm volatile("s_waitcnt lgkmcnt(0)" ::: "memory");
  float rli[16];
#pragma unroll
  for (int r = 0; r < 16; ++r) rli[r] = __builtin_amdgcn_rcpf(li_l[crow(r, hi)]);
  unsigned short* Ow = (unsigned short*)Ob + (long)(wid * QBLK) * LDO;
#pragma unroll
  for (int r = 0; r < 16; ++r) { int orow = crow(r, hi);
    for (int d0 = 0; d0 < 4; ++d0) { const unsigned pk = cvtpk(o[d0][r] * rli[r], 0.f); Ow[(long)orow * LDO + d0 * 32 + r32] = (unsigned short)(pk & 0xffffu); } }
  __syncthreads();
#undef SLOAD
#undef SWRITE
#undef SWAIT
#undef RESC
}
#undef KSWZ
#undef SBAR
}

constexpr int NWAVES = 8;
constexpr int DM = 1024, NB = 8, SEQ = 2048, CTXL = 256, NLAT = NB * SEQ, NCTX = NB * CTXL, NTOK = NLAT + NCTX;
constexpr int DEPTH = 4, MODW = 6 * DM;
constexpr float EPS = 1e-6f;
constexpr int SGUW = 2048, NEXP = 16384, KVROWS = SEQ + CTXL;

constexpr size_t MiB = 1u << 20;
constexpr size_t WS_CTL = 0, CTL_ZERO_BYTES = 1 * MiB;
constexpr size_t WS_MOD = 1 * MiB;
constexpr size_t WS_SS = 2 * MiB;
constexpr size_t WS_X = 4 * MiB;
constexpr size_t WS_H = 76 * MiB;
constexpr size_t WS_Z = 112 * MiB;
constexpr size_t WS_G = 256 * MiB;
constexpr size_t WS_SG = 328 * MiB;
constexpr size_t WS_WSGUIN = 346 * MiB;
constexpr size_t WS_WSGUOUT = 362 * MiB;
constexpr size_t WS_WPOOLIN = 370 * MiB, WS_WPOOLOUT = 372 * MiB, WS_WGRP = 374 * MiB, WS_WQKV = 375 * MiB, WS_WO = 378 * MiB;
constexpr size_t WS_WPQ = 380 * MiB;
constexpr size_t WS_KB = 396 * MiB;
constexpr size_t WS_TU = 400 * MiB;
constexpr size_t WS_TV = 464 * MiB;
constexpr size_t WS_SU = 528 * MiB, WS_SV = 529 * MiB;
constexpr size_t WS_IDX = 530 * MiB;
constexpr size_t WS_SHQ = 539 * MiB;
constexpr size_t WS_H8 = 540 * MiB;
constexpr size_t WS_END = 558 * MiB;
constexpr int CW_BAR = 4096;

constexpr int RING_BYTES = 131072;
constexpr int LDSCTL_OFF = RING_BYTES, MISC_OFF = LDSCTL_OFF + 320, WSLOT_OFF = LDSCTL_OFF + 1024;
constexpr int LDS_BYTES = 147456;

#define GAS __attribute__((address_space(1)))
#define LAS __attribute__((address_space(3)))
typedef unsigned short bf16;
typedef unsigned v4u __attribute__((ext_vector_type(4)));
typedef unsigned v2u __attribute__((ext_vector_type(2)));
typedef float f32x4 __attribute__((ext_vector_type(4)));
typedef short bf16x8 __attribute__((ext_vector_type(8)));
typedef __bf16 bf2 __attribute__((ext_vector_type(2)));
#define LDS_WAIT() asm volatile("s_waitcnt lgkmcnt(0)" ::: "memory")
__device__ __forceinline__ unsigned f2bf(float f) { unsigned u = __builtin_bit_cast(unsigned, f); return (u + 0x7fffu + ((u >> 16) & 1u)) >> 16; }
__device__ __forceinline__ unsigned pk2(float lo, float hi) { return pg8::cvt_pk_bf16(lo, hi); }
__device__ __forceinline__ float dot2bf(unsigned a, unsigned b, float c) { asm("v_dot2c_f32_bf16 %0, %1, %2" : "+v"(c) : "v"(a), "v"(b)); return c; }
typedef _Float16 h2_t __attribute__((ext_vector_type(2)));
__device__ __forceinline__ unsigned h2u(h2_t v) { return __builtin_bit_cast(unsigned, v); }
__device__ __forceinline__ h2_t u2h(unsigned v) { return __builtin_bit_cast(h2_t, v); }
__device__ __forceinline__ float bflo(unsigned u) { return __uint_as_float(u << 16); }
__device__ __forceinline__ float bfhi(unsigned u) { return __uint_as_float(u & 0xffff0000u); }

#define XB_TMO      128
#define XB_XCNT(j)  (256  + 64 * (j))
#define XB_XSUB(j)  (1280 + 64 * (j))
#define XB_XGEN(j)  (2304 + 64 * (j))
#define XB_TOP      3328
#define XB_TOPGEN   3392
#define XCD_BAR_WORDS 3456
#define XB_SPIN_CAP (1u << 22)
__device__ __forceinline__ unsigned xb_ld(unsigned* p)              { return __hip_atomic_load(p, __ATOMIC_RELAXED, __HIP_MEMORY_SCOPE_AGENT); }
__device__ __forceinline__ unsigned xb_add(unsigned* p, unsigned v) { return __hip_atomic_fetch_add(p, v, __ATOMIC_RELAXED, __HIP_MEMORY_SCOPE_AGENT); }
__device__ __forceinline__ unsigned xb_xcc_id() { return (unsigned)__builtin_amdgcn_s_getreg((3 << 11) | 20) & 0xFu; }
#define XB_SPIN(cond, bar) do { unsigned _sp = 0; while (cond) { __builtin_amdgcn_s_sleep(1); \
    if ((++_sp & 255u) == 0u) { if (xb_ld(&(bar)[XB_TMO])) break; if (_sp > XB_SPIN_CAP) { atomicAdd(&(bar)[XB_TMO], 1u); break; } } } } while (0)
struct XcdBarrier { unsigned* bar; unsigned x; volatile LAS unsigned* st; };
__device__ __forceinline__ XcdBarrier xcd_barrier_post(unsigned* bar, volatile LAS unsigned* st) {
    XcdBarrier b; b.bar = bar; b.x = xb_xcc_id(); b.st = st;
    if (threadIdx.x == 0) (void)xb_add(&bar[XB_XCNT(b.x)], 1u);
    return b;
}
__device__ __forceinline__ void xcd_barrier_complete(unsigned* bar, unsigned x, unsigned& nloc, unsigned& nx) {
    const unsigned G = gridDim.x * gridDim.y * gridDim.z;
    unsigned sum, cnt, mine, sp = 0u;
    for (;;) {
        sum = 0u; cnt = 0u; mine = 0u;
#pragma unroll
        for (unsigned j = 0; j < 16; ++j) { const unsigned c = xb_ld(&bar[XB_XCNT(j)]); sum += c; cnt += (c > 0u) ? 1u : 0u; mine = (j == x) ? c : mine; }
        if (sum == G) break;
        __builtin_amdgcn_s_sleep(1);
        if ((++sp & 255u) == 0u) { if (xb_ld(&bar[XB_TMO])) break; if (sp > XB_SPIN_CAP) { atomicAdd(&bar[XB_TMO], 1u); break; } }
    }
    nloc = mine > 0u ? mine : 1u; nx = cnt > 0u ? cnt : 1u;
}
__device__ __forceinline__ void xcd_barrier(const XcdBarrier& b, const int tid) {
    asm volatile("s_waitcnt vmcnt(0)" ::: "memory");
    __syncthreads();
    if (tid == 0) {
        unsigned* bar = b.bar;
        __builtin_amdgcn_s_waitcnt(0);
        unsigned nloc = b.st[0], nx = b.st[1];
        if (nloc == 0u) { xcd_barrier_complete(bar, b.x, nloc, nx); b.st[0] = nloc; b.st[1] = nx; }
        const unsigned old = xb_add(&bar[XB_XSUB(b.x)], 1u);
        const unsigned gen = old / nloc;
        if (old + 1u == (gen + 1u) * nloc) {
            __builtin_amdgcn_fence(__ATOMIC_RELEASE, "agent");
            asm volatile("s_waitcnt vmcnt(0)" ::: "memory");
            const unsigned og = xb_add(&bar[XB_TOP], 1u);
            const unsigned tg = og / nx;
            if (og + 1u == (tg + 1u) * nx) xb_add(&bar[XB_TOPGEN], 1u);
            else XB_SPIN(xb_ld(&bar[XB_TOPGEN]) == tg, bar);
            __builtin_amdgcn_fence(__ATOMIC_ACQUIRE, "agent");
            xb_add(&bar[XB_XGEN(b.x)], 1u);
            asm volatile("s_waitcnt vmcnt(0)" ::: "memory");
        } else {
            XB_SPIN(xb_ld(&bar[XB_XGEN(b.x)]) == gen, bar);
            __builtin_amdgcn_fence(__ATOMIC_ACQUIRE, "agent");
            asm volatile("s_waitcnt vmcnt(0)" ::: "memory");
        }
    }
    __syncthreads();
}

enum { I_X = 0, I_C, I_CTX, I_CCTX, I_ADAW, I_ADAB, I_N1G, I_N2G, I_SGU_WIN, I_SGU_VG, I_SGU_WS, I_SGU_BS, I_SGU_WOUT, I_POOL_WIN, I_POOL_WGRP, I_POOL_SCALE, I_POOL_WOUT,
       I_ATT_WQKV, I_ATT_QG, I_ATT_KG, I_ATT_WO, I_PEER_WQ, I_PEER_K1, I_PEER_K2, I_PEER_U, I_PEER_V, I_FINAL_G, N_IN };
struct Args { const float* in[N_IN]; float* out; unsigned char* ws; int lo, hi; };
typedef const __attribute__((address_space(4))) Args* KArgs;
#define ws_ (A->ws)

struct Frame {
    LAS unsigned char* lds;
    int tid, lane, wave, vcu, G, bx;
};

__device__ __forceinline__ float wave_sum(float v) {
    v += shx<1>(v); v += shx<2>(v); v += shx<4>(v); v += shx<8>(v); v += shx<16>(v);
    { auto r = __builtin_amdgcn_permlane32_swap(__float_as_uint(v), __float_as_uint(v), false, false); v = __uint_as_float(r[0]) + __uint_as_float(r[1]); }
    return v;
}

__device__ __forceinline__ void p0_transpose_item(const float* W, int K, int N, bf16* WT, LAS float* scr, int item, int lane) {
    const int nblk = N / 32, kb = item / nblk, nb = item % nblk, k0 = 64 * kb, n0 = 32 * nb;
#pragma unroll 8
    for (int i = 0; i < 32; ++i) { const int kk = 2 * i + (lane >> 5); scr[kk * 33 + (lane & 31)] = W[(size_t)(k0 + kk) * N + n0 + (lane & 31)]; }
    LDS_WAIT(); asm volatile("" ::: "memory");
    const int c = lane & 7;
#pragma unroll
    for (int j = 0; j < 4; ++j) { const int n = (lane >> 3) + 8 * j; const LAS float* s = scr + (8 * c) * 33 + n;
        v4u o; o.x = pk2(s[0 * 33], s[1 * 33]); o.y = pk2(s[2 * 33], s[3 * 33]); o.z = pk2(s[4 * 33], s[5 * 33]); o.w = pk2(s[6 * 33], s[7 * 33]);
        *(v4u*)(WT + (size_t)(n0 + n) * K + k0 + 8 * c) = o; }
    LDS_WAIT(); asm volatile("" ::: "memory");
}
__device__ __forceinline__ float silu(float v) { return v / (1.f + __expf(-v)); }

__device__ __forceinline__ void op_prep(Frame& F, KArgs A) {
    unsigned char* ws = ws_;
    for (int rep_ = 0; rep_ < 1 + ((PREPREP >> 0) & 1); ++rep_) {
        LAS float* S = (LAS float*)F.lds;
        LAS float* Pp = (LAS float*)(F.lds + 40960);
        for (int e = F.tid; e < 9 * 1024; e += NWAVES * 64) { const int r = e >> 10, k = e & 1023; S[e] = silu(r < 8 ? A->in[I_C][r * 1024 + k] : A->in[I_CCTX][k]); }
        __syncthreads();
        for (int task = F.vcu; task < DEPTH * 48; task += F.G) {
            const int i = task / 48, cg = task % 48, col = cg * 128 + 2 * F.lane;
            const float* W = A->in[I_ADAW] + (size_t)i * 1024 * MODW + col;
            float acc[9][2];
#pragma unroll
            for (int r = 0; r < 9; ++r) { acc[r][0] = 0.f; acc[r][1] = 0.f; }
            const int k0 = F.wave * 128;
#pragma unroll 8
            for (int k = k0; k < k0 + 128; ++k) { const pg8::f32x2 w = __builtin_nontemporal_load((const pg8::f32x2*)(W + (size_t)k * MODW));
#pragma unroll
                for (int r = 0; r < 9; ++r) { const float sv = S[r * 1024 + k]; acc[r][0] += sv * w.x; acc[r][1] += sv * w.y; } }
#pragma unroll
            for (int r = 0; r < 9; ++r) *(LAS pg8::f32x2*)(Pp + (F.wave * 9 + r) * 128 + 2 * F.lane) = (pg8::f32x2){acc[r][0], acc[r][1]};
            __syncthreads();
            for (int e = F.tid; e < 9 * 128; e += NWAVES * 64) { const int r = e >> 7, l = e & 127; float sacc = 0.f;
#pragma unroll
                for (int w = 0; w < 8; ++w) sacc += Pp[(w * 9 + r) * 128 + l];
                const int c2 = cg * 128 + l;
                ((float*)(ws + WS_MOD))[((size_t)i * 9 + r) * MODW + c2] = sacc + A->in[I_ADAB][(size_t)i * MODW + c2]; }
            __syncthreads();
        }
    }
    __syncthreads();
    const int gw = F.vcu * NWAVES + F.wave, NGW = F.G * NWAVES;
    const long gt = (long)F.vcu * (NWAVES * 64) + F.tid, NGT = (long)F.G * NWAVES * 64;
    for (int rep_ = 0; rep_ < 1 + ((PREPREP >> 1) & 1); ++rep_) {
        LAS float* scr = (LAS float*)(F.lds + F.wave * 16384);
        constexpr int IT_SIN = (1024 / 64) * (4096 / 32), IT_SOUT = (2048 / 64) * (1024 / 32), IT_SQ = (1024 / 64) * (1024 / 32), IT_GRP = (256 / 64) * (256 / 32),
                      IT_QKV = (1024 / 64) * (1536 / 32);
        constexpr int NITEMS = 2 * IT_SIN + 2 * IT_SOUT + 2 * IT_SQ + 4 * IT_GRP + IT_QKV + IT_SQ;
        for (int it = gw; it < NITEMS; it += NGW) {
            int r = it;
            if (r < 2 * IT_SIN) { const int j = r / IT_SIN; p0_transpose_item(A->in[I_SGU_WIN] + (size_t)j * 1024 * 4096, 1024, 4096, (bf16*)(ws + WS_WSGUIN) + (size_t)j * 4096 * 1024, scr, r % IT_SIN, F.lane); continue; } r -= 2 * IT_SIN;
            if (r < 2 * IT_SOUT) { const int j = r / IT_SOUT; p0_transpose_item(A->in[I_SGU_WOUT] + (size_t)j * 2048 * 1024, 2048, 1024, (bf16*)(ws + WS_WSGUOUT) + (size_t)j * 1024 * 2048, scr, r % IT_SOUT, F.lane); continue; } r -= 2 * IT_SOUT;
            if (r < IT_SQ) { p0_transpose_item(A->in[I_POOL_WIN], 1024, 1024, (bf16*)(ws + WS_WPOOLIN), scr, r, F.lane); continue; } r -= IT_SQ;
            if (r < IT_SQ) { p0_transpose_item(A->in[I_POOL_WOUT], 1024, 1024, (bf16*)(ws + WS_WPOOLOUT), scr, r, F.lane); continue; } r -= IT_SQ;
            if (r < 4 * IT_GRP) { const int j = r / IT_GRP; p0_transpose_item(A->in[I_POOL_WGRP] + (size_t)j * 65536, 256, 256, (bf16*)(ws + WS_WGRP) + (size_t)j * 65536, scr, r % IT_GRP, F.lane); continue; } r -= 4 * IT_GRP;
            if (r < IT_QKV) { p0_transpose_item(A->in[I_ATT_WQKV], 1024, 1536, (bf16*)(ws + WS_WQKV), scr, r, F.lane); continue; } r -= IT_QKV;
            { p0_transpose_item(A->in[I_ATT_WO], 1024, 1024, (bf16*)(ws + WS_WO), scr, r, F.lane); }
        }
        for (long ch = gt; ch < (long)DEPTH * 1024 * 2048 / 8; ch += NGT) {
            const int d8 = (int)(ch & 31), h = (int)(ch >> 5) & 7, kk = (int)(ch >> 8) & 1023, i = (int)(ch >> 18);
            const float* src = A->in[I_PEER_WQ] + ((size_t)i * 1024 + kk) * 2048 + h * 256 + d8 * 8;
            const f32x4 a = *(const f32x4*)src, b = *(const f32x4*)(src + 4);
            v4u o; o.x = pk2(a[0], a[1]); o.y = pk2(a[2], a[3]); o.z = pk2(b[0], b[1]); o.w = pk2(b[2], b[3]);
            *(v4u*)((bf16*)(ws + WS_G) + (((size_t)(i * 8 + h) * 1024 + kk) * 256 + d8 * 8)) = o;
        }
    }
    for (long ch = gt; ch < (long)DEPTH * 8 * 256 * 32; ch += NGT) {
        const int d0 = (int)(ch & 31) * 8, n = (int)(ch >> 5) & 255, ih = (int)(ch >> 13);
        v4u o = {0u, 0u, 0u, 0u};
        const float* src = nullptr;
        if (n < 128 && d0 < 128) src = A->in[I_PEER_K1] + ((size_t)ih * 128 + n) * 128 + d0;
        else if (n >= 128 && d0 >= 128) src = A->in[I_PEER_K2] + ((size_t)ih * 128 + (n - 128)) * 128 + (d0 - 128);
        if (src) { const f32x4 a = *(const f32x4*)src, b = *(const f32x4*)(src + 4); o.x = pk2(a[0], a[1]); o.y = pk2(a[2], a[3]); o.z = pk2(b[0], b[1]); o.w = pk2(b[2], b[3]); }
        *(v4u*)((bf16*)(ws + WS_KB) + ch * 8) = o;
    }
    for (int rep_ = 0; rep_ < 1 + ((PREPREP >> 3) & 1); ++rep_)
    for (int row0 = gw * 4; row0 < 2 * DEPTH * NEXP; row0 += NGW * 4) {
        const bool isU = row0 < DEPTH * NEXP; const int r0 = isU ? row0 : row0 - DEPTH * NEXP;
        const float* sp = (isU ? A->in[I_PEER_U] : A->in[I_PEER_V]) + (size_t)r0 * DM;
        f32x4 v[4][4]; float am[4];
#pragma unroll
        for (int q = 0; q < 4; ++q)
#pragma unroll
            for (int j = 0; j < 4; ++j) v[q][j] = __builtin_nontemporal_load((const f32x4*)(sp + (size_t)q * DM) + F.lane + 64 * j);
#pragma unroll
        for (int q = 0; q < 4; ++q) { float m = 0.f;
#pragma unroll
            for (int j = 0; j < 4; ++j) m = fmaxf(m, fmaxf(fmaxf(fabsf(v[q][j].x), fabsf(v[q][j].y)), fmaxf(fabsf(v[q][j].z), fabsf(v[q][j].w))));
            am[q] = m; }
#pragma unroll
        for (int q = 0; q < 4; ++q) { float m = am[q]; m = fmaxf(m, shx<1>(m)); m = fmaxf(m, shx<2>(m)); m = fmaxf(m, shx<4>(m)); m = fmaxf(m, shx<8>(m)); m = fmaxf(m, shx<16>(m));
            auto r = __builtin_amdgcn_permlane32_swap(__float_as_uint(m), __float_as_uint(m), false, false); am[q] = fmaxf(__uint_as_float(r[0]), __uint_as_float(r[1])); }
        {
            const int lyr = r0 >> 14;
            unsigned char* tb4 = ws + (isU ? WS_TU : WS_TV) + (size_t)lyr * NEXP * 512;
            const unsigned bias = isU ? 0u : 0x0808u;
#pragma unroll
            for (int q = 0; q < 4; ++q) { const int e = (r0 + q) & (NEXP - 1);
                float ss = 0.f;
#pragma unroll
                for (int j = 0; j < 4; ++j) ss += (v[q][j].x * v[q][j].x + v[q][j].y * v[q][j].y) + (v[q][j].z * v[q][j].z + v[q][j].w * v[q][j].w);
                ss = wave_sum(ss);
                float sc = fmaxf(0.3352f * __builtin_sqrtf(ss * (1.f / DM)), am[q] * (1.f / 16.f)); if (!(sc > 0.f)) sc = 1.f;
                const float inv = 1.f / sc;
#pragma unroll
                for (int j = 0; j < 4; ++j) { unsigned w = 0u;
#pragma unroll
                    for (int i = 0; i < 4; ++i) { int n = (int)__builtin_floorf(v[q][j][i] * inv); n = n > 7 ? 7 : (n < -8 ? -8 : n); w |= ((unsigned)n & 15u) << (4 * i); }
                    *(unsigned short*)(tb4 + (size_t)j * (NEXP * 128) + (size_t)e * 128 + 2 * F.lane) = (unsigned short)(w ^ bias); }
                if (F.lane == 0) ((float*)(ws + (isU ? WS_SU : WS_SV)))[r0 + q] = sc; }
        }
    }
}

__device__ __forceinline__ float wave_max(float v) {
    v = fmaxf(v, shx<1>(v)); v = fmaxf(v, shx<2>(v)); v = fmaxf(v, shx<4>(v)); v = fmaxf(v, shx<8>(v)); v = fmaxf(v, shx<16>(v));
    { auto r = __builtin_amdgcn_permlane32_swap(__float_as_uint(v), __float_as_uint(v), false, false); v = fmaxf(__uint_as_float(r[0]), __uint_as_float(r[1])); }
    return v;
}
__device__ __forceinline__ void op_modulate(Frame& F, KArgs A, const float* srcLat, const float* srcCtx, const bf16* srcX, const float* gain, const float* modl, int ch_shift, int nrows, bool fin, bool hq = false) {
    const int gw = F.vcu * NWAVES + F.wave, NGW = F.G * NWAVES;
    bf16* H = (bf16*)(ws_ + WS_H);
    for (int row = gw; row < nrows; row += NGW) {
        const int mr = row < NLAT ? (row >> 11) : 8;
        const float* sh = modl + mr * MODW + ch_shift * DM; const float* sc = sh + DM;
        f32x4 v[4]; float s = 0.f;
        if (srcX) { const v2u* xr = (const v2u*)(srcX + (size_t)row * DM);
#pragma unroll
            for (int j = 0; j < 4; ++j) { const v2u q = xr[F.lane + 64 * j]; v[j] = (f32x4){bflo(q.x), bfhi(q.x), bflo(q.y), bfhi(q.y)}; }
        } else { const float* xr = row < NLAT ? srcLat + (size_t)row * DM : srcCtx + (size_t)(row - NLAT) * DM;
#pragma unroll
            for (int j = 0; j < 4; ++j) v[j] = *((const f32x4*)xr + F.lane + 64 * j); }
#pragma unroll
        for (int j = 0; j < 4; ++j) s += (v[j].x * v[j].x + v[j].y * v[j].y) + (v[j].z * v[j].z + v[j].w * v[j].w);
        const float rstd = __builtin_amdgcn_rsqf(wave_sum(s) * (1.f / DM) + EPS);
        if (fin) {
            f32x4* o16 = (f32x4*)(A->out + (size_t)row * DM) + F.lane;
#pragma unroll
            for (int j = 0; j < 4; ++j) { const f32x4 g = *((const f32x4*)gain + F.lane + 64 * j); o16[64 * j] = v[j] * rstd * g; }
            continue;
        }
        v2u* o8 = (v2u*)(H + (size_t)row * DM) + F.lane;
        float m = 0.f;
#pragma unroll
        for (int j = 0; j < 4; ++j) { const f32x4 g = *((const f32x4*)gain + F.lane + 64 * j), a = *((const f32x4*)sc + F.lane + 64 * j), b = *((const f32x4*)sh + F.lane + 64 * j);
            const f32x4 y = v[j] * rstd * g * (a + 1.f) + b; v2u w; w.x = pk2(y[0], y[1]); w.y = pk2(y[2], y[3]); o8[64 * j] = w;
            if (hq) { v[j] = y; m = fmaxf(m, fmaxf(fmaxf(fabsf(y[0]), fabsf(y[1])), fmaxf(fabsf(y[2]), fabsf(y[3])))); } }
        if (hq) {
            m = wave_max(m);
            const float inv = m > 0.f ? 119.f / m : 0.f;
            unsigned short* hp = (unsigned short*)(ws_ + WS_H8) + (size_t)row * 512 + F.lane;
#pragma unroll
            for (int j = 0; j < 4; ++j) { unsigned pa = 0u, pb = 0u;
#pragma unroll
                for (int i = 0; i < 4; ++i) { int q = (int)__builtin_rintf(v[j][i] * inv); q = q > 119 ? 119 : (q < -119 ? -119 : q);
                    const int b = ((q + 8) & 15) - 8, a = (q - b) >> 4; pa |= ((unsigned)a & 15u) << (4 * i); pb |= ((unsigned)b & 15u) << (4 * i); }
                hp[j * 128] = (unsigned short)pa; hp[j * 128 + 64] = (unsigned short)pb; }
            if (F.lane == 0) ((float*)(ws_ + WS_SHQ))[row] = m * (1.f / 119.f);
        }
    }
}

__device__ __forceinline__ void op_spatial(Frame& F, KArgs A, int j, int nrows) {
    const float* Ws = A->in[I_SGU_WS] + (size_t)j * 8 * 128 * 128; const float* vgain = A->in[I_SGU_VG] + (size_t)j * SGUW; const float* bs = A->in[I_SGU_BS] + (size_t)j * 8 * 128;
    const bf16* ZU = (const bf16*)(ws_ + WS_Z); const bf16* VT = ZU + (size_t)NTOK * SGUW; bf16* GT = (bf16*)(ws_ + WS_G); const float* SS = (const float*)(ws_ + WS_SS);
    LAS unsigned char* lA = F.lds;
    LAS unsigned char* lB = F.lds + 34816;
    LAS float* lR = (LAS float*)(F.lds + 34816 + 69632);
    const int nunits = (nrows / 128) * 8;
    const int wr = F.wave >> 2, wc = F.wave & 3, fr = F.lane & 15, fq = F.lane >> 4;
    int u = F.vcu;
    if (u >= nunits) return;
    const int g = u & 7;
    if ((F.G & 7) != 0) {
    }
    const unsigned tid = (unsigned)F.tid;
    f32x4 wsr[4][2];
#pragma unroll
    for (int it = 0; it < 4; ++it) { const unsigned e = it * 512u + tid, p = e >> 4, q0 = (e & 15u) * 8u; const float* sp = Ws + ((size_t)g * 128 + p) * 128 + q0; wsr[it][0] = *(const f32x4*)sp; wsr[it][1] = *(const f32x4*)(sp + 4); }
    const unsigned erow = tid >> 5, d0 = (tid & 31u) * 8u;
    const f32x4 vg0 = *(const f32x4*)(vgain + g * 256 + d0), vg1 = *(const f32x4*)(vgain + g * 256 + d0 + 4);
    float bsr[8];
#pragma unroll
    for (int ps = 0; ps < 8; ++ps) bsr[ps] = bs[g * 128 + ps * 16 + erow];
    v4u breg[8];
#define SP_PREFETCH(uu) do { const int _c = (uu) >> 3, _g = (uu) & 7; \
        _Pragma("unroll") for (int it = 0; it < 8; ++it) { const unsigned e = it * 512u + tl, d = e >> 4, q0 = (e & 15u) * 8u; breg[it] = *(const v4u*)(VT + (size_t)(_g * 256 + d) * NTOK + _c * 128 + q0); } } while (0)
    unsigned tl = tid; asm volatile("" : "+v"(tl));
    SP_PREFETCH(u);
    for (; u < nunits; u += F.G) {
        const int c = u >> 3;
        tl = tid; asm volatile("" : "+v"(tl));
        if (tid < 128u) { float sq = 0.f;
#pragma unroll
            for (int sl = 0; sl < 16; ++sl) sq += SS[(size_t)sl * NTOK + c * 128 + tid];
            lR[tid] = __builtin_amdgcn_rsqf(sq * (1.f / SGUW) + EPS); }
        __syncthreads();
#pragma unroll
        for (int it = 0; it < 4; ++it) { const unsigned e = it * 512u + tid, p = e >> 4, q0 = (e & 15u) * 8u; const f32x4 a = wsr[it][0], bq = wsr[it][1];
            v4u o; o.x = pk2(a[0] * lR[q0], a[1] * lR[q0 + 1]); o.y = pk2(a[2] * lR[q0 + 2], a[3] * lR[q0 + 3]); o.z = pk2(bq[0] * lR[q0 + 4], bq[1] * lR[q0 + 5]); o.w = pk2(bq[2] * lR[q0 + 6], bq[3] * lR[q0 + 7]);
            *(LAS v4u*)(lA + p * 272 + q0 * 2) = o; }
#pragma unroll
        for (int it = 0; it < 8; ++it) { const unsigned e = it * 512u + tid, d = e >> 4, q0 = (e & 15u) * 8u; *(LAS v4u*)(lB + d * 272 + q0 * 2) = breg[it]; }
        __syncthreads();
        { const int un = (u + F.G < nunits) ? u + F.G : u; SP_PREFETCH(un); }
        v4u zu[8];
        const size_t rowbase = (size_t)(c * 128) * SGUW + g * 256 + d0;
#pragma unroll
        for (int ps = 0; ps < 8; ++ps) zu[ps] = *(const v4u*)(ZU + rowbase + (size_t)(ps * 16 + erow) * SGUW);
        f32x4 acc[4][4];
#pragma unroll
        for (int m = 0; m < 4; ++m)
#pragma unroll
            for (int n = 0; n < 4; ++n) acc[m][n] = (f32x4){0.f, 0.f, 0.f, 0.f};
#pragma unroll
        for (int k = 0; k < 4; ++k) {
            bf16x8 af[4], bfr[4];
#pragma unroll
            for (int m = 0; m < 4; ++m) af[m] = *(const LAS bf16x8*)(lA + (wr * 64 + m * 16 + fr) * 272 + (k * 32 + fq * 8) * 2);
#pragma unroll
            for (int n = 0; n < 4; ++n) bfr[n] = *(const LAS bf16x8*)(lB + (wc * 64 + n * 16 + fr) * 272 + (k * 32 + fq * 8) * 2);
#pragma unroll
            for (int m = 0; m < 4; ++m)
#pragma unroll
                for (int n = 0; n < 4; ++n) acc[m][n] = __builtin_amdgcn_mfma_f32_16x16x32_bf16(bfr[n], af[m], acc[m][n], 0, 0, 0);
        }
        __syncthreads();
#pragma unroll
        for (int m = 0; m < 4; ++m)
#pragma unroll
            for (int n = 0; n < 4; ++n) { v2u w; w.x = pk2(acc[m][n][0], acc[m][n][1]); w.y = pk2(acc[m][n][2], acc[m][n][3]);
                *(LAS v2u*)(lB + (wr * 64 + m * 16 + fr) * 528 + (wc * 64 + n * 16 + 4 * fq) * 2) = w; }
        __syncthreads();
#pragma unroll
        for (int ps = 0; ps < 8; ++ps) { const unsigned p = ps * 16u + erow; const v4u sv = *(const LAS v4u*)(lB + p * 528 + d0 * 2); const v4u z = zu[ps]; const float bsv = bsr[ps];
            v4u o;
            o.x = pk2(bflo(z.x) * (bflo(sv.x) * vg0[0] + bsv), bfhi(z.x) * (bfhi(sv.x) * vg0[1] + bsv)); o.y = pk2(bflo(z.y) * (bflo(sv.y) * vg0[2] + bsv), bfhi(z.y) * (bfhi(sv.y) * vg0[3] + bsv));
            o.z = pk2(bflo(z.z) * (bflo(sv.z) * vg1[0] + bsv), bfhi(z.z) * (bfhi(sv.z) * vg1[1] + bsv)); o.w = pk2(bflo(z.w) * (bflo(sv.w) * vg1[2] + bsv), bfhi(z.w) * (bfhi(sv.w) * vg1[3] + bsv));
            *(v4u*)(GT + rowbase + (size_t)p * SGUW) = o; }
    }
#undef SP_PREFETCH
}

__device__ __forceinline__ void op_pool(Frame& F, KArgs A, int nrows) {
    const bf16* ZP = (const bf16*)(ws_ + WS_Z); bf16* P = (bf16*)(ws_ + WS_G);
    const long gt = (long)F.vcu * (NWAVES * 64) + F.tid, NGT = (long)F.G * NWAVES * 64;
    constexpr int RUN = 32;
    for (long e = gt; e < (long)(nrows / RUN) * 128; e += NGT) {
        const int run = (int)(e >> 7), c0 = (int)(e & 127) * 8, g = c0 >> 8, half = 1 << g;
        const int row0 = run * RUN;
        int pos0, L; if (row0 < NLAT) { pos0 = row0 & (SEQ - 1); L = SEQ; } else { pos0 = (row0 - NLAT) & (CTXL - 1); L = CTXL; }
        const bf16* zb = ZP + (size_t)(row0 - pos0) * DM + c0;
        float s[8];
#pragma unroll
        for (int i = 0; i < 8; ++i) s[i] = 0.f;
#define POOL_ACC(sgn, vv) do { const v4u _v = (vv); s[0] += (sgn) * bflo(_v.x); s[1] += (sgn) * bfhi(_v.x); s[2] += (sgn) * bflo(_v.y); s[3] += (sgn) * bfhi(_v.y); \
        s[4] += (sgn) * bflo(_v.z); s[5] += (sgn) * bfhi(_v.z); s[6] += (sgn) * bflo(_v.w); s[7] += (sgn) * bfhi(_v.w); } while (0)
#pragma unroll
        for (int w = 0; w < 16; ++w) { const int t = pos0 - half + w; const bool in = (w < 2 * half) && t >= 0 && t < L; const int tc = min(max(t, 0), L - 1);
            const v4u v = *(const v4u*)(zb + (size_t)tc * DM); const float f = in ? 1.f : 0.f; POOL_ACC(f, v); }
#pragma unroll 8
        for (int i = 0; i < RUN; ++i) {
            const int pos = pos0 + i;
            const int lo = max(pos - half, 0), hi = min(pos + half, L);
            const v4u z = *(const v4u*)(zb + (size_t)pos * DM); const float ic = 1.f / (float)(hi - lo);
            v4u o; o.x = pk2(s[0] * ic - bflo(z.x), s[1] * ic - bfhi(z.x)); o.y = pk2(s[2] * ic - bflo(z.y), s[3] * ic - bfhi(z.y));
            o.z = pk2(s[4] * ic - bflo(z.z), s[5] * ic - bfhi(z.z)); o.w = pk2(s[6] * ic - bflo(z.w), s[7] * ic - bfhi(z.w));
            *(v4u*)(P + (size_t)(row0 + i) * DM + c0) = o;
            const int tin = pos + half, tout = pos - half;
            const v4u vin = *(const v4u*)(zb + (size_t)min(tin, L - 1) * DM), vout = *(const v4u*)(zb + (size_t)max(tout, 0) * DM);
            POOL_ACC(tin < L ? 1.f : 0.f, vin); POOL_ACC(tout >= 0 ? -1.f : 0.f, vout);
        }
#undef POOL_ACC
    }
}

__device__ __forceinline__ void op_qknorm(Frame& F, KArgs A, int nrows) {
    const bf16* R = (const bf16*)(ws_ + WS_Z);
    bf16* QB = (bf16*)(ws_ + WS_G); bf16* KBUF = QB + (size_t)NTOK * DM; bf16* VBUF = KBUF + (size_t)NB * KVROWS * 256;
    const float* qg = A->in[I_ATT_QG]; const float* kg = A->in[I_ATT_KG];
    LAS float* tab = (LAS float*)F.lds;
    for (int e = F.tid; e < 64 * 32; e += NWAVES * 64) { const int pos = e >> 5, f = e & 31; const float fr = __expf(-(float)f * (9.210340371976184f / 32.f)); float sn, cs; sincosf((float)pos * fr, &sn, &cs); tab[e * 2] = cs; tab[e * 2 + 1] = sn; }
    __syncthreads();
    const int gw = F.vcu * NWAVES + F.wave, NGW = F.G * NWAVES;
    const int hl = F.lane >> 4, j = F.lane & 15;
    for (int row = gw; row < nrows; row += NGW) {
        const bool lat = row < NLAT; int b, pos; if (lat) { b = row >> 11; pos = row & (SEQ - 1); } else { b = (row - NLAT) >> 8; pos = (row - NLAT) & (CTXL - 1); }
        const int krow = b * KVROWS + (lat ? pos : SEQ + pos);
        const bf16* rr = R + (size_t)row * 1536;
#pragma unroll
        for (int pass = 0; pass < 3; ++pass) {
            const int head = pass * 4 + hl;
            const bool act = head < 10;
            float x[8];
            { v4u v = {0u, 0u, 0u, 0u}; if (act) v = *(const v4u*)(rr + head * 128 + j * 8);
              x[0] = bflo(v.x); x[1] = bfhi(v.x); x[2] = bflo(v.y); x[3] = bfhi(v.y); x[4] = bflo(v.z); x[5] = bfhi(v.z); x[6] = bflo(v.w); x[7] = bfhi(v.w); }
            float ss = 0.f;
#pragma unroll
            for (int i = 0; i < 8; ++i) ss += x[i] * x[i];
            ss += shx<1>(ss); ss += shx<2>(ss); ss += shx<4>(ss); ss += shx<8>(ss);
            const float rstd = __builtin_amdgcn_rsqf(ss * (1.f / 128.f) + EPS);
            const float* gn = (head < 8 ? qg : kg) + j * 8;
#pragma unroll
            for (int i = 0; i < 8; ++i) x[i] = x[i] * rstd * gn[i];
            float y[8];
#pragma unroll
            for (int i = 0; i < 8; ++i) { const float other = shx<4>(x[i]);
                const int dd = j * 8 + i, f = dd & 31, axis = dd >> 6, second = (dd >> 5) & 1;
                const int p = axis ? (pos & 63) : (pos >> 6);
                const float cs = tab[(p * 32 + f) * 2], sn = tab[(p * 32 + f) * 2 + 1];
                y[i] = lat ? (second ? x[i] * cs + other * sn : x[i] * cs - other * sn) : x[i]; }
            if (act) { v4u o; o.x = pk2(y[0], y[1]); o.y = pk2(y[2], y[3]); o.z = pk2(y[4], y[5]); o.w = pk2(y[6], y[7]);
                if (head < 8) *(v4u*)(QB + (size_t)row * DM + head * 128 + j * 8) = o;
                else *(v4u*)(KBUF + (size_t)krow * 256 + (head - 8) * 128 + j * 8) = o; }
        }
        if (F.lane < 32) *(v4u*)(VBUF + (size_t)krow * 256 + F.lane * 8) = *(const v4u*)(rr + 1280 + F.lane * 8);
    }
}

__device__ __forceinline__ void op_attn(Frame& F, KArgs A) {
    const attn::bf16* QB = (const attn::bf16*)(ws_ + WS_G); const attn::bf16* KBUF = QB + (size_t)NTOK * DM; const attn::bf16* VBUF = KBUF + (size_t)NB * KVROWS * 256;
    attn::bf16* OB = (attn::bf16*)(ws_ + WS_H);
    for (int u = F.vcu; u < 576; u += F.G) {
        int b, hq, rowbase, kbase, seq;
        if (u < 512) { b = u >> 6; hq = (u >> 3) & 7; rowbase = b * SEQ + (u & 7) * 256; kbase = b * KVROWS; seq = KVROWS; }
        else { const int v = u - 512; b = v >> 3; hq = v & 7; rowbase = NLAT + b * CTXL; kbase = b * KVROWS + SEQ; seq = CTXL; }
        const size_t qo = (size_t)rowbase * DM + hq * 128, ko = (size_t)kbase * 256 + (hq >> 2) * 128;
        attn::attn_dense_body(QB + qo, KBUF + ko, VBUF + ko, OB + qo, seq, (char*)F.lds, F.tid);
    }
}

__device__ __forceinline__ unsigned fkey(float v) { const unsigned u = __float_as_uint(v); return (u & 0x80000000u) ? ~u : (u | 0x80000000u); }
__device__ __forceinline__ float keyf(unsigned k) { return __uint_as_float((k & 0x80000000u) ? (k & 0x7fffffffu) : ~k); }
#define ROR_MAX(m, n) m = max(m, (unsigned)__builtin_amdgcn_update_dpp(0, (int)(m), 0x120 + (n), 0xf, 0xf, false))
__device__ __forceinline__ unsigned row_max16(unsigned m) { ROR_MAX(m, 1); ROR_MAX(m, 2); ROR_MAX(m, 4); ROR_MAX(m, 8); return m; }
__device__ __forceinline__ float row_sum16(float v) {
    v += __uint_as_float((unsigned)__builtin_amdgcn_update_dpp(0, (int)__float_as_uint(v), 0x121, 0xf, 0xf, false));
    v += __uint_as_float((unsigned)__builtin_amdgcn_update_dpp(0, (int)__float_as_uint(v), 0x122, 0xf, 0xf, false));
    v += __uint_as_float((unsigned)__builtin_amdgcn_update_dpp(0, (int)__float_as_uint(v), 0x124, 0xf, 0xf, false));
    v += __uint_as_float((unsigned)__builtin_amdgcn_update_dpp(0, (int)__float_as_uint(v), 0x128, 0xf, 0xf, false));
    return v;
}
#define CE(a, b) do { const unsigned _x = max(a, b), _y = min(a, b); a = _x; b = _y; } while (0)
__device__ __forceinline__ void op_topk(Frame& F, KArgs A, int layer, int nrows) {
    const unsigned short* SC = (const unsigned short*)(ws_ + WS_Z);   int* IDX = (int*)(ws_ + WS_IDX); pg8::f32x2* SG = (pg8::f32x2*)(ws_ + WS_SG); const float* SHQ = (const float*)(ws_ + WS_SHQ);
    const float* SU = (const float*)(ws_ + WS_SU) + (size_t)layer * NEXP; const float* SV = (const float*)(ws_ + WS_SV) + (size_t)layer * NEXP;
    const int gw = F.vcu * NWAVES + F.wave, NGW = F.G * NWAVES;
    const int rowi = F.lane >> 4, l16 = F.lane & 15, half = rowi & 1, pr = rowi >> 1;
    const int npairs = nrows * 8;
    const int base1 = (rowi & ~1) * 16, base2 = base1 + 16;
    v4u va[2];
    { const int pb = gw * 4;
#pragma unroll
      for (int u = 0; u < 2; ++u) { const int th = min(pb + 2 * u + pr, npairs - 1); const unsigned short* sp = SC + (size_t)th * 256 + half * 128;
          va[u] = *(const v4u*)(sp + 8 * l16); } }
    for (int pb = gw * 4; pb < npairs; pb += NGW * 4) {
        unsigned k[2][8];
#pragma unroll
        for (int u = 0; u < 2; ++u)
#pragma unroll
            for (int i = 0; i < 4; ++i) { const h2_t hv = u2h(va[u][i]);
                k[u][2 * i] = (fkey((float)hv.x) & ~127u) | (unsigned)(8 * l16 + 2 * i); k[u][2 * i + 1] = (fkey((float)hv.y) & ~127u) | (unsigned)(8 * l16 + 2 * i + 1); }
        { const int pn = pb + NGW * 4;
#pragma unroll
          for (int u = 0; u < 2; ++u) { const int th = min(pn + 2 * u + pr, npairs - 1); const unsigned short* sp = SC + (size_t)th * 256 + half * 128;
              va[u] = *(const v4u*)(sp + 8 * l16); } }
#pragma unroll
        for (int u = 0; u < 2; ++u) {
            CE(k[u][0], k[u][1]); CE(k[u][2], k[u][3]); CE(k[u][4], k[u][5]); CE(k[u][6], k[u][7]);
            CE(k[u][0], k[u][2]); CE(k[u][1], k[u][3]); CE(k[u][4], k[u][6]); CE(k[u][5], k[u][7]);
            CE(k[u][1], k[u][2]); CE(k[u][5], k[u][6]); CE(k[u][0], k[u][4]); CE(k[u][3], k[u][7]);
            CE(k[u][1], k[u][5]); CE(k[u][2], k[u][6]);
            CE(k[u][1], k[u][4]); CE(k[u][3], k[u][6]);
            CE(k[u][2], k[u][4]); CE(k[u][3], k[u][5]);
            CE(k[u][3], k[u][4]); }
        unsigned res[2] = {0u, 0u};
#pragma unroll
        for (int it = 0; it < 16; ++it) {
#pragma unroll
            for (int u = 0; u < 2; ++u) {
                const unsigned m = row_max16(k[u][0]);
                res[u] = (l16 == it) ? m : res[u];
                const bool win = (k[u][0] == m);
#pragma unroll
                for (int i = 0; i < 7; ++i) k[u][i] = win ? k[u][i + 1] : k[u][i];
                k[u][7] = win ? 0u : k[u][7];
            }
        }
        float val[2]; int kid[2];
#pragma unroll
        for (int u = 0; u < 2; ++u) { val[u] = keyf(res[u] & ~127u); kid[u] = (int)(res[u] & 127u); }
        const int rowbase = rowi * 16, src1 = half ? rowbase - 16 : rowbase, src2 = half ? rowbase : rowbase + 16;
        const float v1o = bperm(src1 + l16, val[1]); const float v1 = half ? v1o : val[0];
        int p = 0;
        const float v2a0 = bperm(src2, val[0]), v2b0 = bperm(src2, val[1]);
        float v2p = half ? v2b0 : v2a0;
        unsigned ck = (fkey(v1 + v2p) & ~255u) | (unsigned)(l16 * 16), best = 0u;
#pragma unroll
        for (int it = 0; it < 16; ++it) {
            const unsigned m = row_max16(ck);
            best = (l16 == it) ? m : best;
            const bool win = (ck == m);
            p += win ? 1 : 0;
            const int pc = min(p, 15);
            const float va = bperm(src2 + pc, val[0]), vb = bperm(src2 + pc, val[1]);
            v2p = half ? vb : va;
            const unsigned nk = (p > 15) ? 0u : ((fkey(v1 + v2p) & ~255u) | (unsigned)(l16 * 16 + pc));
            ck = win ? nk : ck;
        }
        {
            const int th = pb + 2 * half + pr;
            const int cid = (int)(best & 255u); const float bsum = keyf(best & ~255u);
            const int e1a = bperm_i(src1 + (cid >> 4), kid[0]), e1b = bperm_i(src1 + (cid >> 4), kid[1]);
            const int e2a = bperm_i(src2 + (cid & 15), kid[0]), e2b = bperm_i(src2 + (cid & 15), kid[1]);
            const int e1 = half ? e1b : e1a, e2 = half ? e2b : e2a;
            const float mx = bperm(rowbase, bsum);
            const float ex = __expf(bsum - mx);
            const float den = row_sum16(ex);
            if (th < npairs) { const int eid = e1 * 128 + e2; IDX[(size_t)th * 16 + l16] = eid;
                SG[(size_t)th * 16 + l16] = (pg8::f32x2){SU[eid] * (SHQ[th >> 3] * 16.f), (ex / den) * SV[eid]}; }
        }
    }
}

__device__ __forceinline__ void fmac(float& d, float a, float b) { asm("v_fmac_f32 %0, %1, %2" : "+v"(d) : "v"(a), "v"(b)); }
#define FP8_LO(w) __builtin_amdgcn_cvt_pk_f32_fp8((int)(w), false)
#define FP8_HI(w) __builtin_amdgcn_cvt_pk_f32_fp8((int)(w), true)
#define DOT16(a, r) do { pg8::f32x2 _f; \
    _f = FP8_LO((r).x); a += _f.x * hf[0] + _f.y * hf[1];   _f = FP8_HI((r).x); a += _f.x * hf[2] + _f.y * hf[3]; \
    _f = FP8_LO((r).y); a += _f.x * hf[4] + _f.y * hf[5];   _f = FP8_HI((r).y); a += _f.x * hf[6] + _f.y * hf[7]; \
    _f = FP8_LO((r).z); a += _f.x * hf[8] + _f.y * hf[9];   _f = FP8_HI((r).z); a += _f.x * hf[10] + _f.y * hf[11]; \
    _f = FP8_LO((r).w); a += _f.x * hf[12] + _f.y * hf[13]; _f = FP8_HI((r).w); a += _f.x * hf[14] + _f.y * hf[15]; } while (0)
#define AXPY16(w, r) do { pg8::f32x2 _f; \
    _f = FP8_LO((r).x); fmac(fo[0], (w), _f.x); fmac(fo[1], (w), _f.y);   _f = FP8_HI((r).x); fmac(fo[2], (w), _f.x); fmac(fo[3], (w), _f.y); \
    _f = FP8_LO((r).y); fmac(fo[4], (w), _f.x); fmac(fo[5], (w), _f.y);   _f = FP8_HI((r).y); fmac(fo[6], (w), _f.x); fmac(fo[7], (w), _f.y); \
    _f = FP8_LO((r).z); fmac(fo[8], (w), _f.x); fmac(fo[9], (w), _f.y);   _f = FP8_HI((r).z); fmac(fo[10], (w), _f.x); fmac(fo[11], (w), _f.y); \
    _f = FP8_LO((r).w); fmac(fo[12], (w), _f.x); fmac(fo[13], (w), _f.y); _f = FP8_HI((r).w); fmac(fo[14], (w), _f.x); fmac(fo[15], (w), _f.y); } while (0)
#define DOT16V(a, r, H_) do { pg8::f32x2 _f; \
    _f = FP8_LO((r).x); fmac(a, _f.x, H_[0]); fmac(a, _f.y, H_[1]);   _f = FP8_HI((r).x); fmac(a, _f.x, H_[2]); fmac(a, _f.y, H_[3]); \
    _f = FP8_LO((r).y); fmac(a, _f.x, H_[4]); fmac(a, _f.y, H_[5]);   _f = FP8_HI((r).y); fmac(a, _f.x, H_[6]); fmac(a, _f.y, H_[7]); \
    _f = FP8_LO((r).z); fmac(a, _f.x, H_[8]); fmac(a, _f.y, H_[9]);   _f = FP8_HI((r).z); fmac(a, _f.x, H_[10]); fmac(a, _f.y, H_[11]); \
    _f = FP8_LO((r).w); fmac(a, _f.x, H_[12]); fmac(a, _f.y, H_[13]); _f = FP8_HI((r).w); fmac(a, _f.x, H_[14]); fmac(a, _f.y, H_[15]); } while (0)
#define CVH_LO(w) __builtin_bit_cast(h2_t, __builtin_amdgcn_cvt_scalef32_pk_f16_fp8((w), 1.0f, false))
#define CVH_HI(w) __builtin_bit_cast(h2_t, __builtin_amdgcn_cvt_scalef32_pk_f16_fp8((w), 1.0f, true))
#define DOT16H(a, r, Hh) do { \
    a = __builtin_amdgcn_fdot2(CVH_LO((r).x), Hh[0], a, false); a = __builtin_amdgcn_fdot2(CVH_HI((r).x), Hh[1], a, false); \
    a = __builtin_amdgcn_fdot2(CVH_LO((r).y), Hh[2], a, false); a = __builtin_amdgcn_fdot2(CVH_HI((r).y), Hh[3], a, false); \
    a = __builtin_amdgcn_fdot2(CVH_LO((r).z), Hh[4], a, false); a = __builtin_amdgcn_fdot2(CVH_HI((r).z), Hh[5], a, false); \
    a = __builtin_amdgcn_fdot2(CVH_LO((r).w), Hh[6], a, false); a = __builtin_amdgcn_fdot2(CVH_HI((r).w), Hh[7], a, false); } while (0)
#define AXPY16H(wh, r) do { \
    fo[0] = __builtin_elementwise_fma(CVH_LO((r).x), (wh), fo[0]); fo[1] = __builtin_elementwise_fma(CVH_HI((r).x), (wh), fo[1]); \
    fo[2] = __builtin_elementwise_fma(CVH_LO((r).y), (wh), fo[2]); fo[3] = __builtin_elementwise_fma(CVH_HI((r).y), (wh), fo[3]); \
    fo[4] = __builtin_elementwise_fma(CVH_LO((r).z), (wh), fo[4]); fo[5] = __builtin_elementwise_fma(CVH_HI((r).z), (wh), fo[5]); \
    fo[6] = __builtin_elementwise_fma(CVH_LO((r).w), (wh), fo[6]); fo[7] = __builtin_elementwise_fma(CVH_HI((r).w), (wh), fo[7]); } while (0)
__device__ __forceinline__ h2_t pkh(float a, float b) { return __builtin_bit_cast(h2_t, __builtin_amdgcn_cvt_pkrtz(a, b)); }
#define CVL(d, w) asm volatile("v_cvt_scalef32_pk_f16_fp8 %0, %1, 1.0" : "=v"(d) : "v"(w))
#define CVU(d, w) asm volatile("v_cvt_scalef32_pk_f16_fp8 %0, %1, 1.0 op_sel:[1,0,0]" : "=v"(d) : "v"(w))
#define D2H(a, x, h) asm volatile("v_dot2c_f32_f16 %0, %1, %2" : "+v"(a) : "v"(x), "v"(h))
#define PKF(f, x, w) asm volatile("v_pk_fma_f16 %0, %1, %2, %0" : "+v"(f) : "v"(x), "v"(w))
#define DOT2ROWS(accA, accB, ra, rb, hu) do { unsigned _t0, _t1, _t2, _t3, _t4, _t5, _t6, _t7, _s0, _s1, _s2, _s3, _s4, _s5, _s6, _s7; float _a2 = 0.f, _b2 = 0.f; \
    CVL(_t0, (ra).x); CVU(_t1, (ra).x); CVL(_t2, (ra).y); CVU(_t3, (ra).y); CVL(_t4, (ra).z); CVU(_t5, (ra).z); CVL(_t6, (ra).w); CVU(_t7, (ra).w); \
    CVL(_s0, (rb).x); CVU(_s1, (rb).x); CVL(_s2, (rb).y); CVU(_s3, (rb).y); CVL(_s4, (rb).z); CVU(_s5, (rb).z); CVL(_s6, (rb).w); CVU(_s7, (rb).w); \
    D2H(accA, _t0, hu[0]); D2H(accB, _s0, hu[0]); D2H(_a2, _t1, hu[1]); D2H(_b2, _s1, hu[1]); D2H(accA, _t2, hu[2]); D2H(accB, _s2, hu[2]); D2H(_a2, _t3, hu[3]); D2H(_b2, _s3, hu[3]); \
    D2H(accA, _t4, hu[4]); D2H(accB, _s4, hu[4]); D2H(_a2, _t5, hu[5]); D2H(_b2, _s5, hu[5]); D2H(accA, _t6, hu[6]); D2H(accB, _s6, hu[6]); \
      \
    asm volatile("v_dot2c_f32_f16 %2, %4, %6\n\tv_dot2c_f32_f16 %3, %5, %6\n\ts_nop 2\n\tv_add_f32 %0, %0, %2\n\tv_add_f32 %1, %1, %3" \
        : "+v"(accA), "+v"(accB), "+v"(_a2), "+v"(_b2) : "v"(_t7), "v"(_s7), "v"(hu[7])); } while (0)
#define AXPYROW(fu, wu, r) do { unsigned _t0, _t1, _t2, _t3, _t4, _t5, _t6, _t7; \
    CVL(_t0, (r).x); CVU(_t1, (r).x); CVL(_t2, (r).y); CVU(_t3, (r).y); CVL(_t4, (r).z); CVU(_t5, (r).z); CVL(_t6, (r).w); CVU(_t7, (r).w); \
    PKF(fu[0], _t0, wu); PKF(fu[1], _t1, wu); PKF(fu[2], _t2, wu); PKF(fu[3], _t3, wu); PKF(fu[4], _t4, wu); PKF(fu[5], _t5, wu); PKF(fu[6], _t6, wu); PKF(fu[7], _t7, wu); } while (0)
#define C4B0(d, w) asm volatile("v_cvt_scalef32_pk_f16_fp4 %0, %1, 1.0" : "=v"(d) : "v"(w))
#define C4B1(d, w) asm volatile("v_cvt_scalef32_pk_f16_fp4 %0, %1, 1.0 op_sel:[1,0,0]" : "=v"(d) : "v"(w))
#define C4B2(d, w) asm volatile("v_cvt_scalef32_pk_f16_fp4 %0, %1, 1.0 op_sel:[0,1,0]" : "=v"(d) : "v"(w))
#define C4B3(d, w) asm volatile("v_cvt_scalef32_pk_f16_fp4 %0, %1, 1.0 op_sel:[1,1,0]" : "=v"(d) : "v"(w))
#define C4ROW(T, r) do { C4B0(T[0], (r).x); C4B1(T[1], (r).x); C4B2(T[2], (r).x); C4B3(T[3], (r).x); C4B0(T[4], (r).y); C4B1(T[5], (r).y); C4B2(T[6], (r).y); C4B3(T[7], (r).y); \
    C4B0(T[8], (r).z); C4B1(T[9], (r).z); C4B2(T[10], (r).z); C4B3(T[11], (r).z); C4B0(T[12], (r).w); C4B1(T[13], (r).w); C4B2(T[14], (r).w); C4B3(T[15], (r).w); } while (0)
#define DOT2ROWS4(accA, accB, ra, rb, hu) do { unsigned _t[16], _s[16]; float _a2 = 0.f, _b2 = 0.f; C4ROW(_t, ra); C4ROW(_s, rb); \
    _Pragma("unroll") for (int _i = 0; _i < 14; _i += 2) { D2H(accA, _t[_i], hu[_i]); D2H(accB, _s[_i], hu[_i]); D2H(_a2, _t[_i + 1], hu[_i + 1]); D2H(_b2, _s[_i + 1], hu[_i + 1]); } \
    D2H(accA, _t[14], hu[14]); D2H(accB, _s[14], hu[14]); \
    asm volatile("v_dot2c_f32_f16 %2, %4, %6\n\tv_dot2c_f32_f16 %3, %5, %6\n\ts_nop 2\n\tv_add_f32 %0, %0, %2\n\tv_add_f32 %1, %1, %3" \
        : "+v"(accA), "+v"(accB), "+v"(_a2), "+v"(_b2) : "v"(_t[15]), "v"(_s[15]), "v"(hu[15])); } while (0)
#define AXPYROW4(fu, wu, r) do { unsigned _t[16]; C4ROW(_t, r); _Pragma("unroll") for (int _i = 0; _i < 16; ++_i) PKF(fu[_i], _t[_i], wu); } while (0)
__device__ __forceinline__ void slice_map(Frame& F, KArgs A, int& x0, int& nsl, int& w0, int& NW_) {
    if ((F.G % 8) != 0) { x0 = 0; nsl = 8; w0 = F.vcu * NWAVES + F.wave; NW_ = F.G * NWAVES; return; }
    unsigned* bar = (unsigned*)(ws_ + WS_CTL) + CW_BAR; bool even = true;
#pragma unroll
    for (int j = 0; j < 8; ++j) even = even && (xb_ld(&bar[XB_XCNT(j)]) == (unsigned)(F.G >> 3));
    const unsigned rk = ((volatile LAS unsigned*)(F.lds + MISC_OFF))[12], xcc = ((volatile LAS unsigned*)(F.lds + MISC_OFF))[13];
    const int sl = even ? (int)__builtin_amdgcn_readfirstlane(xcc) : (F.bx & 7), sub = even ? (int)__builtin_amdgcn_readfirstlane(rk) : (F.bx >> 3);
    x0 = sl; nsl = 1; w0 = sub * NWAVES + F.wave; NW_ = (F.G >> 3) * NWAVES;
}
__device__ __forceinline__ void slice_map4(Frame& F, KArgs A, int& x0, int& nsl, int& w0, int& NW_) {
    slice_map(F, A, x0, nsl, w0, NW_);
    if (nsl == 8) { nsl = 4; return; }
    const int sl = x0; x0 = sl >> 1; w0 += (sl & 1) * NW_; NW_ *= 2;
}
#define G_LOAD_E(E_, tt) do { const int* _ip = IDX + (size_t)(tt) * 128; _Pragma("unroll") for (int q = 0; q < 4; ++q) E_[q] = *(const v4u*)(_ip + 16u * gg + 4u * q); } while (0)
#define G_LOAD_R8(R_, Ea, Eb, tsl_) do { \
    R_[0] = *(const v4u*)((tsl_) + ((Ea).x * 128u + 16u * pp)); R_[1] = *(const v4u*)((tsl_) + ((Ea).y * 128u + 16u * pp)); \
    R_[2] = *(const v4u*)((tsl_) + ((Ea).z * 128u + 16u * pp)); R_[3] = *(const v4u*)((tsl_) + ((Ea).w * 128u + 16u * pp)); \
    R_[4] = *(const v4u*)((tsl_) + ((Eb).x * 128u + 16u * pp)); R_[5] = *(const v4u*)((tsl_) + ((Eb).y * 128u + 16u * pp)); \
    R_[6] = *(const v4u*)((tsl_) + ((Eb).z * 128u + 16u * pp)); R_[7] = *(const v4u*)((tsl_) + ((Eb).w * 128u + 16u * pp)); } while (0)
#define G_RING(r_, n_) ((r_) + (n_) >= 3 ? (r_) + (n_) - 3 : (r_) + (n_))
#define G_LOAD_R8L(R_, Ea, Eb, tsl_) do { \
    R_[0] = *(const v4u*)((tsl_) + ((Ea).x * 128u + 16u * pp)); R_[1] = *(const v4u*)((tsl_) + ((Ea).y * 128u + 16u * pp)); \
    R_[2] = *(const v4u*)((tsl_) + ((Ea).z * 128u + 16u * pp)); R_[3] = *(const v4u*)((tsl_) + ((Ea).w * 128u + 16u * pp)); \
    R_[4] = *(const v4u*)((tsl_) + ((Eb).x * 128u + 16u * pp)); R_[5] = *(const v4u*)((tsl_) + ((Eb).y * 128u + 16u * pp)); \
    R_[6] = *(const v4u*)((tsl_) + ((Eb).z * 128u + 16u * pp)); R_[7] = *(const v4u*)((tsl_) + ((Eb).w * 128u + 16u * pp)); } while (0)
__device__ __forceinline__ void op_gather_u(Frame& F, KArgs A, int layer, int nrows, bool dry) {
    const unsigned char* TU = ws_ + WS_TU + (size_t)layer * NEXP * 512;
    const int* IDX = (const int*)(ws_ + WS_IDX); const unsigned* HQ = (const unsigned*)(ws_ + WS_H8);
    unsigned* PACT = (unsigned*)(ws_ + (dry ? WS_G : WS_Z));
    int x0, nsl, w0, NW_; slice_map4(F, A, x0, nsl, w0, NW_);
    const unsigned pp0 = (unsigned)F.lane & 7u, gg0 = (unsigned)F.lane >> 3, ll0 = (unsigned)F.lane;
    const bool b0 = F.lane & 1, b1 = F.lane & 2, b2 = F.lane & 4;
    LAS unsigned* lE = (LAS unsigned*)(F.lds + F.wave * 4096 + 1024);
    LAS unsigned* lH = (LAS unsigned*)(F.lds + F.wave * 4096 + 2560);
    for (int xs = 0; xs < nsl; ++xs) {
        const int x = x0 + xs;
        const unsigned char* tsl = TU + (size_t)x * (NEXP * 128);
        const unsigned* Hx = HQ + x * 64;
        int t = w0;
        if (t >= nrows) continue;
        const int tlast = t + ((nrows - 1 - t) / NW_) * NW_;
        unsigned pp = pp0, gg = gg0, ll = ll0; asm volatile("" : "+v"(pp), "+v"(gg), "+v"(ll));
        v4u R0[8], R1[8]; v2u eraw; unsigned hraw;
#define G1_GLOAD(tt) do { const int _t = (tt) < tlast ? (tt) : tlast; eraw = *(const v2u*)(IDX + (size_t)_t * 128 + 2u * ll); hraw = Hx[(size_t)_t * 256 + ll]; } while (0)
#define G1_LWRITE(r_) do { *(LAS v2u*)(lE + (r_) * 128 + 2u * ll) = eraw; lH[(r_) * 64 + ll] = hraw; } while (0)
        G1_GLOAD(t); G1_LWRITE(0); G1_GLOAD(t + NW_); G1_LWRITE(1); G1_GLOAD(t + 2 * NW_);
        { const v4u e0 = *(const LAS v4u*)(lE + 16u * gg), e1 = *(const LAS v4u*)(lE + 16u * gg + 4u); G_LOAD_R8L(R0, e0, e1, tsl); }
        int r = 0;
        while (t < nrows) {
            const int tn = t + NW_;
            pp = pp0; gg = gg0; ll = ll0; asm volatile("" : "+v"(pp), "+v"(gg), "+v"(ll));
            const unsigned k0 = 16u * gg + ((pp & 1u) << 3) + ((pp & 2u) << 1) + ((pp & 4u) >> 1);
            const int r1 = G_RING(r, 1), r2 = G_RING(r, 2);
            G1_LWRITE(r2);
            G1_GLOAD(t + 3 * NW_);
            const v4u ea0 = *(const LAS v4u*)(lE + r * 128 + 16u * gg + 8u), ea1 = *(const LAS v4u*)(lE + r * 128 + 16u * gg + 12u);
            const v4u eb0 = *(const LAS v4u*)(lE + r1 * 128 + 16u * gg), eb1 = *(const LAS v4u*)(lE + r1 * 128 + 16u * gg + 4u);
            const v4u ha = *(const LAS v4u*)(lH + r * 64 + 4u * pp), hb = *(const LAS v4u*)(lH + r * 64 + 32u + 4u * pp);
            G_LOAD_R8L(R1, ea0, ea1, tsl);
            int hs;
            { int sa = __builtin_amdgcn_sdot8((int)ha.x, 0x11111111, 0, false); sa = __builtin_amdgcn_sdot8((int)ha.y, 0x11111111, sa, false); sa = __builtin_amdgcn_sdot8((int)ha.z, 0x11111111, sa, false); sa = __builtin_amdgcn_sdot8((int)ha.w, 0x11111111, sa, false);
              int sb = __builtin_amdgcn_sdot8((int)hb.x, 0x11111111, 0, false); sb = __builtin_amdgcn_sdot8((int)hb.y, 0x11111111, sb, false); sb = __builtin_amdgcn_sdot8((int)hb.z, 0x11111111, sb, false); sb = __builtin_amdgcn_sdot8((int)hb.w, 0x11111111, sb, false);
              hs = (sa << 4) + sb; }
            unsigned a[16];
#define G1_ROW(R_) ({ int _a = __builtin_amdgcn_sdot8((int)(R_).x, (int)ha.x, 0, false), _b = __builtin_amdgcn_sdot8((int)(R_).x, (int)hb.x, 0, false); \
            _a = __builtin_amdgcn_sdot8((int)(R_).y, (int)ha.y, _a, false); _b = __builtin_amdgcn_sdot8((int)(R_).y, (int)hb.y, _b, false); \
            _a = __builtin_amdgcn_sdot8((int)(R_).z, (int)ha.z, _a, false); _b = __builtin_amdgcn_sdot8((int)(R_).z, (int)hb.z, _b, false); \
            _a = __builtin_amdgcn_sdot8((int)(R_).w, (int)ha.w, _a, false); _b = __builtin_amdgcn_sdot8((int)(R_).w, (int)hb.w, _b, false); \
            (unsigned)((((_a << 4) + _b) << 1) + hs); })
#pragma unroll
            for (int i = 0; i < 8; ++i) a[i] = G1_ROW(R0[i]);
            G_LOAD_R8L(R0, eb0, eb1, tsl);
#pragma unroll
            for (int i = 0; i < 8; ++i) a[8 + i] = G1_ROW(R1[i]);
#undef G1_ROW
            unsigned a8[8], a4[4], a2[2];
#pragma unroll
            for (int i = 0; i < 8; ++i) { const unsigned mine = b0 ? a[8 + i] : a[i], send = b0 ? a[i] : a[8 + i]; a8[i] = mine + shx_u<1>(send); }
#pragma unroll
            for (int i = 0; i < 4; ++i) { const unsigned mine = b1 ? a8[4 + i] : a8[i], send = b1 ? a8[i] : a8[4 + i]; a4[i] = mine + shx_u<2>(send); }
#pragma unroll
            for (int i = 0; i < 2; ++i) { const unsigned mine = b2 ? a4[2 + i] : a4[i], send = b2 ? a4[i] : a4[2 + i]; a2[i] = mine + shx_u<4>(send); }
            PACT[((size_t)x * NTOK + t) * 64 + (k0 >> 1)] = h2u(pkh((float)(int)a2[0] * (1.f / 32.f), (float)(int)a2[1] * (1.f / 32.f)));
            r = r1; t = tn;
        }
#undef G1_GLOAD
#undef G1_LWRITE
        LDS_WAIT(); asm volatile("" ::: "memory");
    }
}
#define G2_TR4(y0, y1, y2, y3, x0, x1, x2, x3) do { const unsigned _t0 = __builtin_amdgcn_perm(x1, x0, 0x05010400u), _t1 = __builtin_amdgcn_perm(x1, x0, 0x07030602u), \
    _t2 = __builtin_amdgcn_perm(x3, x2, 0x05010400u), _t3 = __builtin_amdgcn_perm(x3, x2, 0x07030602u); \
    y0 = __builtin_amdgcn_perm(_t2, _t0, 0x05040100u); y1 = __builtin_amdgcn_perm(_t2, _t0, 0x07060302u); y2 = __builtin_amdgcn_perm(_t3, _t1, 0x05040100u); y3 = __builtin_amdgcn_perm(_t3, _t1, 0x07060302u); } while (0)
#define G2_QUAD(Ra, Rb, Rc, Rd, W_) do { _Pragma("unroll") for (int _d = 0; _d < 4; ++_d) { unsigned _y0, _y1, _y2, _y3; G2_TR4(_y0, _y1, _y2, _y3, (Ra)[_d], (Rb)[_d], (Rc)[_d], (Rd)[_d]); \
    aT[4 * _d] = __builtin_amdgcn_sdot4((int)_y0, (int)(W_), aT[4 * _d], false); aL[4 * _d] = __builtin_amdgcn_sdot4((int)(_y0 & 0x0f0f0f0fu), (int)(W_), aL[4 * _d], false); \
    aT[4 * _d + 1] = __builtin_amdgcn_sdot4((int)_y1, (int)(W_), aT[4 * _d + 1], false); aL[4 * _d + 1] = __builtin_amdgcn_sdot4((int)(_y1 & 0x0f0f0f0fu), (int)(W_), aL[4 * _d + 1], false); \
    aT[4 * _d + 2] = __builtin_amdgcn_sdot4((int)_y2, (int)(W_), aT[4 * _d + 2], false); aL[4 * _d + 2] = __builtin_amdgcn_sdot4((int)(_y2 & 0x0f0f0f0fu), (int)(W_), aL[4 * _d + 2], false); \
    aT[4 * _d + 3] = __builtin_amdgcn_sdot4((int)_y3, (int)(W_), aT[4 * _d + 3], false); aL[4 * _d + 3] = __builtin_amdgcn_sdot4((int)(_y3 & 0x0f0f0f0fu), (int)(W_), aL[4 * _d + 3], false); } } while (0)
#define G2_D0(d, y, w) asm volatile("v_dot4_i32_i8 %0, %1, %2, 0" : "=v"(d) : "v"(y), "v"(w))
#define G2_QUAD0(Ra, Rb, Rc, Rd, W_) do { _Pragma("unroll") for (int _d = 0; _d < 4; ++_d) { unsigned _y0, _y1, _y2, _y3; G2_TR4(_y0, _y1, _y2, _y3, (Ra)[_d], (Rb)[_d], (Rc)[_d], (Rd)[_d]); \
    const unsigned _m0 = _y0 & 0x0f0f0f0fu, _m1 = _y1 & 0x0f0f0f0fu, _m2 = _y2 & 0x0f0f0f0fu, _m3 = _y3 & 0x0f0f0f0fu; \
    G2_D0(aT[4 * _d], _y0, W_); G2_D0(aL[4 * _d], _m0, W_); G2_D0(aT[4 * _d + 1], _y1, W_); G2_D0(aL[4 * _d + 1], _m1, W_); \
    G2_D0(aT[4 * _d + 2], _y2, W_); G2_D0(aL[4 * _d + 2], _m2, W_); G2_D0(aT[4 * _d + 3], _y3, W_); G2_D0(aL[4 * _d + 3], _m3, W_); } } while (0)
__device__ __forceinline__ void op_gather_v(Frame& F, KArgs A, int layer, int nrows, bool dry) {
    const unsigned char* TV = ws_ + WS_TV + (size_t)layer * NEXP * 512;
    const int* IDX = (const int*)(ws_ + WS_IDX); const f32x4* SG = (const f32x4*)(ws_ + WS_SG); const unsigned* PACT = (const unsigned*)(ws_ + WS_Z);
    unsigned* X = (unsigned*)(ws_ + WS_X); unsigned* Xw = dry ? (unsigned*)(ws_ + WS_Z + 80 * MiB) : X;
    const float* modl = (const float*)(ws_ + WS_MOD) + (size_t)layer * 9 * MODW;
    LAS unsigned* wl = (LAS unsigned*)(F.lds + F.wave * 4096);
    LAS unsigned* lE = (LAS unsigned*)(F.lds + F.wave * 4096 + 1024);
    int x0, nsl, w0, NW_; slice_map4(F, A, x0, nsl, w0, NW_);
    const unsigned pp0 = (unsigned)F.lane & 7u, gg0 = (unsigned)F.lane >> 3, ll0 = (unsigned)F.lane;
    const bool b3 = F.lane & 8, b4 = F.lane & 16, b5 = F.lane & 32;
    for (int xs = 0; xs < nsl; ++xs) {
        const int x = x0 + xs;
        const unsigned char* tsl = TV + (size_t)x * (NEXP * 128);
        int t = w0;
        if (t >= nrows) continue;
        const int tlast = t + ((nrows - 1 - t) / NW_) * NW_;
        v4u R0[8], R1[8]; v2u eraw;
        unsigned pp = pp0, gg = gg0, ll = ll0; asm volatile("" : "+v"(pp), "+v"(gg), "+v"(ll));
        unsigned pw[4]; f32x4 psg;
        float swc, swn;
#define G2_LOAD_W(tt) do { const int _t = (tt) < tlast ? (tt) : tlast; const unsigned* _pa = PACT + (size_t)_t * 64; \
        _Pragma("unroll") for (int xx = 0; xx < 4; ++xx) pw[xx] = _pa[(size_t)xx * NTOK * 64 + ll]; \
        psg = SG[(size_t)_t * 64 + ll]; } while (0)
#define G2_MAKE_W(buf, sw_) do { float s0 = 0.f, s1 = 0.f; _Pragma("unroll") for (int xx = 0; xx < 4; ++xx) { const h2_t _h = u2h(pw[xx]); s0 += (float)_h.x; s1 += (float)_h.y; } \
        const float _w0 = pg8::gelu1(s0 * psg.x) * psg.y, _w1 = pg8::gelu1(s1 * psg.z) * psg.w; \
        const float _m = wave_max(fmaxf(fabsf(_w0), fabsf(_w1))), _inv = _m > 0.f ? 127.f / _m : 0.f; \
        const int _q0 = (int)__builtin_rintf(_w0 * _inv), _q1 = (int)__builtin_rintf(_w1 * _inv); \
        *((LAS unsigned short*)(wl + (buf) * 32) + ll) = (unsigned short)(((unsigned)_q0 & 255u) | (((unsigned)_q1 & 255u) << 8)); sw_ = _m * (1.f / 127.f); } while (0)
#define G2_GLOAD(tt) do { const int _t = (tt) < tlast ? (tt) : tlast; eraw = *(const v2u*)(IDX + (size_t)_t * 128 + 2u * ll); } while (0)
#define G2_LWRITE(r_) do { *(LAS v2u*)(lE + (r_) * 128 + 2u * ll) = eraw; } while (0)
        G2_GLOAD(t); G2_LWRITE(0); G2_GLOAD(t + NW_); G2_LWRITE(1); G2_GLOAD(t + 2 * NW_);
        G2_LOAD_W(t);
        { const v4u e0 = *(const LAS v4u*)(lE + 16u * gg), e1 = *(const LAS v4u*)(lE + 16u * gg + 4u); G_LOAD_R8L(R0, e0, e1, tsl); }
        G2_MAKE_W(0, swc);
        int buf = 0, r = 0;
        while (t < nrows) {
            const int tn = t + NW_; const int mr = t < NLAT ? (t >> 11) : 8;
            pp = pp0; gg = gg0; ll = ll0; asm volatile("" : "+v"(pp), "+v"(gg), "+v"(ll));
            const unsigned colb = (unsigned)x * 256u + 32u * pp + ((gg & 1u) << 4) + ((gg & 2u) << 2) + (gg & 4u);
            const int r1 = G_RING(r, 1), r2 = G_RING(r, 2);
            G2_LWRITE(r2);
            G2_GLOAD(t + 3 * NW_);
            const v4u ea0 = *(const LAS v4u*)(lE + r * 128 + 16u * gg + 8u), ea1 = *(const LAS v4u*)(lE + r * 128 + 16u * gg + 12u);
            const v4u eb0 = *(const LAS v4u*)(lE + r1 * 128 + 16u * gg), eb1 = *(const LAS v4u*)(lE + r1 * 128 + 16u * gg + 4u);
            G_LOAD_R8L(R1, ea0, ea1, tsl);
            G2_LOAD_W(tn);
            const f32x4 gt2 = *(const f32x4*)(modl + mr * MODW + 5 * DM + colb);
            const v2u xo = *(const v2u*)(X + (((size_t)t * DM + colb) >> 1));
            LDS_WAIT(); asm volatile("" ::: "memory");
            const v4u wq = *(const LAS v4u*)(wl + buf * 32 + 4u * gg);
            int aT[16], aL[16];
            G2_QUAD0(R0[0], R0[1], R0[2], R0[3], wq.x); G2_QUAD(R0[4], R0[5], R0[6], R0[7], wq.y);
            G_LOAD_R8L(R0, eb0, eb1, tsl);
            G2_QUAD(R1[0], R1[1], R1[2], R1[3], wq.z); G2_QUAD(R1[4], R1[5], R1[6], R1[7], wq.w);
            int sw = __builtin_amdgcn_sdot4((int)wq.x, 0x01010101, 0, false); sw = __builtin_amdgcn_sdot4((int)wq.y, 0x01010101, sw, false);
            sw = __builtin_amdgcn_sdot4((int)wq.z, 0x01010101, sw, false); sw = __builtin_amdgcn_sdot4((int)wq.w, 0x01010101, sw, false);
            sw += (int)shx_u<8>((unsigned)sw); sw += (int)shx_u<16>((unsigned)sw); sw += (int)shx32_u((unsigned)sw, b5);
            unsigned T8[8], T4[4], T2[2], L8[8], L4[4], L2[2];
#pragma unroll
            for (int i = 0; i < 8; ++i) { const unsigned mt = (unsigned)(b3 ? aT[8 + i] : aT[i]), st = (unsigned)(b3 ? aT[i] : aT[8 + i]); T8[i] = mt + shx_u<8>(st);
                                          const unsigned ml = (unsigned)(b3 ? aL[8 + i] : aL[i]), sl = (unsigned)(b3 ? aL[i] : aL[8 + i]); L8[i] = ml + shx_u<8>(sl); }
#pragma unroll
            for (int i = 0; i < 4; ++i) { const unsigned mt = b4 ? T8[4 + i] : T8[i], st = b4 ? T8[i] : T8[4 + i]; T4[i] = mt + shx_u<16>(st);
                                          const unsigned ml = b4 ? L8[4 + i] : L8[i], sl = b4 ? L8[i] : L8[4 + i]; L4[i] = ml + shx_u<16>(sl); }
#pragma unroll
            for (int i = 0; i < 2; ++i) { const unsigned mt = b5 ? T4[2 + i] : T4[i], st = b5 ? T4[i] : T4[2 + i]; T2[i] = mt + shx32_u(st, b5);
                                          const unsigned ml = b5 ? L4[2 + i] : L4[i], sl = b5 ? L4[i] : L4[2 + i]; L2[i] = ml + shx32_u(sl, b5); }
            const float hsc = 0.5f * swc;
            const float o0 = (float)(2 * (int)L2[0] - 15 * sw) * hsc, o1 = (float)((((int)T2[0] - (int)L2[0]) >> 3) + sw) * hsc;
            const float o2 = (float)(2 * (int)L2[1] - 15 * sw) * hsc, o3 = (float)((((int)T2[1] - (int)L2[1]) >> 3) + sw) * hsc;
            { v2u xn; xn.x = pk2(bflo(xo.x) + gt2[0] * o0, bfhi(xo.x) + gt2[1] * o1); xn.y = pk2(bflo(xo.y) + gt2[2] * o2, bfhi(xo.y) + gt2[3] * o3);
              *(v2u*)(Xw + (((size_t)t * DM + colb) >> 1)) = xn; }
            G2_MAKE_W(1 - buf, swn);
            swc = swn;
            buf = 1 - buf; r = r1; t = tn;
        }
#undef G2_LOAD_W
#undef G2_MAKE_W
#undef G2_GLOAD
#undef G2_LWRITE
        LDS_WAIT(); asm volatile("" ::: "memory");
    }
}

constexpr int SPL = 11;
constexpr int NSTEPS = 2 + SPL * DEPTH;
#ifndef DIS
#define DIS 0
#endif
#ifndef ZB
#define ZB 0
#endif
#define EN(n) (!((DIS >> (n)) & 1))
__device__ __forceinline__ bool run_step(Frame& F, KArgs A, int step, bool dry) {
    unsigned char* ws = ws_;
    bf16* X = (bf16*)(ws + WS_X); const float* MOD = (const float*)(ws + WS_MOD);
    bf16* H = (bf16*)(ws + WS_H);
    if (step == 0) { if (EN(0)) op_prep(F, A); return true; }
    if (step == 1) { if (EN(1)) op_modulate(F, A, A->in[I_X], A->in[I_CTX], nullptr, A->in[I_N1G], MOD, 0, NTOK, false); }
    const int layer = (step - 2) / SPL, k = (step - 2) % SPL, kind = layer % 3, jj = layer / 3;
    const int nrows = (layer == DEPTH - 1) ? NLAT : NTOK, nM = nrows / 256;
    const float* modl = MOD + (size_t)layer * 9 * MODW;
    if (k == 1) { if (kind == 0) { if (EN(4)) op_spatial(F, A, jj, nrows); } else if (kind == 1) { if (EN(5)) op_pool(F, A, nrows); } else { if (EN(6)) op_qknorm(F, A, nrows); } return true; }
    if (k == 2 && kind == 0) return false;
    if (k == 2 && kind == 2) { if (EN(8)) op_attn(F, A); return true; }
    if (k == 4) { if (EN(10)) op_modulate(F, A, nullptr, nullptr, X, A->in[I_N2G] + layer * DM, modl, 3, nrows, false, true); return true; }
    if (k == 7) { if (EN(13)) op_topk(F, A, layer, nrows); return true; }
    if (k == 8) { if (EN(14)) op_gather_u(F, A, layer, nrows, dry); return true; }
    if (k == 9) { if (EN(14)) op_gather_v(F, A, layer, nrows, dry); return true; }
    if (k == 10) {
        if (layer == DEPTH - 1) op_modulate(F, A, nullptr, nullptr, X, A->in[I_FINAL_G], modl, 0, NLAT, true);
        else op_modulate(F, A, nullptr, nullptr, X, A->in[I_N1G] + (layer + 1) * DM, modl + 9 * MODW, 0, (layer == DEPTH - 2) ? NLAT : NTOK, false);
        return true; }
    if (k == 6) return false;
    const int nrep = (k == 0 && kind == 0) ? 2 : 1;
    for (int rep = 0; rep < nrep; ++rep) {
        pg8::Gemm g; pg8::EpiAny E;
        g.A = H; g.lda = DM; g.K = DM; g.nM = nM; g.nN = 4; g.a_pm = 256 * DM; g.a_pn = 0; g.Bt = H; g.ldb = DM; g.b_pm = 0; g.b_pn = 256 * DM;
        E.type = 0; E.perm = true; E.O = (void*)(ws + WS_Z); E.ldc = DM; E.act = 0; E.mul = nullptr; E.o_pm = 0; E.o_pn = 256;
        E.srcLat = nullptr; E.srcCtx = nullptr; E.X = (void*)X; E.Xsrc = (const void*)X; E.modl = modl; E.nlat = NLAT; E.chunk = 2; E.SS = (float*)(ws + WS_SS); if (dry) E.X = (void*)(ws + WS_Z); E.gs = ((ZB >> kind) & 1) ? 0.f : 1.f;
        if (k < 0) {
            g.A = (const bf16*)(ws + WS_KB); g.lda = 256; g.K = 256; g.nM = DEPTH * 8; g.nN = 4; g.a_pm = 65536; g.a_pn = 0;
            g.Bt = (const bf16*)(ws + WS_G); g.ldb = 256; g.b_pm = 1024 * 256; g.b_pn = 65536;
            E.O = (void*)(ws + WS_WPQ); E.ldc = DM;
        } else if (k == 0) {
            if (kind == 0 && rep == 0) { g.Bt = (const bf16*)(ws + WS_WSGUIN) + (size_t)jj * 4096 * 1024; g.nN = 8; E.ldc = SGUW; E.act = 1; }
            else if (kind == 0) {
                g.A = (const bf16*)(ws + WS_WSGUIN) + (size_t)jj * 4096 * 1024 + (size_t)2048 * 1024; g.nM = 8; g.nN = nM; g.Bt = H;
                E.type = 3; E.O = (void*)((bf16*)(ws + WS_Z) + (size_t)NTOK * SGUW); E.ldc = NTOK; }
            else if (kind == 1) { g.Bt = (const bf16*)(ws + WS_WPOOLIN); g.nN = 4; E.ldc = DM; }
            else { g.Bt = (const bf16*)(ws + WS_WQKV); g.nN = 6; E.ldc = 1536; }
        } else if (k == 2) {
            g.A = (const bf16*)(ws + WS_G); g.K = 256; g.a_pn = 256; g.Bt = (const bf16*)(ws + WS_WGRP); g.ldb = 256; g.b_pn = 65536;
            E.O = (void*)H; E.ldc = DM; E.mul = A->in[I_POOL_SCALE];
        } else if (k == 3) {
            if (kind == 0) { g.A = (const bf16*)(ws + WS_G); g.lda = SGUW; g.K = SGUW; g.Bt = (const bf16*)(ws + WS_WSGUOUT) + (size_t)jj * 1024 * 2048; }
            else if (kind == 1) { g.Bt = (const bf16*)(ws + WS_WPOOLOUT); }
            else { g.Bt = (const bf16*)(ws + WS_WO); }
            g.ldb = g.K; g.a_pm = 256 * (long)g.lda; g.b_pn = 256 * (long)g.ldb;
            E.type = 2; E.perm = true; E.srcLat = layer == 0 ? A->in[I_X] : nullptr; E.srcCtx = layer == 0 ? A->in[I_CTX] : nullptr;
        } else {
            g.nN = 8; g.Bt = (const bf16*)(ws + WS_WPQ) + (size_t)layer * 2048 * 1024; E.act = 2; E.O = (void*)(ws + WS_Z); E.ldc = 2048;
        }
        E.o_pm = 256 * (long)E.ldc;
        pg8::StaticOrder S; S.init(g.nM, g.nN, F.G, F.bx);
        if (EN(2)) pg8::gemm_phase<true>(F.lds, g, S, E, F.tid);
    }
    return true;
}

__global__ void __launch_bounds__(NWAVES * 64, 2) mega_fwd(Args args) {
    extern __shared__ __attribute__((aligned(16))) unsigned char lds[];
    for (int u = threadIdx.x; u < (LDS_BYTES - LDSCTL_OFF) / 4; u += NWAVES * 64) ((LAS unsigned*)((LAS unsigned char*)lds + LDSCTL_OFF))[u] = 0u;
    __syncthreads();
    { const unsigned hw = (unsigned)__builtin_amdgcn_s_getreg((5 << 11) | 4) & 63u;
      if ((threadIdx.x & 63) == 0) ((LAS unsigned*)((LAS unsigned char*)lds + WSLOT_OFF))[hw] = threadIdx.x >> 6; }
    const int lo = args.lo, hi = args.hi;
    if (hi - lo > 1 && threadIdx.x == 0) {
        const unsigned xcc = xb_xcc_id(); const unsigned rk = xb_add((unsigned*)(args.ws + WS_CTL) + CW_BAR + XB_XCNT(xcc), 1u);
        ((LAS unsigned*)((LAS unsigned char*)lds + MISC_OFF))[12] = rk; ((LAS unsigned*)((LAS unsigned char*)lds + MISC_OFF))[13] = xcc; }
    __syncthreads();
    for (int step = lo; step < hi; ++step) {
        KArgs kp = (KArgs)__builtin_amdgcn_kernarg_segment_ptr();
        asm volatile("" : "+s"(kp));
        int g_ = gridDim.x, bx_ = blockIdx.x; unsigned lo_ = 0;
        asm volatile("" : "+s"(g_), "+s"(bx_), "+s"(lo_));
        Frame F;
        F.lds = (LAS unsigned char*)lds + lo_;
        const unsigned hw = (unsigned)__builtin_amdgcn_s_getreg((5 << 11) | 4) & 63u;
        F.wave = __builtin_amdgcn_readfirstlane(((volatile LAS unsigned*)(F.lds + WSLOT_OFF))[hw]);
        F.lane = (int)__builtin_amdgcn_mbcnt_hi(~0u, __builtin_amdgcn_mbcnt_lo(~0u, 0u)); asm volatile("" : "+v"(F.lane));
        F.tid = F.wave * 64 + F.lane;
        F.G = g_; F.bx = bx_; F.vcu = (g_ % 8 == 0) ? (bx_ % 8) * (g_ / 8) + bx_ / 8 : bx_;
        const int kcls = step < 2 ? 11 + step : (step - 2) % SPL;
        bool dry = ((REPK >> kcls) & 1) != 0 && (step < 2 || ((REPL >> ((step - 2) / SPL)) & 1));
        bool did = run_step(F, kp, step, dry);
        if (dry) {
            XcdBarrier bar; bar.bar = (unsigned*)(kp->ws + WS_CTL) + CW_BAR; bar.x = xb_xcc_id(); bar.st = (volatile LAS unsigned*)(F.lds + MISC_OFF) + 8;
            if (did) xcd_barrier(bar, F.tid);
            did = run_step(F, kp, step, false);
        }
        if (did && step + 1 < hi) {
            XcdBarrier bar; bar.bar = (unsigned*)(kp->ws + WS_CTL) + CW_BAR; bar.x = xb_xcc_id(); bar.st = (volatile LAS unsigned*)(F.lds + MISC_OFF) + 8;
            xcd_barrier(bar, F.tid);
        }
    }
}

extern "C" void kernel_launch(void* const* d_in, const int* in_sizes, int n_in, void* d_out, int out_size, void* d_ws, size_t ws_size, hipStream_t stream) {
    static int grid = 0;
    if (grid == 0) {
        if (n_in != N_IN || out_size != NLAT * DM || ws_size < WS_END) { fprintf(stderr, "kernel_launch: unexpected shapes: n_in %d out %d ws %zu (need >= %zu)\n", n_in, out_size, ws_size, (size_t)WS_END); grid = -1; return; }
        int dev = 0, cus = 0, per_cu = 0;
        if (hipGetDevice(&dev) != hipSuccess || hipDeviceGetAttribute(&cus, hipDeviceAttributeMultiprocessorCount, dev) != hipSuccess) { grid = -1; return; }
        if (hipFuncSetAttribute((const void*)mega_fwd, hipFuncAttributeMaxDynamicSharedMemorySize, LDS_BYTES) != hipSuccess) { fprintf(stderr, "kernel_launch: hipFuncSetAttribute failed\n"); grid = -1; return; }
        if (hipOccupancyMaxActiveBlocksPerMultiprocessor(&per_cu, (const void*)mega_fwd, NWAVES * 64, LDS_BYTES) != hipSuccess || per_cu < 1) { fprintf(stderr, "kernel_launch: occupancy query says %d\n", per_cu); (void)hipGetLastError(); grid = -1; return; }
        grid = cus;
    }
    if (grid < 0) return;
    (void)hipMemsetAsync((char*)d_ws + WS_CTL, 0, CTL_ZERO_BYTES, stream);
    Args a{};
    for (int i = 0; i < N_IN; ++i) a.in[i] = (const float*)d_in[i];
    a.out = (float*)d_out; a.ws = (unsigned char*)d_ws;
#if MK_MULTI
    for (int s = 0; s < NSTEPS; ++s) { a.lo = s; a.hi = s + 1; hipLaunchKernelGGL(mega_fwd, dim3(grid), dim3(NWAVES * 64), LDS_BYTES, stream, a); }
#else
    a.lo = 0; a.hi = NSTEPS;
    void* kargs[] = {&a};
    hipError_t e = hipLaunchCooperativeKernel((const void*)mega_fwd, dim3(grid), dim3(NWAVES * 64), kargs, LDS_BYTES, stream);
    if (e != hipSuccess) { fprintf(stderr, "kernel_launch: cooperative launch failed: %s\n", hipGetErrorString(e)); (void)hipGetLastError();
        hipLaunchKernelGGL(mega_fwd, dim3(grid), dim3(NWAVES * 64), LDS_BYTES, stream, a); }
#endif
}
```

```cpp
#include <hip/hip_runtime.h>
#include <hip/hip_bf16.h>
#include <cstdio>
#include <cstdint>

#ifndef MK_MULTI
#define MK_MULTI 0
#endif
#ifndef PEER_SCALE
#define PEER_SCALE 1.0f
#endif
#ifndef REPL
#define REPL 15
#endif
#ifndef PREPREP
#define PREPREP 0
#endif
#ifndef GVAR
#define GVAR 0
#endif
#ifndef EMASK
#define EMASK 0xffffffff
#endif
#ifndef REPK
#define REPK 0
#endif
#ifndef TOPK_REF
#define TOPK_REF 0
#endif
#ifndef GATHER_REF
#define GATHER_REF 0
#endif
#ifndef ZB
#define ZB 0
#endif

template <int M> __device__ __forceinline__ unsigned shx_u(unsigned v) {
    if (M == 1) return (unsigned)__builtin_amdgcn_mov_dpp((int)v, 0xB1, 0xf, 0xf, true);
    if (M == 2) return (unsigned)__builtin_amdgcn_mov_dpp((int)v, 0x4E, 0xf, 0xf, true);
    if (M == 8) return (unsigned)__builtin_amdgcn_mov_dpp((int)v, 0x128, 0xf, 0xf, true);
    return (unsigned)__builtin_amdgcn_ds_swizzle((int)v, (M << 10) | 0x1f);
}
template <int M> __device__ __forceinline__ float shx(float v) { return __uint_as_float(shx_u<M>(__float_as_uint(v))); }
__device__ __forceinline__ unsigned shx32_u(unsigned v, bool upper) {
    auto r = __builtin_amdgcn_permlane32_swap(v, v, false, false); return upper ? r[0] : r[1]; }
__device__ __forceinline__ float shx32(float v, bool upper) { return __uint_as_float(shx32_u(__float_as_uint(v), upper)); }
__device__ __forceinline__ float bperm(int srcLane, float v) { return __uint_as_float((unsigned)__builtin_amdgcn_ds_bpermute(srcLane << 2, (int)__float_as_uint(v))); }
__device__ __forceinline__ int bperm_i(int srcLane, int v) { return __builtin_amdgcn_ds_bpermute(srcLane << 2, v); }
namespace pg8 {
#define PG8_LAS __attribute__((address_space(3)))
typedef unsigned short bf16_t;
typedef short bf16x8 __attribute__((ext_vector_type(8)));
typedef float f32x4 __attribute__((ext_vector_type(4)));
typedef float f32x2 __attribute__((ext_vector_type(2)));
typedef unsigned u32x4 __attribute__((ext_vector_type(4)));
typedef unsigned u32x2 __attribute__((ext_vector_type(2)));
constexpr int BM = 256, BK = 64, HALF = 128, HTB = HALF * BK * 2, STAGE_BYTES = 8 * HTB, NXCD = 8, WGM = 8;

__host__ __device__ __forceinline__ int lds_byte(int r, int c) { const int st = (r >> 4) * 2 + (c >> 5), rr = r & 15, cc = c & 31, ob = rr * 64 + cc * 2; return st * 1024 + (ob ^ (((ob >> 9) & 1) << 5)); }
__host__ __device__ __forceinline__ void stage_rc(int b, int& R, int& C) { const int st = b / 1024, sb = b % 1024, swz = sb ^ (((sb >> 9) & 1) << 5); R = (st >> 1) * 16 + swz / 64; C = (st & 1) * 32 + (swz % 64) / 2; }
__host__ __device__ __forceinline__ int perm32(int rho) { const int n = rho >> 4, i = rho & 15; return 8 * (i >> 2) + 4 * n + (i & 3); }

struct Unit { int pm, pn; };
struct Gemm { const bf16_t* A; const bf16_t* Bt; int lda, ldb, K, nM, nN; long a_pm, a_pn, b_pm, b_pn; };

struct StaticOrder {
    int nM, nN, nwg, G, c;
    __host__ __device__ void init(int nM_, int nN_, int G_, int c_) { nM = nM_; nN = nN_; nwg = nM * nN; G = G_; c = c_; }
    __host__ __device__ bool next(int i, Unit& u) const {
        const long L = (long)i * G + c; if (L >= nwg) return false;
        int wgid = (int)L; { const int q = nwg / NXCD, r = nwg % NXCD, xcd = wgid % NXCD, off = wgid / NXCD; wgid = (xcd < r ? xcd * (q + 1) : r * (q + 1) + (xcd - r) * q) + off; }
        const int nig = WGM * nN, gid = wgid / nig, fm = gid * WGM, gsz = (nM - fm) < WGM ? (nM - fm) : WGM;
        u.pm = fm + ((wgid % nig) % gsz); u.pn = (wgid % nig) / gsz; return true;
    }
};

__device__ __forceinline__ unsigned cvt_pk_bf16(float lo, float hi) { unsigned r; asm volatile("v_cvt_pk_bf16_f32 %0, %1, %2" : "=v"(r) : "v"(lo), "v"(hi)); return r; }
__device__ __forceinline__ f32x2 gelu_pk(f32x2 v) {
    const f32x2 av = __builtin_elementwise_abs(v), d = av * 0.2316418882f + 1.0f;
    f32x2 t; t.x = __builtin_amdgcn_rcpf(d.x); t.y = __builtin_amdgcn_rcpf(d.y);
    f32x2 q = t * 0.5307027145f + (-0.7265760135f); q = q * t + 0.7107068705f; q = q * t + (-0.142248368f); q = q * t + 0.127414796f; q = q * t;
    const f32x2 s = (v * v) * (-0.72134752044f);
    f32x2 e; e.x = __builtin_amdgcn_exp2f(s.x); e.y = __builtin_amdgcn_exp2f(s.y);
    const f32x2 m = v * (q * e), r = v - m;
    f32x2 o; o.x = v.x < 0.f ? m.x : r.x; o.y = v.y < 0.f ? m.y : r.y; return o;
}
__device__ __forceinline__ float gelu1(float v) { f32x2 r = gelu_pk((f32x2){v, v}); return r.x; }
__device__ __forceinline__ f32x4 gelu4(f32x4 v) { f32x2 a = gelu_pk((f32x2){v[0], v[1]}), b = gelu_pk((f32x2){v[2], v[3]}); return (f32x4){a.x, a.y, b.x, b.y}; }

struct EpiAny {
    int type;
    bool perm;
    void* O; int ldc; int act; const float* mul; long o_pm, o_pn;
    const float* srcLat; const float* srcCtx; void* X; const void* Xsrc; const float* modl; int nlat; int chunk;
    float* SS;
    float gs;
    __device__ __forceinline__ void bf16_store(const f32x4 (&acc)[2][2][4][2], const Unit& u, int wr, int wc, int fr, int fq) const {
        bf16_t* base = (bf16_t*)O + u.pm * o_pm + u.pn * o_pn;
        const int row0 = wr * 64 + fr, col0 = wc * 32 + 8 * fq;
        f32x4 mv[2][2];
#pragma unroll
        for (int bj = 0; bj < 2; ++bj)
#pragma unroll
            for (int n = 0; n < 2; ++n) mv[bj][n] = mul ? *(const f32x4*)(mul + u.pn * BM + col0 + bj * HALF + 4 * n) : (f32x4){1.f, 1.f, 1.f, 1.f};
#pragma unroll
        for (int ai = 0; ai < 2; ++ai)
#pragma unroll
            for (int m = 0; m < 4; ++m) { bf16_t* rowp = base + (size_t)(row0 + ai * HALF + m * 16) * ldc + col0;
#pragma unroll
                for (int bj = 0; bj < 2; ++bj) { f32x4 v0 = acc[ai][bj][m][0], v1 = acc[ai][bj][m][1];
                    if (act == 1) { v0 = gelu4(v0); v1 = gelu4(v1); }
                    v0 = v0 * mv[bj][0]; v1 = v1 * mv[bj][1];
                    u32x4 w;
                    if (act == 2) {
                        w.x = __builtin_bit_cast(unsigned, __builtin_amdgcn_cvt_pkrtz(v0[0], v0[1])); w.y = __builtin_bit_cast(unsigned, __builtin_amdgcn_cvt_pkrtz(v0[2], v0[3]));
                        w.z = __builtin_bit_cast(unsigned, __builtin_amdgcn_cvt_pkrtz(v1[0], v1[1])); w.w = __builtin_bit_cast(unsigned, __builtin_amdgcn_cvt_pkrtz(v1[2], v1[3]));
                    } else { w.x = cvt_pk_bf16(v0[0], v0[1]); w.y = cvt_pk_bf16(v0[2], v0[3]); w.z = cvt_pk_bf16(v1[0], v1[1]); w.w = cvt_pk_bf16(v1[2], v1[3]); }
                    *(u32x4*)(rowp + bj * HALF) = w; } }
    }
    __device__ __forceinline__ void f32_store(const f32x4 (&acc)[2][2][4][2], const Unit& u, int wr, int wc, int fr, int fq) const {
        float* C = (float*)O;
        const int row0 = u.pm * BM + wr * 64 + fr, col0 = u.pn * BM + wc * 32 + 4 * fq;
#pragma unroll
        for (int ai = 0; ai < 2; ++ai)
#pragma unroll
            for (int m = 0; m < 4; ++m) { float* rowp = C + (size_t)(row0 + ai * HALF + m * 16) * ldc + col0;
#pragma unroll
                for (int bj = 0; bj < 2; ++bj)
#pragma unroll
                    for (int n = 0; n < 2; ++n) *(f32x4*)(rowp + bj * HALF + n * 16) = acc[ai][bj][m][n]; }
    }
    __device__ __forceinline__ void resid(const f32x4 (&acc)[2][2][4][2], const Unit& u, int wr, int wc, int fr, int fq) const {
        const int rowt = u.pm * BM; const int mr = rowt < nlat ? (rowt >> 11) : 8;
        const float* gp = modl + mr * 6144 + chunk * 1024;
        bf16_t* xp = (bf16_t*)X + (size_t)rowt * 1024;
        const int row0 = wr * 64 + fr, col0 = u.pn * BM + wc * 32 + 8 * fq;
        f32x4 gv[2][2];
#pragma unroll
        for (int bj = 0; bj < 2; ++bj)
#pragma unroll
            for (int n = 0; n < 2; ++n) gv[bj][n] = *(const f32x4*)(gp + col0 + bj * HALF + n * 4) * gs;
        if (srcLat) {
            const float* sp = rowt < nlat ? srcLat + (size_t)rowt * 1024 : srcCtx + (size_t)(rowt - nlat) * 1024;
#pragma unroll
            for (int ai = 0; ai < 2; ++ai)
#pragma unroll
                for (int m = 0; m < 4; ++m) { const size_t off = (size_t)(row0 + ai * HALF + m * 16) * 1024 + col0;
#pragma unroll
                    for (int bj = 0; bj < 2; ++bj) { const f32x4 s0 = *(const f32x4*)(sp + off + bj * HALF), s1 = *(const f32x4*)(sp + off + bj * HALF + 4);
                        const f32x4 y0 = s0 + gv[bj][0] * acc[ai][bj][m][0], y1 = s1 + gv[bj][1] * acc[ai][bj][m][1];
                        u32x4 w; w.x = cvt_pk_bf16(y0[0], y0[1]); w.y = cvt_pk_bf16(y0[2], y0[3]); w.z = cvt_pk_bf16(y1[0], y1[1]); w.w = cvt_pk_bf16(y1[2], y1[3]);
                        *(u32x4*)(xp + off + bj * HALF) = w; }
                    if (m & 1) asm volatile("" ::: "memory"); }
        } else {
            const bf16_t* sp = (const bf16_t*)Xsrc + (size_t)rowt * 1024;
#pragma unroll
            for (int ai = 0; ai < 2; ++ai)
#pragma unroll
                for (int m = 0; m < 4; ++m) { const size_t off = (size_t)(row0 + ai * HALF + m * 16) * 1024 + col0;
#pragma unroll
                    for (int bj = 0; bj < 2; ++bj) { const u32x4 sv = *(const u32x4*)(sp + off + bj * HALF);
                        const f32x4 s0 = {__uint_as_float(sv.x << 16), __uint_as_float(sv.x & 0xffff0000u), __uint_as_float(sv.y << 16), __uint_as_float(sv.y & 0xffff0000u)};
                        const f32x4 s1 = {__uint_as_float(sv.z << 16), __uint_as_float(sv.z & 0xffff0000u), __uint_as_float(sv.w << 16), __uint_as_float(sv.w & 0xffff0000u)};
                        const f32x4 y0 = s0 + gv[bj][0] * acc[ai][bj][m][0], y1 = s1 + gv[bj][1] * acc[ai][bj][m][1];
                        u32x4 w; w.x = cvt_pk_bf16(y0[0], y0[1]); w.y = cvt_pk_bf16(y0[2], y0[3]); w.z = cvt_pk_bf16(y1[0], y1[1]); w.w = cvt_pk_bf16(y1[2], y1[3]);
                        *(u32x4*)(xp + off + bj * HALF) = w; }
                    if (m & 1) asm volatile("" ::: "memory"); }
        }
    }
    __device__ __forceinline__ void swapv(const f32x4 (&acc)[2][2][4][2], const Unit& u, int wr, int wc, int fr, int fq) const {
        bf16_t* base = (bf16_t*)O + (size_t)u.pm * BM * ldc + (size_t)u.pn * BM;
        const int row0 = wr * 64 + fr, col0 = wc * 32 + 8 * fq;
        float cs[16];
#pragma unroll
        for (int i = 0; i < 16; ++i) cs[i] = 0.f;
#pragma unroll
        for (int ai = 0; ai < 2; ++ai)
#pragma unroll
            for (int m = 0; m < 4; ++m) { bf16_t* rowp = base + (size_t)(row0 + ai * HALF + m * 16) * ldc + col0;
#pragma unroll
                for (int bj = 0; bj < 2; ++bj) { const f32x4 v0 = gelu4(acc[ai][bj][m][0]), v1 = gelu4(acc[ai][bj][m][1]);
#pragma unroll
                    for (int e = 0; e < 4; ++e) { cs[bj * 8 + e] += v0[e] * v0[e]; cs[bj * 8 + 4 + e] += v1[e] * v1[e]; }
                    u32x4 w; w.x = cvt_pk_bf16(v0[0], v0[1]); w.y = cvt_pk_bf16(v0[2], v0[3]); w.z = cvt_pk_bf16(v1[0], v1[1]); w.w = cvt_pk_bf16(v1[2], v1[3]);
                    *(u32x4*)(rowp + bj * HALF) = w; } }
        const bool b3 = fr & 8, b2 = fr & 4, b1 = fr & 2, b0 = fr & 1;
        float d[8], e4[4], f2[2];
#pragma unroll
        for (int i = 0; i < 8; ++i) { const float mine = b3 ? cs[8 + i] : cs[i], send = b3 ? cs[i] : cs[8 + i]; d[i] = mine + shx<8>(send); }
#pragma unroll
        for (int i = 0; i < 4; ++i) { const float mine = b2 ? d[4 + i] : d[i], send = b2 ? d[i] : d[4 + i]; e4[i] = mine + shx<4>(send); }
#pragma unroll
        for (int i = 0; i < 2; ++i) { const float mine = b1 ? e4[2 + i] : e4[i], send = b1 ? e4[i] : e4[2 + i]; f2[i] = mine + shx<2>(send); }
        const float tot = (b0 ? f2[1] : f2[0]) + shx<1>(b0 ? f2[0] : f2[1]);
        const int ci = fr;
        const int col = u.pn * BM + (ci >> 3) * HALF + wc * 32 + 8 * fq + (ci & 7);
        SS[(size_t)(u.pm * 2 + wr) * ldc + col] = tot;
    }
    __device__ __forceinline__ void operator()(const f32x4 (&acc)[2][2][4][2], const Unit& u, int wr, int wc, int fr, int fq) const {
        if (type == 0) bf16_store(acc, u, wr, wc, fr, fq);
        else if (type == 1) f32_store(acc, u, wr, wc, fr, fq);
        else if (type == 2) resid(acc, u, wr, wc, fr, fq);
        else swapv(acc, u, wr, wc, fr, fq);
    }
};

template <bool ALIGN_EPI = true>
__device__ __forceinline__ void gemm_phase(PG8_LAS unsigned char* lds, const Gemm g, const StaticOrder& S, const EpiAny& E, const int tid) {
    const int wid = __builtin_amdgcn_readfirstlane(tid >> 6), lane = tid & 63, wr = wid >> 2, wc = wid & 3, fr = lane & 15, fq = lane >> 4;
    const int nt = g.K / BK;
    unsigned voffA[2], voffB[2];
#pragma unroll
    for (int i = 0; i < 2; ++i) { int R, C; stage_rc(tid * 16 + i * 8192, R, C); const int Rb = E.perm ? ((R & ~31) + perm32(R & 31)) : R;
        voffA[i] = (unsigned)(R * g.lda + C) * 2u; voffB[i] = (unsigned)(Rb * g.ldb + C) * 2u; }
    const size_t kstep = (size_t)(BK * 2);
    const size_t hA = (size_t)HALF * g.lda * 2, hB = (size_t)HALF * g.ldb * 2;
    const unsigned ldsw = (unsigned)wid * 1024u;
    const int aoff = lds_byte(wr * 64 + fr, fq * 8), boff = lds_byte(wc * 32 + fr, fq * 8);
#define PG8_SA(b, h) (((b) * 2 + (h)) * HTB)
#define PG8_SB(b, h) ((4 + (b) * 2 + (h)) * HTB)
#define PG8_STAGE(bufoff, gbase, voff) do { _Pragma("unroll") for (int _i = 0; _i < 2; ++_i) \
        __builtin_amdgcn_global_load_lds((const unsigned*)((const char*)(gbase) + (voff)[_i]), (PG8_LAS unsigned*)(lds + (bufoff) + ldsw + _i * 8192), 16, 0, 0); } while (0)
#define PG8_LDA(dst, b, h) do { _Pragma("unroll") for (int m = 0; m < 4; ++m) _Pragma("unroll") for (int k = 0; k < 2; ++k) dst[m][k] = *(const PG8_LAS bf16x8*)(lds + PG8_SA(b, h) + aoff + m * 2048 + k * 1024); } while (0)
#define PG8_LDB(dst, b, h) do { _Pragma("unroll") for (int n = 0; n < 2; ++n) _Pragma("unroll") for (int k = 0; k < 2; ++k) dst[n][k] = *(const PG8_LAS bf16x8*)(lds + PG8_SB(b, h) + boff + n * 2048 + k * 1024); } while (0)
#define PG8_MMA(ai, bj, At, Bt) do { __builtin_amdgcn_s_setprio(1); _Pragma("unroll") for (int m = 0; m < 4; ++m) _Pragma("unroll") for (int n = 0; n < 2; ++n) _Pragma("unroll") for (int k = 0; k < 2; ++k) \
        acc[ai][bj][m][n] = __builtin_amdgcn_mfma_f32_16x16x32_bf16(Bt[n][k], At[m][k], acc[ai][bj][m][n], 0, 0, 0); __builtin_amdgcn_s_setprio(0); } while (0)
#define PG8_WAIT_V(n) asm volatile("s_waitcnt vmcnt(" #n ")" ::: "memory")
#define PG8_WAIT_L(n) asm volatile("s_waitcnt lgkmcnt(" #n ")" ::: "memory")
#define PG8_BAR __builtin_amdgcn_s_barrier()
#define PG8_SCHED __builtin_amdgcn_sched_barrier(0)
#define PG8_PA(u) ((const char*)g.A + 2 * ((long)(u).pm * g.a_pm + (long)(u).pn * g.a_pn))
#define PG8_PB(u) ((const char*)g.Bt + 2 * ((long)(u).pm * g.b_pm + (long)(u).pn * g.b_pn))
    Unit cur, nxt; int ui = 0;
    if (!S.next(0, cur)) return;
    f32x4 acc[2][2][4][2];
#pragma unroll
    for (int a = 0; a < 2; ++a)
#pragma unroll
        for (int b = 0; b < 2; ++b)
#pragma unroll
            for (int m = 0; m < 4; ++m)
#pragma unroll
                for (int n = 0; n < 2; ++n) acc[a][b][m][n] = (f32x4){0.f, 0.f, 0.f, 0.f};
    bf16x8 At[4][2], B0[2][2], B1[2][2];
    const char* cA = PG8_PA(cur); const char* cB = PG8_PB(cur);
    PG8_STAGE(PG8_SB(0, 0), cB, voffB); PG8_STAGE(PG8_SB(0, 1), cB + hB, voffB); PG8_STAGE(PG8_SA(0, 0), cA, voffA); PG8_STAGE(PG8_SA(0, 1), cA + hA, voffA);
    if (wr == 1) PG8_BAR;
    PG8_WAIT_V(2); PG8_BAR;
    PG8_STAGE(PG8_SB(1, 0), cB + kstep, voffB); PG8_STAGE(PG8_SA(1, 0), cA + kstep, voffA); PG8_STAGE(PG8_SB(1, 1), cB + hB + kstep, voffB);
    PG8_WAIT_V(6); PG8_BAR;
    for (;;) {
        const bool has_next = S.next(ui + 1, nxt);
        const char* nA = has_next ? PG8_PA(nxt) : cA; const char* nB = has_next ? PG8_PB(nxt) : cB;
        for (int t = 0; t < nt; t += 2) {
            const bool last = (t == nt - 2);
            const char* a1 = cA + (size_t)(t + 1) * kstep;
            const char* a2 = last ? nA : cA + (size_t)(t + 2) * kstep; const char* b2 = last ? nB : cB + (size_t)(t + 2) * kstep;
            const char* a3 = a2 + kstep; const char* b3 = b2 + kstep;
            PG8_LDB(B0, 0, 0); PG8_LDB(B1, 0, 1); PG8_SCHED; PG8_LDA(At, 0, 0); PG8_STAGE(PG8_SA(1, 1), a1 + hA, voffA);
            PG8_WAIT_V(8); PG8_WAIT_L(0); PG8_BAR; PG8_MMA(0, 0, At, B0); PG8_MMA(0, 1, At, B1); PG8_BAR; PG8_SCHED;
            PG8_LDA(At, 0, 1); PG8_STAGE(PG8_SB(0, 0), b2, voffB); PG8_STAGE(PG8_SB(0, 1), b2 + hB, voffB); PG8_STAGE(PG8_SA(0, 0), a2, voffA);
            PG8_WAIT_V(8); PG8_WAIT_L(0); PG8_BAR; PG8_MMA(1, 0, At, B0); PG8_MMA(1, 1, At, B1); PG8_BAR; PG8_SCHED;
            PG8_LDB(B0, 1, 0); PG8_LDB(B1, 1, 1); PG8_SCHED; PG8_LDA(At, 1, 0); PG8_STAGE(PG8_SA(0, 1), a2 + hA, voffA);
            PG8_WAIT_V(8); PG8_WAIT_L(0); PG8_BAR; PG8_MMA(0, 0, At, B0); PG8_MMA(0, 1, At, B1); PG8_BAR; PG8_SCHED;
            PG8_LDA(At, 1, 1); PG8_STAGE(PG8_SB(1, 0), b3, voffB); PG8_STAGE(PG8_SB(1, 1), b3 + hB, voffB); PG8_STAGE(PG8_SA(1, 0), a3, voffA);
            PG8_WAIT_V(8); PG8_WAIT_L(0); PG8_BAR; PG8_MMA(1, 0, At, B0); PG8_MMA(1, 1, At, B1); PG8_BAR; PG8_SCHED;
        }
        if constexpr (ALIGN_EPI) { if (wr == 0) PG8_BAR; }
        { int el = (int)__builtin_amdgcn_mbcnt_hi(~0u, __builtin_amdgcn_mbcnt_lo(~0u, 0u)); asm volatile("" : "+v"(el));
          E(acc, cur, wr, wc, el & 15, el >> 4); }
        if (!has_next) break;
#pragma unroll
        for (int a = 0; a < 2; ++a)
#pragma unroll
            for (int b = 0; b < 2; ++b)
#pragma unroll
                for (int m = 0; m < 4; ++m)
#pragma unroll
                    for (int n = 0; n < 2; ++n) acc[a][b][m][n] = (f32x4){0.f, 0.f, 0.f, 0.f};
        cur = nxt; cA = nA; cB = nB; ++ui;
        if constexpr (ALIGN_EPI) { if (wr == 1) PG8_BAR; }
    }
    PG8_WAIT_V(0);
    if constexpr (!ALIGN_EPI) { if (wr == 0) PG8_BAR; }
    PG8_BAR;
#undef PG8_SA
#undef PG8_SB
#undef PG8_STAGE
#undef PG8_LDA
#undef PG8_LDB
#undef PG8_MMA
#undef PG8_WAIT_V
#undef PG8_WAIT_L
#undef PG8_BAR
#undef PG8_SCHED
#undef PG8_PA
#undef PG8_PB
}
}

namespace attn {
using bf16 = __hip_bfloat16;
constexpr int D = 128, NW = 8, QBLK = 32, KVBLK = 64;
constexpr float SCALE = 0.088388347648318440f;
constexpr float THR = 8.f;
constexpr int LDQ = 1024, LDK = 256, LDO = 1024;
constexpr size_t SHM_V = KVBLK * D * 2, SHM_K = KVBLK * D * 2, SHM_ATTN = 2 * SHM_V + 2 * SHM_K + NW * 64 * 4;
using bf16x8 = __attribute__((ext_vector_type(8))) short;
using s16x4  = __attribute__((ext_vector_type(4))) short;
using f32x16 = __attribute__((ext_vector_type(16))) float;
using u32x4  = __attribute__((ext_vector_type(4))) unsigned;
#define KSWZ(row, colB) ((row) * 256 + ((colB) ^ (((row) & 7) << 4)))
#define SBAR() __builtin_amdgcn_sched_barrier(0)
__device__ __forceinline__ int crow(int r, int hi) { return (r & 3) + 8 * (r >> 2) + 4 * hi; }
__device__ __forceinline__ unsigned cvtpk(float lo, float hi) { unsigned r; asm volatile("v_cvt_pk_bf16_f32 %0, %1, %2" : "=v"(r) : "v"(lo), "v"(hi)); return r; }
__device__ __forceinline__ void partialSM(f32x16& p0, f32x16& p1, float& m_reg, float& mn, float& alpha) {
  constexpr float C = SCALE * 1.4426950408889634f;
  float pmax = p0[0]; for (int r = 1; r < 16; ++r) pmax = fmaxf(pmax, p0[r]); for (int r = 0; r < 16; ++r) pmax = fmaxf(pmax, p1[r]);
  { auto rr = __builtin_amdgcn_permlane32_swap(__float_as_uint(pmax), __float_as_uint(pmax), false, false);
    pmax = fmaxf(__uint_as_float(rr[0]), __uint_as_float(rr[1])); }
  if (__builtin_expect(__all(pmax - m_reg <= THR / SCALE), 1)) { mn = m_reg; alpha = 1.f; }
  else { mn = fmaxf(m_reg, pmax); alpha = __builtin_amdgcn_exp2f((m_reg - mn) * C); m_reg = mn; }
  float mnC = -mn * C;
  for (int r = 0; r < 16; ++r) p0[r] = fmaf(p0[r], C, mnC); for (int r = 0; r < 16; ++r) p1[r] = fmaf(p1[r], C, mnC);
  for (int r = 0; r < 16; ++r) p0[r] = __builtin_amdgcn_exp2f(p0[r]);
}
__device__ __forceinline__ void finishSM(f32x16& p0, f32x16& p1, float alpha, float& l_reg, bf16x8& pa0, bf16x8& pa1, bf16x8& pa2, bf16x8& pa3) {
  for (int r = 0; r < 16; ++r) p1[r] = __builtin_amdgcn_exp2f(p1[r]);
  float ps = 0; for (int r = 0; r < 16; ++r) ps += p0[r]; for (int r = 0; r < 16; ++r) ps += p1[r];
  { auto rr = __builtin_amdgcn_permlane32_swap(__float_as_uint(ps), __float_as_uint(ps), false, false);
    ps = __uint_as_float(rr[0]) + __uint_as_float(rr[1]); }
  l_reg = l_reg * alpha + ps;
#define PK4(P, BASE, OUT) do { unsigned a0 = cvtpk(P[BASE + 0], P[BASE + 1]), a1 = cvtpk(P[BASE + 2], P[BASE + 3]);   \
    unsigned b0 = cvtpk(P[BASE + 4], P[BASE + 5]), b1 = cvtpk(P[BASE + 6], P[BASE + 7]);                              \
    auto r0 = __builtin_amdgcn_permlane32_swap(a0, b0, false, false); auto r1 = __builtin_amdgcn_permlane32_swap(a1, b1, false, false); \
    u32x4 w = {r0[0], r1[0], r0[1], r1[1]}; OUT = *reinterpret_cast<bf16x8*>(&w); } while (0)
  PK4(p0, 0, pa0); PK4(p0, 8, pa1); PK4(p1, 0, pa2); PK4(p1, 8, pa3);
#undef PK4
}
__device__ __forceinline__ void qkt(f32x16& p0, f32x16& p1, const bf16* Ks, const bf16x8* qr, int r32, int hi) {
  p0 = f32x16{}; p1 = f32x16{};
  for (int d0 = 0; d0 < 8; ++d0) { int cb = (d0 * 16 + hi * 8) * 2;
    bf16x8 b0 = *reinterpret_cast<const bf16x8*>((const char*)Ks + KSWZ(r32, cb));
    bf16x8 b1 = *reinterpret_cast<const bf16x8*>((const char*)Ks + KSWZ(32 + r32, cb));
    p0 = __builtin_amdgcn_mfma_f32_32x32x16_bf16(b0, qr[d0], p0, 0, 0, 0);
    p1 = __builtin_amdgcn_mfma_f32_32x32x16_bf16(b1, qr[d0], p1, 0, 0, 0); }
}
__device__ __forceinline__ int v_st(int k, int c) { const int kk = (k & ~0xC) | ((k & 4) << 1) | ((k & 8) >> 1); return ((kk >> 3) * 4 + (c >> 5)) * 512 + ((kk & 7) * 32 + (c & 31)) * 2; }
__device__ __forceinline__ int v_rd_base(int lane) { return ((lane & 3) << 3) | (((lane >> 2) & 3) << 6) | (((lane >> 4) & 1) << 5) | (((lane >> 5) & 1) << 8); }
constexpr int v_rd_off(int d0, int ks, int half) { return d0 * 512 + ks * 4096 + half * 2048; }
template <int OFF> __device__ __forceinline__ s16x4 tr_read(int vb) {
  s16x4 r; asm volatile("ds_read_b64_tr_b16 %0, %1 offset:%2" : "=&v"(r) : "v"(vb), "i"(OFF) : "memory"); return r;
}
template <int D0> __device__ __forceinline__ void pv_one(f32x16& od, int vb, bf16x8 pa0, bf16x8 pa1, bf16x8 pa2, bf16x8 pa3) {
  const s16x4 l0 = tr_read<v_rd_off(D0, 0, 0)>(vb), h0 = tr_read<v_rd_off(D0, 0, 1)>(vb), l1 = tr_read<v_rd_off(D0, 1, 0)>(vb), h1 = tr_read<v_rd_off(D0, 1, 1)>(vb);
  const s16x4 l2 = tr_read<v_rd_off(D0, 2, 0)>(vb), h2 = tr_read<v_rd_off(D0, 2, 1)>(vb), l3 = tr_read<v_rd_off(D0, 3, 0)>(vb), h3 = tr_read<v_rd_off(D0, 3, 1)>(vb);
  asm volatile("s_waitcnt lgkmcnt(0)" ::: "memory"); SBAR();
#define PK(L, H) (bf16x8){L[0], L[1], L[2], L[3], H[0], H[1], H[2], H[3]}
  od = __builtin_amdgcn_mfma_f32_32x32x16_bf16(pa0, PK(l0, h0), od, 0, 0, 0);
  od = __builtin_amdgcn_mfma_f32_32x32x16_bf16(pa1, PK(l1, h1), od, 0, 0, 0);
  od = __builtin_amdgcn_mfma_f32_32x32x16_bf16(pa2, PK(l2, h2), od, 0, 0, 0);
  od = __builtin_amdgcn_mfma_f32_32x32x16_bf16(pa3, PK(l3, h3), od, 0, 0, 0);
#undef PK
}
__device__ __forceinline__ void pv_d0(f32x16* o, int vb, bf16x8 pa0, bf16x8 pa1, bf16x8 pa2, bf16x8 pa3) {
  pv_one<0>(o[0], vb, pa0, pa1, pa2, pa3); pv_one<1>(o[1], vb, pa0, pa1, pa2, pa3); pv_one<2>(o[2], vb, pa0, pa1, pa2, pa3); pv_one<3>(o[3], vb, pa0, pa1, pa2, pa3);
}
__device__ __forceinline__ void attn_dense_body(const bf16* __restrict__ Qb, const bf16* __restrict__ Kh, const bf16* __restrict__ Vh,
                                                bf16* __restrict__ Ob, int seq, char* lds, const int tid) {
  const int wid = tid >> 6, lane = tid & 63, r32 = lane & 31, hi = lane >> 5;
  bf16* V_lds = (bf16*)lds; bf16* K_lds = (bf16*)(lds + 2 * SHM_V);
  float* ws = (float*)(lds + 2 * SHM_V + 2 * SHM_K) + wid * 64; float* li_l = ws; float* al_l = ws + 32;
  float m_reg = -1e30f, l_reg = 0; f32x16 o[4] = {}; bf16x8 qr[8];
  const bf16* Qw = Qb + (long)(wid * QBLK + r32) * LDQ + hi * 8;
#pragma unroll
  for (int d0 = 0; d0 < 8; ++d0) qr[d0] = *reinterpret_cast<const bf16x8*>(Qw + d0 * 16);
  const int sr = tid >> 4, sc = (tid & 15) * 8, vst0 = v_st(sr, sc), vst1 = v_st(32 + sr, sc);
  const int vb0 = (int)(uintptr_t)V_lds + v_rd_base(lane);
  struct { bf16x8 vs0, vs1, ks0, ks1; } sr_[1];
#define SLOAD(i, k0) do { sr_[i].vs0 = *reinterpret_cast<const bf16x8*>(&Vh[(long)((k0) + sr) * LDK + sc]); sr_[i].vs1 = *reinterpret_cast<const bf16x8*>(&Vh[(long)((k0) + 32 + sr) * LDK + sc]); \
    sr_[i].ks0 = *reinterpret_cast<const bf16x8*>(&Kh[(long)((k0) + sr) * LDK + sc]); sr_[i].ks1 = *reinterpret_cast<const bf16x8*>(&Kh[(long)((k0) + 32 + sr) * LDK + sc]); } while (0)
#define SWRITE(b, i) do { *(bf16x8*)((char*)V_lds + (b) * SHM_V + vst0) = sr_[i].vs0;          \
    *(bf16x8*)((char*)V_lds + (b) * SHM_V + vst1) = sr_[i].vs1; int kc = sc * 2;               \
    *(bf16x8*)((char*)K_lds + (b) * SHM_K + KSWZ(sr, kc)) = sr_[i].ks0;                       \
    *(bf16x8*)((char*)K_lds + (b) * SHM_K + KSWZ(32 + sr, kc)) = sr_[i].ks1; } while (0)
#define SWAIT() asm volatile("s_waitcnt vmcnt(0)" ::: "memory")
#define RESC(a) do { if (__any((a) < 1.f)) { if (hi == 0) al_l[r32] = (a); asm volatile("s_waitcnt lgkmcnt(0)" ::: "memory"); \
    for (int d = 0; d < 4; ++d) for (int r = 0; r < 16; ++r) o[d][r] *= al_l[crow(r, hi)]; } } while (0)
  f32x16 pA0, pA1, pB0, pB1; float mnA, mnB, alA, alB; bf16x8 pa0, pa1, pa2, pa3; const int NT = seq / KVBLK;
  constexpr int SE = 0, SO = 0;
  SLOAD(SE, 0); asm volatile("s_waitcnt vmcnt(0)" ::: "memory"); SWRITE(0, SE); __syncthreads();
  qkt(pA0, pA1, K_lds, qr, r32, hi); partialSM(pA0, pA1, m_reg, mnA, alA);
  SLOAD(SO, KVBLK);
  SWAIT(); SWRITE(1, SO); __syncthreads();
  for (int j = 1; j + 1 < NT; j += 2) {
    SBAR(); qkt(pB0, pB1, (bf16*)((char*)K_lds + SHM_K), qr, r32, hi);
    finishSM(pA0, pA1, alA, l_reg, pa0, pa1, pa2, pa3); SBAR();
    SLOAD(SO, (j + 1) * KVBLK); SBAR();
    pv_d0(o, vb0, pa0, pa1, pa2, pa3); partialSM(pB0, pB1, m_reg, mnB, alB);
    __syncthreads(); SWAIT(); SWRITE(0, SE);
    RESC(alB); __syncthreads();
    SBAR(); qkt(pA0, pA1, K_lds, qr, r32, hi);
    finishSM(pB0, pB1, alB, l_reg, pa0, pa1, pa2, pa3); SBAR();
    SLOAD(SE, (j + 2) * KVBLK); SBAR();
    pv_d0(o, vb0 + (int)SHM_V, pa0, pa1, pa2, pa3); partialSM(pA0, pA1, m_reg, mnA, alA);
    __syncthreads(); SWAIT(); SWRITE(1, SO);
    RESC(alA); __syncthreads();
  }
  SBAR(); qkt(pB0, pB1, (bf16*)((char*)K_lds + SHM_K), qr, r32, hi);
  finishSM(pA0, pA1, alA, l_reg, pa0, pa1, pa2, pa3); SBAR();
  pv_d0(o, vb0, pa0, pa1, pa2, pa3); partialSM(pB0, pB1, m_reg, mnB, alB);
  __syncthreads(); RESC(alB);
  finishSM(pB0, pB1, alB, l_reg, pa0, pa1, pa2, pa3); SBAR();
  pv_d0(o, vb0 + (int)SHM_V, pa0, pa1, pa2, pa3);
  if (hi == 0) li_l[r32] = l_reg; asm volatile("s_waitcnt lgkmcnt(0)" ::: "memory");
  float rli[16];
#pragma unroll
  for (int r = 0; r < 16; ++r) rli[r] = __builtin_amdgcn_rcpf(li_l[crow(r, hi)]);
  unsigned short* Ow = (unsigned short*)Ob + (long)(wid * QBLK) * LDO;
#pragma unroll
  for (int r = 0; r < 16; ++r) { int orow = crow(r, hi);
    for (int d0 = 0; d0 < 4; ++d0) { const unsigned pk = cvtpk(o[d0][r] * rli[r], 0.f); Ow[(long)orow * LDO + d0 * 32 + r32] = (unsigned short)(pk & 0xffffu); } }
  __syncthreads();
#undef SLOAD
#undef SWRITE
#undef SWAIT
#undef RESC
}
#undef KSWZ
#undef SBAR
}

constexpr int NWAVES = 8;
constexpr int DM = 1024, NB = 8, SEQ = 2048, CTXL = 256, NLAT = NB * SEQ, NCTX = NB * CTXL, NTOK = NLAT + NCTX;
constexpr int DEPTH = 4, MODW = 6 * DM;
constexpr float EPS = 1e-6f;
constexpr int SGUW = 2048, NEXP = 16384, KVROWS = SEQ + CTXL;

constexpr size_t MiB = 1u << 20;
constexpr size_t WS_CTL = 0, CTL_ZERO_BYTES = 1 * MiB;
constexpr size_t WS_MOD = 1 * MiB;
constexpr size_t WS_SS = 2 * MiB;
constexpr size_t WS_X = 4 * MiB;
constexpr size_t WS_H = 76 * MiB;
constexpr size_t WS_Z = 112 * MiB;
constexpr size_t WS_G = 256 * MiB;
constexpr size_t WS_SG = 328 * MiB;
constexpr size_t WS_WSGUIN = 346 * MiB;
constexpr size_t WS_WSGUOUT = 362 * MiB;
constexpr size_t WS_WPOOLIN = 370 * MiB, WS_WPOOLOUT = 372 * MiB, WS_WGRP = 374 * MiB, WS_WQKV = 375 * MiB, WS_WO = 378 * MiB;
constexpr size_t WS_WPQ = 380 * MiB;
constexpr size_t WS_KB = 396 * MiB;
constexpr size_t WS_TU = 400 * MiB;
constexpr size_t WS_TV = 464 * MiB;
constexpr size_t WS_SU = 528 * MiB, WS_SV = 529 * MiB;
constexpr size_t WS_IDX = 530 * MiB;
constexpr size_t WS_SHQ = 539 * MiB;
constexpr size_t WS_H8 = 540 * MiB;
constexpr size_t WS_END = 558 * MiB;
constexpr int CW_BAR = 4096;

constexpr int RING_BYTES = 131072;
constexpr int LDSCTL_OFF = RING_BYTES, MISC_OFF = LDSCTL_OFF + 320, WSLOT_OFF = LDSCTL_OFF + 1024;
constexpr int LDS_BYTES = 147456;

#define GAS __attribute__((address_space(1)))
#define LAS __attribute__((address_space(3)))
typedef unsigned short bf16;
typedef unsigned v4u __attribute__((ext_vector_type(4)));
typedef unsigned v2u __attribute__((ext_vector_type(2)));
typedef float f32x4 __attribute__((ext_vector_type(4)));
typedef short bf16x8 __attribute__((ext_vector_type(8)));
typedef __bf16 bf2 __attribute__((ext_vector_type(2)));
#define LDS_WAIT() asm volatile("s_waitcnt lgkmcnt(0)" ::: "memory")
__device__ __forceinline__ unsigned f2bf(float f) { unsigned u = __builtin_bit_cast(unsigned, f); return (u + 0x7fffu + ((u >> 16) & 1u)) >> 16; }
__device__ __forceinline__ unsigned pk2(float lo, float hi) { return pg8::cvt_pk_bf16(lo, hi); }
__device__ __forceinline__ float dot2bf(unsigned a, unsigned b, float c) { asm("v_dot2c_f32_bf16 %0, %1, %2" : "+v"(c) : "v"(a), "v"(b)); return c; }
typedef _Float16 h2_t __attribute__((ext_vector_type(2)));
__device__ __forceinline__ unsigned h2u(h2_t v) { return __builtin_bit_cast(unsigned, v); }
__device__ __forceinline__ h2_t u2h(unsigned v) { return __builtin_bit_cast(h2_t, v); }
__device__ __forceinline__ float bflo(unsigned u) { return __uint_as_float(u << 16); }
__device__ __forceinline__ float bfhi(unsigned u) { return __uint_as_float(u & 0xffff0000u); }

#define XB_TMO      128
#define XB_XCNT(j)  (256  + 64 * (j))
#define XB_XSUB(j)  (1280 + 64 * (j))
#define XB_XGEN(j)  (2304 + 64 * (j))
#define XB_TOP      3328
#define XB_TOPGEN   3392
#define XCD_BAR_WORDS 3456
#define XB_SPIN_CAP (1u << 22)
__device__ __forceinline__ unsigned xb_ld(unsigned* p)              { return __hip_atomic_load(p, __ATOMIC_RELAXED, __HIP_MEMORY_SCOPE_AGENT); }
__device__ __forceinline__ unsigned xb_add(unsigned* p, unsigned v) { return __hip_atomic_fetch_add(p, v, __ATOMIC_RELAXED, __HIP_MEMORY_SCOPE_AGENT); }
__device__ __forceinline__ unsigned xb_xcc_id() { return (unsigned)__builtin_amdgcn_s_getreg((3 << 11) | 20) & 0xFu; }
#define XB_SPIN(cond, bar) do { unsigned _sp = 0; while (cond) { __builtin_amdgcn_s_sleep(1); \
    if ((++_sp & 255u) == 0u) { if (xb_ld(&(bar)[XB_TMO])) break; if (_sp > XB_SPIN_CAP) { atomicAdd(&(bar)[XB_TMO], 1u); break; } } } } while (0)
struct XcdBarrier { unsigned* bar; unsigned x; volatile LAS unsigned* st; };
__device__ __forceinline__ XcdBarrier xcd_barrier_post(unsigned* bar, volatile LAS unsigned* st) {
    XcdBarrier b; b.bar = bar; b.x = xb_xcc_id(); b.st = st;
    if (threadIdx.x == 0) (void)xb_add(&bar[XB_XCNT(b.x)], 1u);
    return b;
}
__device__ __forceinline__ void xcd_barrier_complete(unsigned* bar, unsigned x, unsigned& nloc, unsigned& nx) {
    const unsigned G = gridDim.x * gridDim.y * gridDim.z;
    unsigned sum, cnt, mine, sp = 0u;
    for (;;) {
        sum = 0u; cnt = 0u; mine = 0u;
#pragma unroll
        for (unsigned j = 0; j < 16; ++j) { const unsigned c = xb_ld(&bar[XB_XCNT(j)]); sum += c; cnt += (c > 0u) ? 1u : 0u; mine = (j == x) ? c : mine; }
        if (sum == G) break;
        __builtin_amdgcn_s_sleep(1);
        if ((++sp & 255u) == 0u) { if (xb_ld(&bar[XB_TMO])) break; if (sp > XB_SPIN_CAP) { atomicAdd(&bar[XB_TMO], 1u); break; } }
    }
    nloc = mine > 0u ? mine : 1u; nx = cnt > 0u ? cnt : 1u;
}
__device__ __forceinline__ void xcd_barrier(const XcdBarrier& b, const int tid) {
    asm volatile("s_waitcnt vmcnt(0)" ::: "memory");
    __syncthreads();
    if (tid == 0) {
        unsigned* bar = b.bar;
        __builtin_amdgcn_s_waitcnt(0);
        unsigned nloc = b.st[0], nx = b.st[1];
        if (nloc == 0u) { xcd_barrier_complete(bar, b.x, nloc, nx); b.st[0] = nloc; b.st[1] = nx; }
        const unsigned old = xb_add(&bar[XB_XSUB(b.x)], 1u);
        const unsigned gen = old / nloc;
        if (old + 1u == (gen + 1u) * nloc) {
            __builtin_amdgcn_fence(__ATOMIC_RELEASE, "agent");
            asm volatile("s_waitcnt vmcnt(0)" ::: "memory");
            const unsigned og = xb_add(&bar[XB_TOP], 1u);
            const unsigned tg = og / nx;
            if (og + 1u == (tg + 1u) * nx) xb_add(&bar[XB_TOPGEN], 1u);
            else XB_SPIN(xb_ld(&bar[XB_TOPGEN]) == tg, bar);
            __builtin_amdgcn_fence(__ATOMIC_ACQUIRE, "agent");
            xb_add(&bar[XB_XGEN(b.x)], 1u);
            asm volatile("s_waitcnt vmcnt(0)" ::: "memory");
        } else {
            XB_SPIN(xb_ld(&bar[XB_XGEN(b.x)]) == gen, bar);
            __builtin_amdgcn_fence(__ATOMIC_ACQUIRE, "agent");
            asm volatile("s_waitcnt vmcnt(0)" ::: "memory");
        }
    }
    __syncthreads();
}

enum { I_X = 0, I_C, I_CTX, I_CCTX, I_ADAW, I_ADAB, I_N1G, I_N2G, I_SGU_WIN, I_SGU_VG, I_SGU_WS, I_SGU_BS, I_SGU_WOUT, I_POOL_WIN, I_POOL_WGRP, I_POOL_SCALE, I_POOL_WOUT,
       I_ATT_WQKV, I_ATT_QG, I_ATT_KG, I_ATT_WO, I_PEER_WQ, I_PEER_K1, I_PEER_K2, I_PEER_U, I_PEER_V, I_FINAL_G, N_IN };
struct Args { const float* in[N_IN]; float* out; unsigned char* ws; int lo, hi; };
typedef const __attribute__((address_space(4))) Args* KArgs;
#define ws_ (A->ws)

struct Frame {
    LAS unsigned char* lds;
    int tid, lane, wave, vcu, G, bx;
};

__device__ __forceinline__ float wave_sum(float v) {
    v += shx<1>(v); v += shx<2>(v); v += shx<4>(v); v += shx<8>(v); v += shx<16>(v);
    { auto r = __builtin_amdgcn_permlane32_swap(__float_as_uint(v), __float_as_uint(v), false, false); v = __uint_as_float(r[0]) + __uint_as_float(r[1]); }
    return v;
}

__device__ __forceinline__ void p0_transpose_item(const float* W, int K, int N, bf16* WT, LAS float* scr, int item, int lane) {
    const int nblk = N / 32, kb = item / nblk, nb = item % nblk, k0 = 64 * kb, n0 = 32 * nb;
#pragma unroll 8
    for (int i = 0; i < 32; ++i) { const int kk = 2 * i + (lane >> 5); scr[kk * 33 + (lane & 31)] = W[(size_t)(k0 + kk) * N + n0 + (lane & 31)]; }
    LDS_WAIT(); asm volatile("" ::: "memory");
    const int c = lane & 7;
#pragma unroll
    for (int j = 0; j < 4; ++j) { const int n = (lane >> 3) + 8 * j; const LAS float* s = scr + (8 * c) * 33 + n;
        v4u o; o.x = pk2(s[0 * 33], s[1 * 33]); o.y = pk2(s[2 * 33], s[3 * 33]); o.z = pk2(s[4 * 33], s[5 * 33]); o.w = pk2(s[6 * 33], s[7 * 33]);
        *(v4u*)(WT + (size_t)(n0 + n) * K + k0 + 8 * c) = o; }
    LDS_WAIT(); asm volatile("" ::: "memory");
}
__device__ __forceinline__ float silu(float v) { return v / (1.f + __expf(-v)); }

__device__ __forceinline__ void op_prep(Frame& F, KArgs A) {
    unsigned char* ws = ws_;
    for (int rep_ = 0; rep_ < 1 + ((PREPREP >> 0) & 1); ++rep_) {
        LAS float* S = (LAS float*)F.lds;
        LAS float* Pp = (LAS float*)(F.lds + 40960);
        for (int e = F.tid; e < 9 * 1024; e += NWAVES * 64) { const int r = e >> 10, k = e & 1023; S[e] = silu(r < 8 ? A->in[I_C][r * 1024 + k] : A->in[I_CCTX][k]); }
        __syncthreads();
        for (int task = F.vcu; task < DEPTH * 48; task += F.G) {
            const int i = task / 48, cg = task % 48, col = cg * 128 + 2 * F.lane;
            const float* W = A->in[I_ADAW] + (size_t)i * 1024 * MODW + col;
            float acc[9][2];
#pragma unroll
            for (int r = 0; r < 9; ++r) { acc[r][0] = 0.f; acc[r][1] = 0.f; }
            const int k0 = F.wave * 128;
#pragma unroll 8
            for (int k = k0; k < k0 + 128; ++k) { const pg8::f32x2 w = __builtin_nontemporal_load((const pg8::f32x2*)(W + (size_t)k * MODW));
#pragma unroll
                for (int r = 0; r < 9; ++r) { const float sv = S[r * 1024 + k]; acc[r][0] += sv * w.x; acc[r][1] += sv * w.y; } }
#pragma unroll
            for (int r = 0; r < 9; ++r) *(LAS pg8::f32x2*)(Pp + (F.wave * 9 + r) * 128 + 2 * F.lane) = (pg8::f32x2){acc[r][0], acc[r][1]};
            __syncthreads();
            for (int e = F.tid; e < 9 * 128; e += NWAVES * 64) { const int r = e >> 7, l = e & 127; float sacc = 0.f;
#pragma unroll
                for (int w = 0; w < 8; ++w) sacc += Pp[(w * 9 + r) * 128 + l];
                const int c2 = cg * 128 + l;
                ((float*)(ws + WS_MOD))[((size_t)i * 9 + r) * MODW + c2] = sacc + A->in[I_ADAB][(size_t)i * MODW + c2]; }
            __syncthreads();
        }
    }
    __syncthreads();
    const int gw = F.vcu * NWAVES + F.wave, NGW = F.G * NWAVES;
    const long gt = (long)F.vcu * (NWAVES * 64) + F.tid, NGT = (long)F.G * NWAVES * 64;
    for (int rep_ = 0; rep_ < 1 + ((PREPREP >> 1) & 1); ++rep_) {
        LAS float* scr = (LAS float*)(F.lds + F.wave * 16384);
        constexpr int IT_SIN = (1024 / 64) * (4096 / 32), IT_SOUT = (2048 / 64) * (1024 / 32), IT_SQ = (1024 / 64) * (1024 / 32), IT_GRP = (256 / 64) * (256 / 32),
                      IT_QKV = (1024 / 64) * (1536 / 32);
        constexpr int NITEMS = 2 * IT_SIN + 2 * IT_SOUT + 2 * IT_SQ + 4 * IT_GRP + IT_QKV + IT_SQ;
        for (int it = gw; it < NITEMS; it += NGW) {
            int r = it;
            if (r < 2 * IT_SIN) { const int j = r / IT_SIN; p0_transpose_item(A->in[I_SGU_WIN] + (size_t)j * 1024 * 4096, 1024, 4096, (bf16*)(ws + WS_WSGUIN) + (size_t)j * 4096 * 1024, scr, r % IT_SIN, F.lane); continue; } r -= 2 * IT_SIN;
            if (r < 2 * IT_SOUT) { const int j = r / IT_SOUT; p0_transpose_item(A->in[I_SGU_WOUT] + (size_t)j * 2048 * 1024, 2048, 1024, (bf16*)(ws + WS_WSGUOUT) + (size_t)j * 1024 * 2048, scr, r % IT_SOUT, F.lane); continue; } r -= 2 * IT_SOUT;
            if (r < IT_SQ) { p0_transpose_item(A->in[I_POOL_WIN], 1024, 1024, (bf16*)(ws + WS_WPOOLIN), scr, r, F.lane); continue; } r -= IT_SQ;
            if (r < IT_SQ) { p0_transpose_item(A->in[I_POOL_WOUT], 1024, 1024, (bf16*)(ws + WS_WPOOLOUT), scr, r, F.lane); continue; } r -= IT_SQ;
            if (r < 4 * IT_GRP) { const int j = r / IT_GRP; p0_transpose_item(A->in[I_POOL_WGRP] + (size_t)j * 65536, 256, 256, (bf16*)(ws + WS_WGRP) + (size_t)j * 65536, scr, r % IT_GRP, F.lane); continue; } r -= 4 * IT_GRP;
            if (r < IT_QKV) { p0_transpose_item(A->in[I_ATT_WQKV], 1024, 1536, (bf16*)(ws + WS_WQKV), scr, r, F.lane); continue; } r -= IT_QKV;
            { p0_transpose_item(A->in[I_ATT_WO], 1024, 1024, (bf16*)(ws + WS_WO), scr, r, F.lane); }
        }
        for (long ch = gt; ch < (long)DEPTH * 1024 * 2048 / 8; ch += NGT) {
            const int d8 = (int)(ch & 31), h = (int)(ch >> 5) & 7, kk = (int)(ch >> 8) & 1023, i = (int)(ch >> 18);
            const float* src = A->in[I_PEER_WQ] + ((size_t)i * 1024 + kk) * 2048 + h * 256 + d8 * 8;
            const f32x4 a = *(const f32x4*)src, b = *(const f32x4*)(src + 4);
            v4u o; o.x = pk2(a[0], a[1]); o.y = pk2(a[2], a[3]); o.z = pk2(b[0], b[1]); o.w = pk2(b[2], b[3]);
            *(v4u*)((bf16*)(ws + WS_G) + (((size_t)(i * 8 + h) * 1024 + kk) * 256 + d8 * 8)) = o;
        }
    }
    for (long ch = gt; ch < (long)DEPTH * 8 * 256 * 32; ch += NGT) {
        const int d0 = (int)(ch & 31) * 8, n = (int)(ch >> 5) & 255, ih = (int)(ch >> 13);
        v4u o = {0u, 0u, 0u, 0u};
        const float* src = nullptr;
        if (n < 128 && d0 < 128) src = A->in[I_PEER_K1] + ((size_t)ih * 128 + n) * 128 + d0;
        else if (n >= 128 && d0 >= 128) src = A->in[I_PEER_K2] + ((size_t)ih * 128 + (n - 128)) * 128 + (d0 - 128);
        if (src) { const f32x4 a = *(const f32x4*)src, b = *(const f32x4*)(src + 4); o.x = pk2(a[0], a[1]); o.y = pk2(a[2], a[3]); o.z = pk2(b[0], b[1]); o.w = pk2(b[2], b[3]); }
        *(v4u*)((bf16*)(ws + WS_KB) + ch * 8) = o;
    }
    for (int rep_ = 0; rep_ < 1 + ((PREPREP >> 3) & 1); ++rep_)
    for (int row0 = gw * 4; row0 < 2 * DEPTH * NEXP; row0 += NGW * 4) {
        const bool isU = row0 < DEPTH * NEXP; const int r0 = isU ? row0 : row0 - DEPTH * NEXP;
        const float* sp = (isU ? A->in[I_PEER_U] : A->in[I_PEER_V]) + (size_t)r0 * DM;
        f32x4 v[4][4]; float am[4];
#pragma unroll
        for (int q = 0; q < 4; ++q)
#pragma unroll
            for (int j = 0; j < 4; ++j) v[q][j] = __builtin_nontemporal_load((const f32x4*)(sp + (size_t)q * DM) + F.lane + 64 * j);
#pragma unroll
        for (int q = 0; q < 4; ++q) { float m = 0.f;
#pragma unroll
            for (int j = 0; j < 4; ++j) m = fmaxf(m, fmaxf(fmaxf(fabsf(v[q][j].x), fabsf(v[q][j].y)), fmaxf(fabsf(v[q][j].z), fabsf(v[q][j].w))));
            am[q] = m; }
#pragma unroll
        for (int q = 0; q < 4; ++q) { float m = am[q]; m = fmaxf(m, shx<1>(m)); m = fmaxf(m, shx<2>(m)); m = fmaxf(m, shx<4>(m)); m = fmaxf(m, shx<8>(m)); m = fmaxf(m, shx<16>(m));
            auto r = __builtin_amdgcn_permlane32_swap(__float_as_uint(m), __float_as_uint(m), false, false); am[q] = fmaxf(__uint_as_float(r[0]), __uint_as_float(r[1])); }
        {
            const int lyr = r0 >> 14;
            unsigned char* tb4 = ws + (isU ? WS_TU : WS_TV) + (size_t)lyr * NEXP * 512;
            const unsigned bias = isU ? 0x8888u : 0x8080u;
#pragma unroll
            for (int q = 0; q < 4; ++q) { const int e = (r0 + q) & (NEXP - 1);
                float ss = 0.f;
#pragma unroll
                for (int j = 0; j < 4; ++j) ss += (v[q][j].x * v[q][j].x + v[q][j].y * v[q][j].y) + (v[q][j].z * v[q][j].z + v[q][j].w * v[q][j].w);
                ss = wave_sum(ss);
                float sc = fmaxf(0.3352f * __builtin_sqrtf(ss * (1.f / DM)), am[q] * (1.f / 16.f)); if (!(sc > 0.f)) sc = 1.f;
                const float inv = 1.f / sc;
#pragma unroll
                for (int j = 0; j < 4; ++j) { unsigned w = 0u;
#pragma unroll
                    for (int i = 0; i < 4; ++i) { const float t = __builtin_fminf(__builtin_fmaxf(v[q][j][i] * inv + 8.f, 0.f), 15.5f); w |= (unsigned)t << (4 * i); }
                    *(unsigned short*)(tb4 + (size_t)j * (NEXP * 128) + (size_t)e * 128 + 2 * F.lane) = (unsigned short)(w ^ bias); }
                if (F.lane == 0) ((float*)(ws + (isU ? WS_SU : WS_SV)))[r0 + q] = sc; }
        }
    }
}

__device__ __forceinline__ float wave_max(float v) {
    v = fmaxf(v, shx<1>(v)); v = fmaxf(v, shx<2>(v)); v = fmaxf(v, shx<4>(v)); v = fmaxf(v, shx<8>(v)); v = fmaxf(v, shx<16>(v));
    { auto r = __builtin_amdgcn_permlane32_swap(__float_as_uint(v), __float_as_uint(v), false, false); v = fmaxf(__uint_as_float(r[0]), __uint_as_float(r[1])); }
    return v;
}
__device__ __forceinline__ void op_modulate(Frame& F, KArgs A, const float* srcLat, const float* srcCtx, const bf16* srcX, const float* gain, const float* modl, int ch_shift, int nrows, bool fin, bool hq = false) {
    const int gw = F.vcu * NWAVES + F.wave, NGW = F.G * NWAVES;
    bf16* H = (bf16*)(ws_ + WS_H);
    for (int row = gw; row < nrows; row += NGW) {
        const int mr = row < NLAT ? (row >> 11) : 8;
        const float* sh = modl + mr * MODW + ch_shift * DM; const float* sc = sh + DM;
        f32x4 v[4]; float s = 0.f;
        if (srcX) { const v2u* xr = (const v2u*)(srcX + (size_t)row * DM);
#pragma unroll
            for (int j = 0; j < 4; ++j) { const v2u q = xr[F.lane + 64 * j]; v[j] = (f32x4){bflo(q.x), bfhi(q.x), bflo(q.y), bfhi(q.y)}; }
        } else { const float* xr = row < NLAT ? srcLat + (size_t)row * DM : srcCtx + (size_t)(row - NLAT) * DM;
#pragma unroll
            for (int j = 0; j < 4; ++j) v[j] = *((const f32x4*)xr + F.lane + 64 * j); }
#pragma unroll
        for (int j = 0; j < 4; ++j) s += (v[j].x * v[j].x + v[j].y * v[j].y) + (v[j].z * v[j].z + v[j].w * v[j].w);
        const float rstd = __builtin_amdgcn_rsqf(wave_sum(s) * (1.f / DM) + EPS);
        if (fin) {
            f32x4* o16 = (f32x4*)(A->out + (size_t)row * DM) + F.lane;
#pragma unroll
            for (int j = 0; j < 4; ++j) { const f32x4 g = *((const f32x4*)gain + F.lane + 64 * j); o16[64 * j] = v[j] * rstd * g; }
            continue;
        }
        v2u* o8 = (v2u*)(H + (size_t)row * DM) + F.lane;
        float m = 0.f;
#pragma unroll
        for (int j = 0; j < 4; ++j) { const f32x4 g = *((const f32x4*)gain + F.lane + 64 * j), a = *((const f32x4*)sc + F.lane + 64 * j), b = *((const f32x4*)sh + F.lane + 64 * j);
            const f32x4 y = v[j] * rstd * g * (a + 1.f) + b; v2u w; w.x = pk2(y[0], y[1]); w.y = pk2(y[2], y[3]); o8[64 * j] = w;
            if (hq) { v[j] = y; m = fmaxf(m, fmaxf(fmaxf(fabsf(y[0]), fabsf(y[1])), fmaxf(fabsf(y[2]), fabsf(y[3])))); } }
        if (hq) {
            m = wave_max(m);
            const float inv = m > 0.f ? 119.f / m : 0.f;
            unsigned short* hp = (unsigned short*)(ws_ + WS_H8) + (size_t)row * 512 + F.lane;
#pragma unroll
            for (int j = 0; j < 4; ++j) { unsigned pa = 0u, pb = 0u;
#pragma unroll
                for (int i = 0; i < 4; ++i) { int q = (int)__builtin_rintf(v[j][i] * inv); q = q > 119 ? 119 : (q < -119 ? -119 : q);
                    const int b = ((q + 8) & 15) - 8, a = (q - b) >> 4; pa |= ((unsigned)a & 15u) << (4 * i); pb |= ((unsigned)b & 15u) << (4 * i); }
                hp[j * 128] = (unsigned short)pa; hp[j * 128 + 64] = (unsigned short)pb; }
            if (F.lane == 0) ((float*)(ws_ + WS_SHQ))[row] = m * (1.f / 119.f);
        }
    }
}

__device__ __forceinline__ void op_spatial(Frame& F, KArgs A, int j, int nrows) {
    const float* Ws = A->in[I_SGU_WS] + (size_t)j * 8 * 128 * 128; const float* vgain = A->in[I_SGU_VG] + (size_t)j * SGUW; const float* bs = A->in[I_SGU_BS] + (size_t)j * 8 * 128;
    const bf16* ZU = (const bf16*)(ws_ + WS_Z); const bf16* VT = ZU + (size_t)NTOK * SGUW; bf16* GT = (bf16*)(ws_ + WS_G); const float* SS = (const float*)(ws_ + WS_SS);
    LAS unsigned char* lA = F.lds;
    LAS unsigned char* lB = F.lds + 34816;
    LAS float* lR = (LAS float*)(F.lds + 34816 + 69632);
    const int nunits = (nrows / 128) * 8;
    const int wr = F.wave >> 2, wc = F.wave & 3, fr = F.lane & 15, fq = F.lane >> 4;
    int u = F.vcu;
    if (u >= nunits) return;
    const int g = u & 7;
    if ((F.G & 7) != 0) {
    }
    const unsigned tid = (unsigned)F.tid;
    f32x4 wsr[4][2];
#pragma unroll
    for (int it = 0; it < 4; ++it) { const unsigned e = it * 512u + tid, p = e >> 4, q0 = (e & 15u) * 8u; const float* sp = Ws + ((size_t)g * 128 + p) * 128 + q0; wsr[it][0] = *(const f32x4*)sp; wsr[it][1] = *(const f32x4*)(sp + 4); }
    const unsigned erow = tid >> 5, d0 = (tid & 31u) * 8u;
    const f32x4 vg0 = *(const f32x4*)(vgain + g * 256 + d0), vg1 = *(const f32x4*)(vgain + g * 256 + d0 + 4);
    float bsr[8];
#pragma unroll
    for (int ps = 0; ps < 8; ++ps) bsr[ps] = bs[g * 128 + ps * 16 + erow];
    v4u breg[8];
#define SP_PREFETCH(uu) do { const int _c = (uu) >> 3, _g = (uu) & 7; \
        _Pragma("unroll") for (int it = 0; it < 8; ++it) { const unsigned e = it * 512u + tl, d = e >> 4, q0 = (e & 15u) * 8u; breg[it] = *(const v4u*)(VT + (size_t)(_g * 256 + d) * NTOK + _c * 128 + q0); } } while (0)
    unsigned tl = tid; asm volatile("" : "+v"(tl));
    SP_PREFETCH(u);
    for (; u < nunits; u += F.G) {
        const int c = u >> 3;
        tl = tid; asm volatile("" : "+v"(tl));
        if (tid < 128u) { float sq = 0.f;
#pragma unroll
            for (int sl = 0; sl < 16; ++sl) sq += SS[(size_t)sl * NTOK + c * 128 + tid];
            lR[tid] = __builtin_amdgcn_rsqf(sq * (1.f / SGUW) + EPS); }
        __syncthreads();
#pragma unroll
        for (int it = 0; it < 4; ++it) { const unsigned e = it * 512u + tid, p = e >> 4, q0 = (e & 15u) * 8u; const f32x4 a = wsr[it][0], bq = wsr[it][1];
            v4u o; o.x = pk2(a[0] * lR[q0], a[1] * lR[q0 + 1]); o.y = pk2(a[2] * lR[q0 + 2], a[3] * lR[q0 + 3]); o.z = pk2(bq[0] * lR[q0 + 4], bq[1] * lR[q0 + 5]); o.w = pk2(bq[2] * lR[q0 + 6], bq[3] * lR[q0 + 7]);
            *(LAS v4u*)(lA + p * 272 + q0 * 2) = o; }
#pragma unroll
        for (int it = 0; it < 8; ++it) { const unsigned e = it * 512u + tid, d = e >> 4, q0 = (e & 15u) * 8u; *(LAS v4u*)(lB + d * 272 + q0 * 2) = breg[it]; }
        __syncthreads();
        { const int un = (u + F.G < nunits) ? u + F.G : u; SP_PREFETCH(un); }
        v4u zu[8];
        const size_t rowbase = (size_t)(c * 128) * SGUW + g * 256 + d0;
#pragma unroll
        for (int ps = 0; ps < 8; ++ps) zu[ps] = *(const v4u*)(ZU + rowbase + (size_t)(ps * 16 + erow) * SGUW);
        f32x4 acc[4][4];
#pragma unroll
        for (int m = 0; m < 4; ++m)
#pragma unroll
            for (int n = 0; n < 4; ++n) acc[m][n] = (f32x4){0.f, 0.f, 0.f, 0.f};
#pragma unroll
        for (int k = 0; k < 4; ++k) {
            bf16x8 af[4], bfr[4];
#pragma unroll
            for (int m = 0; m < 4; ++m) af[m] = *(const LAS bf16x8*)(lA + (wr * 64 + m * 16 + fr) * 272 + (k * 32 + fq * 8) * 2);
#pragma unroll
            for (int n = 0; n < 4; ++n) bfr[n] = *(const LAS bf16x8*)(lB + (wc * 64 + n * 16 + fr) * 272 + (k * 32 + fq * 8) * 2);
#pragma unroll
            for (int m = 0; m < 4; ++m)
#pragma unroll
                for (int n = 0; n < 4; ++n) acc[m][n] = __builtin_amdgcn_mfma_f32_16x16x32_bf16(bfr[n], af[m], acc[m][n], 0, 0, 0);
        }
        __syncthreads();
#pragma unroll
        for (int m = 0; m < 4; ++m)
#pragma unroll
            for (int n = 0; n < 4; ++n) { v2u w; w.x = pk2(acc[m][n][0], acc[m][n][1]); w.y = pk2(acc[m][n][2], acc[m][n][3]);
                *(LAS v2u*)(lB + (wr * 64 + m * 16 + fr) * 528 + (wc * 64 + n * 16 + 4 * fq) * 2) = w; }
        __syncthreads();
#pragma unroll
        for (int ps = 0; ps < 8; ++ps) { const unsigned p = ps * 16u + erow; const v4u sv = *(const LAS v4u*)(lB + p * 528 + d0 * 2); const v4u z = zu[ps]; const float bsv = bsr[ps];
            v4u o;
            o.x = pk2(bflo(z.x) * (bflo(sv.x) * vg0[0] + bsv), bfhi(z.x) * (bfhi(sv.x) * vg0[1] + bsv)); o.y = pk2(bflo(z.y) * (bflo(sv.y) * vg0[2] + bsv), bfhi(z.y) * (bfhi(sv.y) * vg0[3] + bsv));
            o.z = pk2(bflo(z.z) * (bflo(sv.z) * vg1[0] + bsv), bfhi(z.z) * (bfhi(sv.z) * vg1[1] + bsv)); o.w = pk2(bflo(z.w) * (bflo(sv.w) * vg1[2] + bsv), bfhi(z.w) * (bfhi(sv.w) * vg1[3] + bsv));
            *(v4u*)(GT + rowbase + (size_t)p * SGUW) = o; }
    }
#undef SP_PREFETCH
}

__device__ __forceinline__ void op_pool(Frame& F, KArgs A, int nrows) {
    const bf16* ZP = (const bf16*)(ws_ + WS_Z); bf16* P = (bf16*)(ws_ + WS_G);
    const long gt = (long)F.vcu * (NWAVES * 64) + F.tid, NGT = (long)F.G * NWAVES * 64;
    constexpr int RUN = 32;
    for (long e = gt; e < (long)(nrows / RUN) * 128; e += NGT) {
        const int run = (int)(e >> 7), c0 = (int)(e & 127) * 8, g = c0 >> 8, half = 1 << g;
        const int row0 = run * RUN;
        int pos0, L; if (row0 < NLAT) { pos0 = row0 & (SEQ - 1); L = SEQ; } else { pos0 = (row0 - NLAT) & (CTXL - 1); L = CTXL; }
        const bf16* zb = ZP + (size_t)(row0 - pos0) * DM + c0;
        float s[8];
#pragma unroll
        for (int i = 0; i < 8; ++i) s[i] = 0.f;
#define POOL_ACC(sgn, vv) do { const v4u _v = (vv); s[0] += (sgn) * bflo(_v.x); s[1] += (sgn) * bfhi(_v.x); s[2] += (sgn) * bflo(_v.y); s[3] += (sgn) * bfhi(_v.y); \
        s[4] += (sgn) * bflo(_v.z); s[5] += (sgn) * bfhi(_v.z); s[6] += (sgn) * bflo(_v.w); s[7] += (sgn) * bfhi(_v.w); } while (0)
#pragma unroll
        for (int w = 0; w < 16; ++w) { const int t = pos0 - half + w; const bool in = (w < 2 * half) && t >= 0 && t < L; const int tc = min(max(t, 0), L - 1);
            const v4u v = *(const v4u*)(zb + (size_t)tc * DM); const float f = in ? 1.f : 0.f; POOL_ACC(f, v); }
#pragma unroll 8
        for (int i = 0; i < RUN; ++i) {
            const int pos = pos0 + i;
            const int lo = max(pos - half, 0), hi = min(pos + half, L);
            const v4u z = *(const v4u*)(zb + (size_t)pos * DM); const float ic = 1.f / (float)(hi - lo);
            v4u o; o.x = pk2(s[0] * ic - bflo(z.x), s[1] * ic - bfhi(z.x)); o.y = pk2(s[2] * ic - bflo(z.y), s[3] * ic - bfhi(z.y));
            o.z = pk2(s[4] * ic - bflo(z.z), s[5] * ic - bfhi(z.z)); o.w = pk2(s[6] * ic - bflo(z.w), s[7] * ic - bfhi(z.w));
            *(v4u*)(P + (size_t)(row0 + i) * DM + c0) = o;
            const int tin = pos + half, tout = pos - half;
            const v4u vin = *(const v4u*)(zb + (size_t)min(tin, L - 1) * DM), vout = *(const v4u*)(zb + (size_t)max(tout, 0) * DM);
            POOL_ACC(tin < L ? 1.f : 0.f, vin); POOL_ACC(tout >= 0 ? -1.f : 0.f, vout);
        }
#undef POOL_ACC
    }
}

__device__ __forceinline__ void op_qknorm(Frame& F, KArgs A, int nrows) {
    const bf16* R = (const bf16*)(ws_ + WS_Z);
    bf16* QB = (bf16*)(ws_ + WS_G); bf16* KBUF = QB + (size_t)NTOK * DM; bf16* VBUF = KBUF + (size_t)NB * KVROWS * 256;
    const float* qg = A->in[I_ATT_QG]; const float* kg = A->in[I_ATT_KG];
    LAS float* tab = (LAS float*)F.lds;
    for (int e = F.tid; e < 64 * 32; e += NWAVES * 64) { const int pos = e >> 5, f = e & 31; const float fr = __expf(-(float)f * (9.210340371976184f / 32.f)); float sn, cs; sincosf((float)pos * fr, &sn, &cs); tab[e * 2] = cs; tab[e * 2 + 1] = sn; }
    __syncthreads();
    const int gw = F.vcu * NWAVES + F.wave, NGW = F.G * NWAVES;
    const int hl = F.lane >> 4, j = F.lane & 15;
    for (int row = gw; row < nrows; row += NGW) {
        const bool lat = row < NLAT; int b, pos; if (lat) { b = row >> 11; pos = row & (SEQ - 1); } else { b = (row - NLAT) >> 8; pos = (row - NLAT) & (CTXL - 1); }
        const int krow = b * KVROWS + (lat ? pos : SEQ + pos);
        const bf16* rr = R + (size_t)row * 1536;
#pragma unroll
        for (int pass = 0; pass < 3; ++pass) {
            const int head = pass * 4 + hl;
            const bool act = head < 10;
            float x[8];
            { v4u v = {0u, 0u, 0u, 0u}; if (act) v = *(const v4u*)(rr + head * 128 + j * 8);
              x[0] = bflo(v.x); x[1] = bfhi(v.x); x[2] = bflo(v.y); x[3] = bfhi(v.y); x[4] = bflo(v.z); x[5] = bfhi(v.z); x[6] = bflo(v.w); x[7] = bfhi(v.w); }
            float ss = 0.f;
#pragma unroll
            for (int i = 0; i < 8; ++i) ss += x[i] * x[i];
            ss += shx<1>(ss); ss += shx<2>(ss); ss += shx<4>(ss); ss += shx<8>(ss);
            const float rstd = __builtin_amdgcn_rsqf(ss * (1.f / 128.f) + EPS);
            const float* gn = (head < 8 ? qg : kg) + j * 8;
#pragma unroll
            for (int i = 0; i < 8; ++i) x[i] = x[i] * rstd * gn[i];
            float y[8];
#pragma unroll
            for (int i = 0; i < 8; ++i) { const float other = shx<4>(x[i]);
                const int dd = j * 8 + i, f = dd & 31, axis = dd >> 6, second = (dd >> 5) & 1;
                const int p = axis ? (pos & 63) : (pos >> 6);
                const float cs = tab[(p * 32 + f) * 2], sn = tab[(p * 32 + f) * 2 + 1];
                y[i] = lat ? (second ? x[i] * cs + other * sn : x[i] * cs - other * sn) : x[i]; }
            if (act) { v4u o; o.x = pk2(y[0], y[1]); o.y = pk2(y[2], y[3]); o.z = pk2(y[4], y[5]); o.w = pk2(y[6], y[7]);
                if (head < 8) *(v4u*)(QB + (size_t)row * DM + head * 128 + j * 8) = o;
                else *(v4u*)(KBUF + (size_t)krow * 256 + (head - 8) * 128 + j * 8) = o; }
        }
        if (F.lane < 32) *(v4u*)(VBUF + (size_t)krow * 256 + F.lane * 8) = *(const v4u*)(rr + 1280 + F.lane * 8);
    }
}

__device__ __forceinline__ void op_attn(Frame& F, KArgs A) {
    const attn::bf16* QB = (const attn::bf16*)(ws_ + WS_G); const attn::bf16* KBUF = QB + (size_t)NTOK * DM; const attn::bf16* VBUF = KBUF + (size_t)NB * KVROWS * 256;
    attn::bf16* OB = (attn::bf16*)(ws_ + WS_H);
    for (int u = F.vcu; u < 576; u += F.G) {
        int b, hq, rowbase, kbase, seq;
        if (u < 512) { b = u >> 6; hq = (u >> 3) & 7; rowbase = b * SEQ + (u & 7) * 256; kbase = b * KVROWS; seq = KVROWS; }
        else { const int v = u - 512; b = v >> 3; hq = v & 7; rowbase = NLAT + b * CTXL; kbase = b * KVROWS + SEQ; seq = CTXL; }
        const size_t qo = (size_t)rowbase * DM + hq * 128, ko = (size_t)kbase * 256 + (hq >> 2) * 128;
        attn::attn_dense_body(QB + qo, KBUF + ko, VBUF + ko, OB + qo, seq, (char*)F.lds, F.tid);
    }
}

__device__ __forceinline__ unsigned fkey(float v) { const unsigned u = __float_as_uint(v); return (u & 0x80000000u) ? ~u : (u | 0x80000000u); }
__device__ __forceinline__ float keyf(unsigned k) { return __uint_as_float((k & 0x80000000u) ? (k & 0x7fffffffu) : ~k); }
#define ROR_MAX(m, n) m = max(m, (unsigned)__builtin_amdgcn_update_dpp(0, (int)(m), 0x120 + (n), 0xf, 0xf, false))
__device__ __forceinline__ unsigned row_max16(unsigned m) { ROR_MAX(m, 1); ROR_MAX(m, 2); ROR_MAX(m, 4); ROR_MAX(m, 8); return m; }
__device__ __forceinline__ float row_sum16(float v) {
    v += __uint_as_float((unsigned)__builtin_amdgcn_update_dpp(0, (int)__float_as_uint(v), 0x121, 0xf, 0xf, false));
    v += __uint_as_float((unsigned)__builtin_amdgcn_update_dpp(0, (int)__float_as_uint(v), 0x122, 0xf, 0xf, false));
    v += __uint_as_float((unsigned)__builtin_amdgcn_update_dpp(0, (int)__float_as_uint(v), 0x124, 0xf, 0xf, false));
    v += __uint_as_float((unsigned)__builtin_amdgcn_update_dpp(0, (int)__float_as_uint(v), 0x128, 0xf, 0xf, false));
    return v;
}
#define CE(a, b) do { const unsigned _x = max(a, b), _y = min(a, b); a = _x; b = _y; } while (0)
__device__ __forceinline__ void op_topk(Frame& F, KArgs A, int layer, int nrows) {
    const unsigned short* SC = (const unsigned short*)(ws_ + WS_Z);   int* IDX = (int*)(ws_ + WS_IDX); pg8::f32x2* SG = (pg8::f32x2*)(ws_ + WS_SG); const float* SHQ = (const float*)(ws_ + WS_SHQ);
    const float* SU = (const float*)(ws_ + WS_SU) + (size_t)layer * NEXP; const float* SV = (const float*)(ws_ + WS_SV) + (size_t)layer * NEXP;
    const int gw = F.vcu * NWAVES + F.wave, NGW = F.G * NWAVES;
    const int rowi = F.lane >> 4, l16 = F.lane & 15, half = rowi & 1, pr = rowi >> 1;
    const int npairs = nrows * 8;
    const int base1 = (rowi & ~1) * 16, base2 = base1 + 16;
    v4u va[2];
    { const int pb = gw * 4;
#pragma unroll
      for (int u = 0; u < 2; ++u) { const int th = min(pb + 2 * u + pr, npairs - 1); const unsigned short* sp = SC + (size_t)th * 256 + half * 128;
          va[u] = *(const v4u*)(sp + 8 * l16); } }
    for (int pb = gw * 4; pb < npairs; pb += NGW * 4) {
        unsigned k[2][8];
#pragma unroll
        for (int u = 0; u < 2; ++u)
#pragma unroll
            for (int i = 0; i < 4; ++i) { const h2_t hv = u2h(va[u][i]);
                k[u][2 * i] = (fkey((float)hv.x) & ~127u) | (unsigned)(8 * l16 + 2 * i); k[u][2 * i + 1] = (fkey((float)hv.y) & ~127u) | (unsigned)(8 * l16 + 2 * i + 1); }
        { const int pn = pb + NGW * 4;
#pragma unroll
          for (int u = 0; u < 2; ++u) { const int th = min(pn + 2 * u + pr, npairs - 1); const unsigned short* sp = SC + (size_t)th * 256 + half * 128;
              va[u] = *(const v4u*)(sp + 8 * l16); } }
#pragma unroll
        for (int u = 0; u < 2; ++u) {
            CE(k[u][0], k[u][1]); CE(k[u][2], k[u][3]); CE(k[u][4], k[u][5]); CE(k[u][6], k[u][7]);
            CE(k[u][0], k[u][2]); CE(k[u][1], k[u][3]); CE(k[u][4], k[u][6]); CE(k[u][5], k[u][7]);
            CE(k[u][1], k[u][2]); CE(k[u][5], k[u][6]); CE(k[u][0], k[u][4]); CE(k[u][3], k[u][7]);
            CE(k[u][1], k[u][5]); CE(k[u][2], k[u][6]);
            CE(k[u][1], k[u][4]); CE(k[u][3], k[u][6]);
            CE(k[u][2], k[u][4]); CE(k[u][3], k[u][5]);
            CE(k[u][3], k[u][4]); }
        unsigned res[2] = {0u, 0u};
#pragma unroll
        for (int it = 0; it < 16; ++it) {
#pragma unroll
            for (int u = 0; u < 2; ++u) {
                const unsigned m = row_max16(k[u][0]);
                res[u] = (l16 == it) ? m : res[u];
                const bool win = (k[u][0] == m);
#pragma unroll
                for (int i = 0; i < 7; ++i) k[u][i] = win ? k[u][i + 1] : k[u][i];
                k[u][7] = win ? 0u : k[u][7];
            }
        }
        float val[2]; int kid[2];
#pragma unroll
        for (int u = 0; u < 2; ++u) { val[u] = keyf(res[u] & ~127u); kid[u] = (int)(res[u] & 127u); }
        const int rowbase = rowi * 16, src1 = half ? rowbase - 16 : rowbase, src2 = half ? rowbase : rowbase + 16;
        const float v1o = bperm(src1 + l16, val[1]); const float v1 = half ? v1o : val[0];
        int p = 0;
        const float v2a0 = bperm(src2, val[0]), v2b0 = bperm(src2, val[1]);
        float v2p = half ? v2b0 : v2a0;
        unsigned ck = (fkey(v1 + v2p) & ~255u) | (unsigned)(l16 * 16), best = 0u;
#pragma unroll
        for (int it = 0; it < 16; ++it) {
            const unsigned m = row_max16(ck);
            best = (l16 == it) ? m : best;
            const bool win = (ck == m);
            p += win ? 1 : 0;
            const int pc = min(p, 15);
            const float va = bperm(src2 + pc, val[0]), vb = bperm(src2 + pc, val[1]);
            v2p = half ? vb : va;
            const unsigned nk = (p > 15) ? 0u : ((fkey(v1 + v2p) & ~255u) | (unsigned)(l16 * 16 + pc));
            ck = win ? nk : ck;
        }
        {
            const int th = pb + 2 * half + pr;
            const int cid = (int)(best & 255u); const float bsum = keyf(best & ~255u);
            const int e1a = bperm_i(src1 + (cid >> 4), kid[0]), e1b = bperm_i(src1 + (cid >> 4), kid[1]);
            const int e2a = bperm_i(src2 + (cid & 15), kid[0]), e2b = bperm_i(src2 + (cid & 15), kid[1]);
            const int e1 = half ? e1b : e1a, e2 = half ? e2b : e2a;
            const float mx = bperm(rowbase, bsum);
            const float ex = __expf(bsum - mx);
            const float den = row_sum16(ex);
            if (th < npairs) { const int eid = e1 * 128 + e2; IDX[(size_t)th * 16 + l16] = eid;
                SG[(size_t)th * 16 + l16] = (pg8::f32x2){SU[eid] * (SHQ[th >> 3] * 16.f), (ex / den) * SV[eid]}; }
        }
    }
}

__device__ __forceinline__ void fmac(float& d, float a, float b) { asm("v_fmac_f32 %0, %1, %2" : "+v"(d) : "v"(a), "v"(b)); }
#define FP8_LO(w) __builtin_amdgcn_cvt_pk_f32_fp8((int)(w), false)
#define FP8_HI(w) __builtin_amdgcn_cvt_pk_f32_fp8((int)(w), true)
#define DOT16(a, r) do { pg8::f32x2 _f; \
    _f = FP8_LO((r).x); a += _f.x * hf[0] + _f.y * hf[1];   _f = FP8_HI((r).x); a += _f.x * hf[2] + _f.y * hf[3]; \
    _f = FP8_LO((r).y); a += _f.x * hf[4] + _f.y * hf[5];   _f = FP8_HI((r).y); a += _f.x * hf[6] + _f.y * hf[7]; \
    _f = FP8_LO((r).z); a += _f.x * hf[8] + _f.y * hf[9];   _f = FP8_HI((r).z); a += _f.x * hf[10] + _f.y * hf[11]; \
    _f = FP8_LO((r).w); a += _f.x * hf[12] + _f.y * hf[13]; _f = FP8_HI((r).w); a += _f.x * hf[14] + _f.y * hf[15]; } while (0)
#define AXPY16(w, r) do { pg8::f32x2 _f; \
    _f = FP8_LO((r).x); fmac(fo[0], (w), _f.x); fmac(fo[1], (w), _f.y);   _f = FP8_HI((r).x); fmac(fo[2], (w), _f.x); fmac(fo[3], (w), _f.y); \
    _f = FP8_LO((r).y); fmac(fo[4], (w), _f.x); fmac(fo[5], (w), _f.y);   _f = FP8_HI((r).y); fmac(fo[6], (w), _f.x); fmac(fo[7], (w), _f.y); \
    _f = FP8_LO((r).z); fmac(fo[8], (w), _f.x); fmac(fo[9], (w), _f.y);   _f = FP8_HI((r).z); fmac(fo[10], (w), _f.x); fmac(fo[11], (w), _f.y); \
    _f = FP8_LO((r).w); fmac(fo[12], (w), _f.x); fmac(fo[13], (w), _f.y); _f = FP8_HI((r).w); fmac(fo[14], (w), _f.x); fmac(fo[15], (w), _f.y); } while (0)
#define DOT16V(a, r, H_) do { pg8::f32x2 _f; \
    _f = FP8_LO((r).x); fmac(a, _f.x, H_[0]); fmac(a, _f.y, H_[1]);   _f = FP8_HI((r).x); fmac(a, _f.x, H_[2]); fmac(a, _f.y, H_[3]); \
    _f = FP8_LO((r).y); fmac(a, _f.x, H_[4]); fmac(a, _f.y, H_[5]);   _f = FP8_HI((r).y); fmac(a, _f.x, H_[6]); fmac(a, _f.y, H_[7]); \
    _f = FP8_LO((r).z); fmac(a, _f.x, H_[8]); fmac(a, _f.y, H_[9]);   _f = FP8_HI((r).z); fmac(a, _f.x, H_[10]); fmac(a, _f.y, H_[11]); \
    _f = FP8_LO((r).w); fmac(a, _f.x, H_[12]); fmac(a, _f.y, H_[13]); _f = FP8_HI((r).w); fmac(a, _f.x, H_[14]); fmac(a, _f.y, H_[15]); } while (0)
#define CVH_LO(w) __builtin_bit_cast(h2_t, __builtin_amdgcn_cvt_scalef32_pk_f16_fp8((w), 1.0f, false))
#define CVH_HI(w) __builtin_bit_cast(h2_t, __builtin_amdgcn_cvt_scalef32_pk_f16_fp8((w), 1.0f, true))
#define DOT16H(a, r, Hh) do { \
    a = __builtin_amdgcn_fdot2(CVH_LO((r).x), Hh[0], a, false); a = __builtin_amdgcn_fdot2(CVH_HI((r).x), Hh[1], a, false); \
    a = __builtin_amdgcn_fdot2(CVH_LO((r).y), Hh[2], a, false); a = __builtin_amdgcn_fdot2(CVH_HI((r).y), Hh[3], a, false); \
    a = __builtin_amdgcn_fdot2(CVH_LO((r).z), Hh[4], a, false); a = __builtin_amdgcn_fdot2(CVH_HI((r).z), Hh[5], a, false); \
    a = __builtin_amdgcn_fdot2(CVH_LO((r).w), Hh[6], a, false); a = __builtin_amdgcn_fdot2(CVH_HI((r).w), Hh[7], a, false); } while (0)
#define AXPY16H(wh, r) do { \
    fo[0] = __builtin_elementwise_fma(CVH_LO((r).x), (wh), fo[0]); fo[1] = __builtin_elementwise_fma(CVH_HI((r).x), (wh), fo[1]); \
    fo[2] = __builtin_elementwise_fma(CVH_LO((r).y), (wh), fo[2]); fo[3] = __builtin_elementwise_fma(CVH_HI((r).y), (wh), fo[3]); \
    fo[4] = __builtin_elementwise_fma(CVH_LO((r).z), (wh), fo[4]); fo[5] = __builtin_elementwise_fma(CVH_HI((r).z), (wh), fo[5]); \
    fo[6] = __builtin_elementwise_fma(CVH_LO((r).w), (wh), fo[6]); fo[7] = __builtin_elementwise_fma(CVH_HI((r).w), (wh), fo[7]); } while (0)
__device__ __forceinline__ h2_t pkh(float a, float b) { return __builtin_bit_cast(h2_t, __builtin_amdgcn_cvt_pkrtz(a, b)); }
#define CVL(d, w) asm volatile("v_cvt_scalef32_pk_f16_fp8 %0, %1, 1.0" : "=v"(d) : "v"(w))
#define CVU(d, w) asm volatile("v_cvt_scalef32_pk_f16_fp8 %0, %1, 1.0 op_sel:[1,0,0]" : "=v"(d) : "v"(w))
#define D2H(a, x, h) asm volatile("v_dot2c_f32_f16 %0, %1, %2" : "+v"(a) : "v"(x), "v"(h))
#define PKF(f, x, w) asm volatile("v_pk_fma_f16 %0, %1, %2, %0" : "+v"(f) : "v"(x), "v"(w))
#define DOT2ROWS(accA, accB, ra, rb, hu) do { unsigned _t0, _t1, _t2, _t3, _t4, _t5, _t6, _t7, _s0, _s1, _s2, _s3, _s4, _s5, _s6, _s7; float _a2 = 0.f, _b2 = 0.f; \
    CVL(_t0, (ra).x); CVU(_t1, (ra).x); CVL(_t2, (ra).y); CVU(_t3, (ra).y); CVL(_t4, (ra).z); CVU(_t5, (ra).z); CVL(_t6, (ra).w); CVU(_t7, (ra).w); \
    CVL(_s0, (rb).x); CVU(_s1, (rb).x); CVL(_s2, (rb).y); CVU(_s3, (rb).y); CVL(_s4, (rb).z); CVU(_s5, (rb).z); CVL(_s6, (rb).w); CVU(_s7, (rb).w); \
    D2H(accA, _t0, hu[0]); D2H(accB, _s0, hu[0]); D2H(_a2, _t1, hu[1]); D2H(_b2, _s1, hu[1]); D2H(accA, _t2, hu[2]); D2H(accB, _s2, hu[2]); D2H(_a2, _t3, hu[3]); D2H(_b2, _s3, hu[3]); \
    D2H(accA, _t4, hu[4]); D2H(accB, _s4, hu[4]); D2H(_a2, _t5, hu[5]); D2H(_b2, _s5, hu[5]); D2H(accA, _t6, hu[6]); D2H(accB, _s6, hu[6]); \
      \
    asm volatile("v_dot2c_f32_f16 %2, %4, %6\n\tv_dot2c_f32_f16 %3, %5, %6\n\ts_nop 2\n\tv_add_f32 %0, %0, %2\n\tv_add_f32 %1, %1, %3" \
        : "+v"(accA), "+v"(accB), "+v"(_a2), "+v"(_b2) : "v"(_t7), "v"(_s7), "v"(hu[7])); } while (0)
#define AXPYROW(fu, wu, r) do { unsigned _t0, _t1, _t2, _t3, _t4, _t5, _t6, _t7; \
    CVL(_t0, (r).x); CVU(_t1, (r).x); CVL(_t2, (r).y); CVU(_t3, (r).y); CVL(_t4, (r).z); CVU(_t5, (r).z); CVL(_t6, (r).w); CVU(_t7, (r).w); \
    PKF(fu[0], _t0, wu); PKF(fu[1], _t1, wu); PKF(fu[2], _t2, wu); PKF(fu[3], _t3, wu); PKF(fu[4], _t4, wu); PKF(fu[5], _t5, wu); PKF(fu[6], _t6, wu); PKF(fu[7], _t7, wu); } while (0)
#define C4B0(d, w) asm volatile("v_cvt_scalef32_pk_f16_fp4 %0, %1, 1.0" : "=v"(d) : "v"(w))
#define C4B1(d, w) asm volatile("v_cvt_scalef32_pk_f16_fp4 %0, %1, 1.0 op_sel:[1,0,0]" : "=v"(d) : "v"(w))
#define C4B2(d, w) asm volatile("v_cvt_scalef32_pk_f16_fp4 %0, %1, 1.0 op_sel:[0,1,0]" : "=v"(d) : "v"(w))
#define C4B3(d, w) asm volatile("v_cvt_scalef32_pk_f16_fp4 %0, %1, 1.0 op_sel:[1,1,0]" : "=v"(d) : "v"(w))
#define C4ROW(T, r) do { C4B0(T[0], (r).x); C4B1(T[1], (r).x); C4B2(T[2], (r).x); C4B3(T[3], (r).x); C4B0(T[4], (r).y); C4B1(T[5], (r).y); C4B2(T[6], (r).y); C4B3(T[7], (r).y); \
    C4B0(T[8], (r).z); C4B1(T[9], (r).z); C4B2(T[10], (r).z); C4B3(T[11], (r).z); C4B0(T[12], (r).w); C4B1(T[13], (r).w); C4B2(T[14], (r).w); C4B3(T[15], (r).w); } while (0)
#define DOT2ROWS4(accA, accB, ra, rb, hu) do { unsigned _t[16], _s[16]; float _a2 = 0.f, _b2 = 0.f; C4ROW(_t, ra); C4ROW(_s, rb); \
    _Pragma("unroll") for (int _i = 0; _i < 14; _i += 2) { D2H(accA, _t[_i], hu[_i]); D2H(accB, _s[_i], hu[_i]); D2H(_a2, _t[_i + 1], hu[_i + 1]); D2H(_b2, _s[_i + 1], hu[_i + 1]); } \
    D2H(accA, _t[14], hu[14]); D2H(accB, _s[14], hu[14]); \
    asm volatile("v_dot2c_f32_f16 %2, %4, %6\n\tv_dot2c_f32_f16 %3, %5, %6\n\ts_nop 2\n\tv_add_f32 %0, %0, %2\n\tv_add_f32 %1, %1, %3" \
        : "+v"(accA), "+v"(accB), "+v"(_a2), "+v"(_b2) : "v"(_t[15]), "v"(_s[15]), "v"(hu[15])); } while (0)
#define AXPYROW4(fu, wu, r) do { unsigned _t[16]; C4ROW(_t, r); _Pragma("unroll") for (int _i = 0; _i < 16; ++_i) PKF(fu[_i], _t[_i], wu); } while (0)
__device__ __forceinline__ void slice_map(Frame& F, KArgs A, int& x0, int& nsl, int& w0, int& NW_) {
    if ((F.G % 8) != 0) { x0 = 0; nsl = 8; w0 = F.vcu * NWAVES + F.wave; NW_ = F.G * NWAVES; return; }
    unsigned* bar = (unsigned*)(ws_ + WS_CTL) + CW_BAR; bool even = true;
#pragma unroll
    for (int j = 0; j < 8; ++j) even = even && (xb_ld(&bar[XB_XCNT(j)]) == (unsigned)(F.G >> 3));
    const unsigned rk = ((volatile LAS unsigned*)(F.lds + MISC_OFF))[12], xcc = ((volatile LAS unsigned*)(F.lds + MISC_OFF))[13];
    const int sl = even ? (int)__builtin_amdgcn_readfirstlane(xcc) : (F.bx & 7), sub = even ? (int)__builtin_amdgcn_readfirstlane(rk) : (F.bx >> 3);
    x0 = sl; nsl = 1; w0 = sub * NWAVES + F.wave; NW_ = (F.G >> 3) * NWAVES;
}
__device__ __forceinline__ void slice_map4(Frame& F, KArgs A, int& x0, int& nsl, int& w0, int& NW_) {
    slice_map(F, A, x0, nsl, w0, NW_);
    if (nsl == 8) { nsl = 4; return; }
    const int sl = x0; x0 = sl >> 1; w0 += (sl & 1) * NW_; NW_ *= 2;
}
#define G_LOAD_E(E_, tt) do { const int* _ip = IDX + (size_t)(tt) * 128; _Pragma("unroll") for (int q = 0; q < 4; ++q) E_[q] = *(const v4u*)(_ip + 16u * gg + 4u * q); } while (0)
#define G_LOAD_R8(R_, Ea, Eb, tsl_) do { \
    R_[0] = *(const v4u*)((tsl_) + ((Ea).x * 128u + 16u * pp)); R_[1] = *(const v4u*)((tsl_) + ((Ea).y * 128u + 16u * pp)); \
    R_[2] = *(const v4u*)((tsl_) + ((Ea).z * 128u + 16u * pp)); R_[3] = *(const v4u*)((tsl_) + ((Ea).w * 128u + 16u * pp)); \
    R_[4] = *(const v4u*)((tsl_) + ((Eb).x * 128u + 16u * pp)); R_[5] = *(const v4u*)((tsl_) + ((Eb).y * 128u + 16u * pp)); \
    R_[6] = *(const v4u*)((tsl_) + ((Eb).z * 128u + 16u * pp)); R_[7] = *(const v4u*)((tsl_) + ((Eb).w * 128u + 16u * pp)); } while (0)
#define G_RING(r_, n_) ((r_) + (n_) >= 3 ? (r_) + (n_) - 3 : (r_) + (n_))
#define G_LOAD_R8L(R_, Ea, Eb, tsl_) do { \
    R_[0] = *(const v4u*)((tsl_) + ((Ea).x * 128u + 16u * pp)); R_[1] = *(const v4u*)((tsl_) + ((Ea).y * 128u + 16u * pp)); \
    R_[2] = *(const v4u*)((tsl_) + ((Ea).z * 128u + 16u * pp)); R_[3] = *(const v4u*)((tsl_) + ((Ea).w * 128u + 16u * pp)); \
    R_[4] = *(const v4u*)((tsl_) + ((Eb).x * 128u + 16u * pp)); R_[5] = *(const v4u*)((tsl_) + ((Eb).y * 128u + 16u * pp)); \
    R_[6] = *(const v4u*)((tsl_) + ((Eb).z * 128u + 16u * pp)); R_[7] = *(const v4u*)((tsl_) + ((Eb).w * 128u + 16u * pp)); } while (0)
__device__ __forceinline__ void op_gather_u(Frame& F, KArgs A, int layer, int nrows, bool dry) {
    const unsigned char* TU = ws_ + WS_TU + (size_t)layer * NEXP * 512;
    const int* IDX = (const int*)(ws_ + WS_IDX); const unsigned* HQ = (const unsigned*)(ws_ + WS_H8);
    unsigned* PACT = (unsigned*)(ws_ + (dry ? WS_G : WS_Z));
    int x0, nsl, w0, NW_; slice_map4(F, A, x0, nsl, w0, NW_);
    const unsigned pp0 = (unsigned)F.lane & 7u, gg0 = (unsigned)F.lane >> 3, ll0 = (unsigned)F.lane;
    const bool b0 = F.lane & 1, b1 = F.lane & 2, b2 = F.lane & 4;
    LAS unsigned* lE = (LAS unsigned*)(F.lds + F.wave * 4096 + 1024);
    LAS unsigned* lH = (LAS unsigned*)(F.lds + F.wave * 4096 + 2560);
    for (int xs = 0; xs < nsl; ++xs) {
        const int x = x0 + xs;
        const unsigned char* tsl = TU + (size_t)x * (NEXP * 128);
        const unsigned* Hx = HQ + x * 64;
        int t = w0;
        if (t >= nrows) continue;
        const int tlast = t + ((nrows - 1 - t) / NW_) * NW_;
        unsigned pp = pp0, gg = gg0, ll = ll0; asm volatile("" : "+v"(pp), "+v"(gg), "+v"(ll));
        v4u R0[8], R1[8]; v2u eraw; unsigned hraw;
#define G1_GLOAD(tt) do { const int _t = (tt) < tlast ? (tt) : tlast; eraw = *(const v2u*)(IDX + (size_t)_t * 128 + 2u * ll); hraw = Hx[(size_t)_t * 256 + ll]; } while (0)
#define G1_LWRITE(r_) do { *(LAS v2u*)(lE + (r_) * 128 + 2u * ll) = eraw; lH[(r_) * 64 + ll] = hraw; } while (0)
        G1_GLOAD(t); G1_LWRITE(0); G1_GLOAD(t + NW_); G1_LWRITE(1); G1_GLOAD(t + 2 * NW_);
        { const v4u e0 = *(const LAS v4u*)(lE + 16u * gg), e1 = *(const LAS v4u*)(lE + 16u * gg + 4u); G_LOAD_R8L(R0, e0, e1, tsl); }
        int r = 0;
        while (t < nrows) {
            const int tn = t + NW_;
            pp = pp0; gg = gg0; ll = ll0; asm volatile("" : "+v"(pp), "+v"(gg), "+v"(ll));
            const unsigned k0 = 16u * gg + ((pp & 1u) << 3) + ((pp & 2u) << 1) + ((pp & 4u) >> 1);
            const int r1 = G_RING(r, 1), r2 = G_RING(r, 2);
            G1_LWRITE(r2);
            G1_GLOAD(t + 3 * NW_);
            const v4u ea0 = *(const LAS v4u*)(lE + r * 128 + 16u * gg + 8u), ea1 = *(const LAS v4u*)(lE + r * 128 + 16u * gg + 12u);
            const v4u eb0 = *(const LAS v4u*)(lE + r1 * 128 + 16u * gg), eb1 = *(const LAS v4u*)(lE + r1 * 128 + 16u * gg + 4u);
            const v4u ha = *(const LAS v4u*)(lH + r * 64 + 4u * pp), hb = *(const LAS v4u*)(lH + r * 64 + 32u + 4u * pp);
            G_LOAD_R8L(R1, ea0, ea1, tsl);
            int hs;
            { int sa = __builtin_amdgcn_sdot8((int)ha.x, 0x11111111, 0, false); sa = __builtin_amdgcn_sdot8((int)ha.y, 0x11111111, sa, false); sa = __builtin_amdgcn_sdot8((int)ha.z, 0x11111111, sa, false); sa = __builtin_amdgcn_sdot8((int)ha.w, 0x11111111, sa, false);
              int sb = __builtin_amdgcn_sdot8((int)hb.x, 0x11111111, 0, false); sb = __builtin_amdgcn_sdot8((int)hb.y, 0x11111111, sb, false); sb = __builtin_amdgcn_sdot8((int)hb.z, 0x11111111, sb, false); sb = __builtin_amdgcn_sdot8((int)hb.w, 0x11111111, sb, false);
              hs = (sa << 4) + sb; }
            unsigned a[16];
#define G1_ROW(R_) ({ int _a = __builtin_amdgcn_sdot8((int)(R_).x, (int)ha.x, 0, false), _b = __builtin_amdgcn_sdot8((int)(R_).x, (int)hb.x, 0, false); \
            _a = __builtin_amdgcn_sdot8((int)(R_).y, (int)ha.y, _a, false); _b = __builtin_amdgcn_sdot8((int)(R_).y, (int)hb.y, _b, false); \
            _a = __builtin_amdgcn_sdot8((int)(R_).z, (int)ha.z, _a, false); _b = __builtin_amdgcn_sdot8((int)(R_).z, (int)hb.z, _b, false); \
            _a = __builtin_amdgcn_sdot8((int)(R_).w, (int)ha.w, _a, false); _b = __builtin_amdgcn_sdot8((int)(R_).w, (int)hb.w, _b, false); \
            (unsigned)((((_a << 4) + _b) << 1) + hs); })
#pragma unroll
            for (int i = 0; i < 8; ++i) a[i] = G1_ROW(R0[i]);
            G_LOAD_R8L(R0, eb0, eb1, tsl);
#pragma unroll
            for (int i = 0; i < 8; ++i) a[8 + i] = G1_ROW(R1[i]);
#undef G1_ROW
            unsigned a8[8], a4[4], a2[2];
#pragma unroll
            for (int i = 0; i < 8; ++i) { const unsigned mine = b0 ? a[8 + i] : a[i], send = b0 ? a[i] : a[8 + i]; a8[i] = mine + shx_u<1>(send); }
#pragma unroll
            for (int i = 0; i < 4; ++i) { const unsigned mine = b1 ? a8[4 + i] : a8[i], send = b1 ? a8[i] : a8[4 + i]; a4[i] = mine + shx_u<2>(send); }
#pragma unroll
            for (int i = 0; i < 2; ++i) { const unsigned mine = b2 ? a4[2 + i] : a4[i], send = b2 ? a4[i] : a4[2 + i]; a2[i] = mine + shx_u<4>(send); }
            PACT[((size_t)x * NTOK + t) * 64 + (k0 >> 1)] = h2u(pkh((float)(int)a2[0] * (1.f / 32.f), (float)(int)a2[1] * (1.f / 32.f)));
            r = r1; t = tn;
        }
#undef G1_GLOAD
#undef G1_LWRITE
        LDS_WAIT(); asm volatile("" ::: "memory");
    }
}
#define G2_TR4(y0, y1, y2, y3, x0, x1, x2, x3) do { const unsigned _t0 = __builtin_amdgcn_perm(x1, x0, 0x05010400u), _t1 = __builtin_amdgcn_perm(x1, x0, 0x07030602u), \
    _t2 = __builtin_amdgcn_perm(x3, x2, 0x05010400u), _t3 = __builtin_amdgcn_perm(x3, x2, 0x07030602u); \
    y0 = __builtin_amdgcn_perm(_t2, _t0, 0x05040100u); y1 = __builtin_amdgcn_perm(_t2, _t0, 0x07060302u); y2 = __builtin_amdgcn_perm(_t3, _t1, 0x05040100u); y3 = __builtin_amdgcn_perm(_t3, _t1, 0x07060302u); } while (0)
#define G2_QUAD(Ra, Rb, Rc, Rd, W_) do { _Pragma("unroll") for (int _d = 0; _d < 4; ++_d) { unsigned _y0, _y1, _y2, _y3; G2_TR4(_y0, _y1, _y2, _y3, (Ra)[_d], (Rb)[_d], (Rc)[_d], (Rd)[_d]); \
    aT[4 * _d] = __builtin_amdgcn_sdot4((int)_y0, (int)(W_), aT[4 * _d], false); aL[4 * _d] = __builtin_amdgcn_sdot4((int)(_y0 & 0x0f0f0f0fu), (int)(W_), aL[4 * _d], false); \
    aT[4 * _d + 1] = __builtin_amdgcn_sdot4((int)_y1, (int)(W_), aT[4 * _d + 1], false); aL[4 * _d + 1] = __builtin_amdgcn_sdot4((int)(_y1 & 0x0f0f0f0fu), (int)(W_), aL[4 * _d + 1], false); \
    aT[4 * _d + 2] = __builtin_amdgcn_sdot4((int)_y2, (int)(W_), aT[4 * _d + 2], false); aL[4 * _d + 2] = __builtin_amdgcn_sdot4((int)(_y2 & 0x0f0f0f0fu), (int)(W_), aL[4 * _d + 2], false); \
    aT[4 * _d + 3] = __builtin_amdgcn_sdot4((int)_y3, (int)(W_), aT[4 * _d + 3], false); aL[4 * _d + 3] = __builtin_amdgcn_sdot4((int)(_y3 & 0x0f0f0f0fu), (int)(W_), aL[4 * _d + 3], false); } } while (0)
#define G2_D0(d, y, w) asm volatile("v_dot4_i32_i8 %0, %1, %2, 0" : "=v"(d) : "v"(y), "v"(w))
#define G2_QUAD0(Ra, Rb, Rc, Rd, W_) do { _Pragma("unroll") for (int _d = 0; _d < 4; ++_d) { unsigned _y0, _y1, _y2, _y3; G2_TR4(_y0, _y1, _y2, _y3, (Ra)[_d], (Rb)[_d], (Rc)[_d], (Rd)[_d]); \
    const unsigned _m0 = _y0 & 0x0f0f0f0fu, _m1 = _y1 & 0x0f0f0f0fu, _m2 = _y2 & 0x0f0f0f0fu, _m3 = _y3 & 0x0f0f0f0fu; \
    G2_D0(aT[4 * _d], _y0, W_); G2_D0(aL[4 * _d], _m0, W_); G2_D0(aT[4 * _d + 1], _y1, W_); G2_D0(aL[4 * _d + 1], _m1, W_); \
    G2_D0(aT[4 * _d + 2], _y2, W_); G2_D0(aL[4 * _d + 2], _m2, W_); G2_D0(aT[4 * _d + 3], _y3, W_); G2_D0(aL[4 * _d + 3], _m3, W_); } } while (0)
__device__ __forceinline__ void op_gather_v(Frame& F, KArgs A, int layer, int nrows, bool dry) {
    const unsigned char* TV = ws_ + WS_TV + (size_t)layer * NEXP * 512;
    const int* IDX = (const int*)(ws_ + WS_IDX); const f32x4* SG = (const f32x4*)(ws_ + WS_SG); const unsigned* PACT = (const unsigned*)(ws_ + WS_Z);
    unsigned* X = (unsigned*)(ws_ + WS_X); unsigned* Xw = dry ? (unsigned*)(ws_ + WS_Z + 80 * MiB) : X;
    const float* modl = (const float*)(ws_ + WS_MOD) + (size_t)layer * 9 * MODW;
    LAS unsigned* wl = (LAS unsigned*)(F.lds + F.wave * 4096);
    LAS unsigned* lE = (LAS unsigned*)(F.lds + F.wave * 4096 + 1024);
    int x0, nsl, w0, NW_; slice_map4(F, A, x0, nsl, w0, NW_);
    const unsigned pp0 = (unsigned)F.lane & 7u, gg0 = (unsigned)F.lane >> 3, ll0 = (unsigned)F.lane;
    const bool b3 = F.lane & 8, b4 = F.lane & 16, b5 = F.lane & 32;
    for (int xs = 0; xs < nsl; ++xs) {
        const int x = x0 + xs;
        const unsigned char* tsl = TV + (size_t)x * (NEXP * 128);
        int t = w0;
        if (t >= nrows) continue;
        const int tlast = t + ((nrows - 1 - t) / NW_) * NW_;
        v4u R0[8], R1[8]; v2u eraw;
        unsigned pp = pp0, gg = gg0, ll = ll0; asm volatile("" : "+v"(pp), "+v"(gg), "+v"(ll));
        unsigned pw[4]; f32x4 psg;
        float swc, swn;
#define G2_LOAD_W(tt) do { const int _t = (tt) < tlast ? (tt) : tlast; const unsigned* _pa = PACT + (size_t)_t * 64; \
        _Pragma("unroll") for (int xx = 0; xx < 4; ++xx) pw[xx] = _pa[(size_t)xx * NTOK * 64 + ll]; \
        psg = SG[(size_t)_t * 64 + ll]; } while (0)
#define G2_MAKE_W(buf, sw_) do { float s0 = 0.f, s1 = 0.f; _Pragma("unroll") for (int xx = 0; xx < 4; ++xx) { const h2_t _h = u2h(pw[xx]); s0 += (float)_h.x; s1 += (float)_h.y; } \
        const float _w0 = pg8::gelu1(s0 * psg.x) * psg.y, _w1 = pg8::gelu1(s1 * psg.z) * psg.w; \
        const float _m = wave_max(fmaxf(fabsf(_w0), fabsf(_w1))), _inv = _m > 0.f ? 127.f / _m : 0.f; \
        const int _q0 = (int)__builtin_rintf(_w0 * _inv), _q1 = (int)__builtin_rintf(_w1 * _inv); \
        *((LAS unsigned short*)(wl + (buf) * 32) + ll) = (unsigned short)(((unsigned)_q0 & 255u) | (((unsigned)_q1 & 255u) << 8)); sw_ = _m * (1.f / 127.f); } while (0)
#define G2_GLOAD(tt) do { const int _t = (tt) < tlast ? (tt) : tlast; eraw = *(const v2u*)(IDX + (size_t)_t * 128 + 2u * ll); } while (0)
#define G2_LWRITE(r_) do { *(LAS v2u*)(lE + (r_) * 128 + 2u * ll) = eraw; } while (0)
        G2_GLOAD(t); G2_LWRITE(0); G2_GLOAD(t + NW_); G2_LWRITE(1); G2_GLOAD(t + 2 * NW_);
        G2_LOAD_W(t);
        { const v4u e0 = *(const LAS v4u*)(lE + 16u * gg), e1 = *(const LAS v4u*)(lE + 16u * gg + 4u); G_LOAD_R8L(R0, e0, e1, tsl); }
        G2_MAKE_W(0, swc);
        int buf = 0, r = 0;
        while (t < nrows) {
            const int tn = t + NW_; const int mr = t < NLAT ? (t >> 11) : 8;
            pp = pp0; gg = gg0; ll = ll0; asm volatile("" : "+v"(pp), "+v"(gg), "+v"(ll));
            const unsigned colb = (unsigned)x * 256u + 32u * pp + ((gg & 1u) << 4) + ((gg & 2u) << 2) + (gg & 4u);
            const int r1 = G_RING(r, 1), r2 = G_RING(r, 2);
            G2_LWRITE(r2);
            G2_GLOAD(t + 3 * NW_);
            const v4u ea0 = *(const LAS v4u*)(lE + r * 128 + 16u * gg + 8u), ea1 = *(const LAS v4u*)(lE + r * 128 + 16u * gg + 12u);
            const v4u eb0 = *(const LAS v4u*)(lE + r1 * 128 + 16u * gg), eb1 = *(const LAS v4u*)(lE + r1 * 128 + 16u * gg + 4u);
            G_LOAD_R8L(R1, ea0, ea1, tsl);
            G2_LOAD_W(tn);
            const f32x4 gt2 = *(const f32x4*)(modl + mr * MODW + 5 * DM + colb);
            const v2u xo = *(const v2u*)(X + (((size_t)t * DM + colb) >> 1));
            LDS_WAIT(); asm volatile("" ::: "memory");
            const v4u wq = *(const LAS v4u*)(wl + buf * 32 + 4u * gg);
            int aT[16], aL[16];
            G2_QUAD0(R0[0], R0[1], R0[2], R0[3], wq.x); G2_QUAD(R0[4], R0[5], R0[6], R0[7], wq.y);
            G_LOAD_R8L(R0, eb0, eb1, tsl);
            G2_QUAD(R1[0], R1[1], R1[2], R1[3], wq.z); G2_QUAD(R1[4], R1[5], R1[6], R1[7], wq.w);
            int sw = __builtin_amdgcn_sdot4((int)wq.x, 0x01010101, 0, false); sw = __builtin_amdgcn_sdot4((int)wq.y, 0x01010101, sw, false);
            sw = __builtin_amdgcn_sdot4((int)wq.z, 0x01010101, sw, false); sw = __builtin_amdgcn_sdot4((int)wq.w, 0x01010101, sw, false);
            sw += (int)shx_u<8>((unsigned)sw); sw += (int)shx_u<16>((unsigned)sw); sw += (int)shx32_u((unsigned)sw, b5);
            unsigned T8[8], T4[4], T2[2], L8[8], L4[4], L2[2];
#pragma unroll
            for (int i = 0; i < 8; ++i) { const unsigned mt = (unsigned)(b3 ? aT[8 + i] : aT[i]), st = (unsigned)(b3 ? aT[i] : aT[8 + i]); T8[i] = mt + shx_u<8>(st);
                                          const unsigned ml = (unsigned)(b3 ? aL[8 + i] : aL[i]), sl = (unsigned)(b3 ? aL[i] : aL[8 + i]); L8[i] = ml + shx_u<8>(sl); }
#pragma unroll
            for (int i = 0; i < 4; ++i) { const unsigned mt = b4 ? T8[4 + i] : T8[i], st = b4 ? T8[i] : T8[4 + i]; T4[i] = mt + shx_u<16>(st);
                                          const unsigned ml = b4 ? L8[4 + i] : L8[i], sl = b4 ? L8[i] : L8[4 + i]; L4[i] = ml + shx_u<16>(sl); }
#pragma unroll
            for (int i = 0; i < 2; ++i) { const unsigned mt = b5 ? T4[2 + i] : T4[i], st = b5 ? T4[i] : T4[2 + i]; T2[i] = mt + shx32_u(st, b5);
                                          const unsigned ml = b5 ? L4[2 + i] : L4[i], sl = b5 ? L4[i] : L4[2 + i]; L2[i] = ml + shx32_u(sl, b5); }
            const float hsc = 0.5f * swc;
            const float o0 = (float)(2 * (int)L2[0] - 15 * sw) * hsc, o1 = (float)((((int)T2[0] - (int)L2[0]) >> 3) + sw) * hsc;
            const float o2 = (float)(2 * (int)L2[1] - 15 * sw) * hsc, o3 = (float)((((int)T2[1] - (int)L2[1]) >> 3) + sw) * hsc;
            { v2u xn; xn.x = pk2(bflo(xo.x) + gt2[0] * o0, bfhi(xo.x) + gt2[1] * o1); xn.y = pk2(bflo(xo.y) + gt2[2] * o2, bfhi(xo.y) + gt2[3] * o3);
              *(v2u*)(Xw + (((size_t)t * DM + colb) >> 1)) = xn; }
            G2_MAKE_W(1 - buf, swn);
            swc = swn;
            buf = 1 - buf; r = r1; t = tn;
        }
#undef G2_LOAD_W
#undef G2_MAKE_W
#undef G2_GLOAD
#undef G2_LWRITE
        LDS_WAIT(); asm volatile("" ::: "memory");
    }
}

constexpr int SPL = 11;
constexpr int NSTEPS = 2 + SPL * DEPTH;
#ifndef DIS
#define DIS 0
#endif
#ifndef ZB
#define ZB 0
#endif
#define EN(n) (!((DIS >> (n)) & 1))
__device__ __forceinline__ bool run_step(Frame& F, KArgs A, int step, bool dry) {
    unsigned char* ws = ws_;
    bf16* X = (bf16*)(ws + WS_X); const float* MOD = (const float*)(ws + WS_MOD);
    bf16* H = (bf16*)(ws + WS_H);
    if (step == 0) { if (EN(0)) op_prep(F, A); return true; }
    if (step == 1) { if (EN(1)) op_modulate(F, A, A->in[I_X], A->in[I_CTX], nullptr, A->in[I_N1G], MOD, 0, NTOK, false); }
    const int layer = (step - 2) / SPL, k = (step - 2) % SPL, kind = layer % 3, jj = layer / 3;
    const int nrows = (layer == DEPTH - 1) ? NLAT : NTOK, nM = nrows / 256;
    const float* modl = MOD + (size_t)layer * 9 * MODW;
    if (k == 1) { if (kind == 0) { if (EN(4)) op_spatial(F, A, jj, nrows); } else if (kind == 1) { if (EN(5)) op_pool(F, A, nrows); } else { if (EN(6)) op_qknorm(F, A, nrows); } return true; }
    if (k == 2 && kind == 0) return false;
    if (k == 2 && kind == 2) { if (EN(8)) op_attn(F, A); return true; }
    if (k == 4) { if (EN(10)) op_modulate(F, A, nullptr, nullptr, X, A->in[I_N2G] + layer * DM, modl, 3, nrows, false, true); return true; }
    if (k == 7) { if (EN(13)) op_topk(F, A, layer, nrows); return true; }
    if (k == 8) { if (EN(14)) op_gather_u(F, A, layer, nrows, dry); return true; }
    if (k == 9) { if (EN(14)) op_gather_v(F, A, layer, nrows, dry); return true; }
    if (k == 10) {
        if (layer == DEPTH - 1) op_modulate(F, A, nullptr, nullptr, X, A->in[I_FINAL_G], modl, 0, NLAT, true);
        else op_modulate(F, A, nullptr, nullptr, X, A->in[I_N1G] + (layer + 1) * DM, modl + 9 * MODW, 0, (layer == DEPTH - 2) ? NLAT : NTOK, false);
        return true; }
    if (k == 6) return false;
    const int nrep = (k == 0 && kind == 0) ? 2 : 1;
    for (int rep = 0; rep < nrep; ++rep) {
        pg8::Gemm g; pg8::EpiAny E;
        g.A = H; g.lda = DM; g.K = DM; g.nM = nM; g.nN = 4; g.a_pm = 256 * DM; g.a_pn = 0; g.Bt = H; g.ldb = DM; g.b_pm = 0; g.b_pn = 256 * DM;
        E.type = 0; E.perm = true; E.O = (void*)(ws + WS_Z); E.ldc = DM; E.act = 0; E.mul = nullptr; E.o_pm = 0; E.o_pn = 256;
        E.srcLat = nullptr; E.srcCtx = nullptr; E.X = (void*)X; E.Xsrc = (const void*)X; E.modl = modl; E.nlat = NLAT; E.chunk = 2; E.SS = (float*)(ws + WS_SS); if (dry) E.X = (void*)(ws + WS_Z); E.gs = ((ZB >> kind) & 1) ? 0.f : 1.f;
        if (k < 0) {
            g.A = (const bf16*)(ws + WS_KB); g.lda = 256; g.K = 256; g.nM = DEPTH * 8; g.nN = 4; g.a_pm = 65536; g.a_pn = 0;
            g.Bt = (const bf16*)(ws + WS_G); g.ldb = 256; g.b_pm = 1024 * 256; g.b_pn = 65536;
            E.O = (void*)(ws + WS_WPQ); E.ldc = DM;
        } else if (k == 0) {
            if (kind == 0 && rep == 0) { g.Bt = (const bf16*)(ws + WS_WSGUIN) + (size_t)jj * 4096 * 1024; g.nN = 8; E.ldc = SGUW; E.act = 1; }
            else if (kind == 0) {
                g.A = (const bf16*)(ws + WS_WSGUIN) + (size_t)jj * 4096 * 1024 + (size_t)2048 * 1024; g.nM = 8; g.nN = nM; g.Bt = H;
                E.type = 3; E.O = (void*)((bf16*)(ws + WS_Z) + (size_t)NTOK * SGUW); E.ldc = NTOK; }
            else if (kind == 1) { g.Bt = (const bf16*)(ws + WS_WPOOLIN); g.nN = 4; E.ldc = DM; }
            else { g.Bt = (const bf16*)(ws + WS_WQKV); g.nN = 6; E.ldc = 1536; }
        } else if (k == 2) {
            g.A = (const bf16*)(ws + WS_G); g.K = 256; g.a_pn = 256; g.Bt = (const bf16*)(ws + WS_WGRP); g.ldb = 256; g.b_pn = 65536;
            E.O = (void*)H; E.ldc = DM; E.mul = A->in[I_POOL_SCALE];
        } else if (k == 3) {
            if (kind == 0) { g.A = (const bf16*)(ws + WS_G); g.lda = SGUW; g.K = SGUW; g.Bt = (const bf16*)(ws + WS_WSGUOUT) + (size_t)jj * 1024 * 2048; }
            else if (kind == 1) { g.Bt = (const bf16*)(ws + WS_WPOOLOUT); }
            else { g.Bt = (const bf16*)(ws + WS_WO); }
            g.ldb = g.K; g.a_pm = 256 * (long)g.lda; g.b_pn = 256 * (long)g.ldb;
            E.type = 2; E.perm = true; E.srcLat = layer == 0 ? A->in[I_X] : nullptr; E.srcCtx = layer == 0 ? A->in[I_CTX] : nullptr;
        } else {
            g.nN = 8; g.Bt = (const bf16*)(ws + WS_WPQ) + (size_t)layer * 2048 * 1024; E.act = 2; E.O = (void*)(ws + WS_Z); E.ldc = 2048;
        }
        E.o_pm = 256 * (long)E.ldc;
        pg8::StaticOrder S; S.init(g.nM, g.nN, F.G, F.bx);
        if (EN(2)) pg8::gemm_phase<true>(F.lds, g, S, E, F.tid);
    }
    return true;
}

__global__ void __launch_bounds__(NWAVES * 64, 2) mega_fwd(Args args) {
    extern __shared__ __attribute__((aligned(16))) unsigned char lds[];
    for (int u = threadIdx.x; u < (LDS_BYTES - LDSCTL_OFF) / 4; u += NWAVES * 64) ((LAS unsigned*)((LAS unsigned char*)lds + LDSCTL_OFF))[u] = 0u;
    __syncthreads();
    { const unsigned hw = (unsigned)__builtin_amdgcn_s_getreg((5 << 11) | 4) & 63u;
      if ((threadIdx.x & 63) == 0) ((LAS unsigned*)((LAS unsigned char*)lds + WSLOT_OFF))[hw] = threadIdx.x >> 6; }
    const int lo = args.lo, hi = args.hi;
    if (hi - lo > 1 && threadIdx.x == 0) {
        const unsigned xcc = xb_xcc_id(); const unsigned rk = xb_add((unsigned*)(args.ws + WS_CTL) + CW_BAR + XB_XCNT(xcc), 1u);
        ((LAS unsigned*)((LAS unsigned char*)lds + MISC_OFF))[12] = rk; ((LAS unsigned*)((LAS unsigned char*)lds + MISC_OFF))[13] = xcc; }
    __syncthreads();
    for (int step = lo; step < hi; ++step) {
        KArgs kp = (KArgs)__builtin_amdgcn_kernarg_segment_ptr();
        asm volatile("" : "+s"(kp));
        int g_ = gridDim.x, bx_ = blockIdx.x; unsigned lo_ = 0;
        asm volatile("" : "+s"(g_), "+s"(bx_), "+s"(lo_));
        Frame F;
        F.lds = (LAS unsigned char*)lds + lo_;
        const unsigned hw = (unsigned)__builtin_amdgcn_s_getreg((5 << 11) | 4) & 63u;
        F.wave = __builtin_amdgcn_readfirstlane(((volatile LAS unsigned*)(F.lds + WSLOT_OFF))[hw]);
        F.lane = (int)__builtin_amdgcn_mbcnt_hi(~0u, __builtin_amdgcn_mbcnt_lo(~0u, 0u)); asm volatile("" : "+v"(F.lane));
        F.tid = F.wave * 64 + F.lane;
        F.G = g_; F.bx = bx_; F.vcu = (g_ % 8 == 0) ? (bx_ % 8) * (g_ / 8) + bx_ / 8 : bx_;
        const int kcls = step < 2 ? 11 + step : (step - 2) % SPL;
        bool dry = ((REPK >> kcls) & 1) != 0 && (step < 2 || ((REPL >> ((step - 2) / SPL)) & 1));
        bool did = run_step(F, kp, step, dry);
        if (dry) {
            XcdBarrier bar; bar.bar = (unsigned*)(kp->ws + WS_CTL) + CW_BAR; bar.x = xb_xcc_id(); bar.st = (volatile LAS unsigned*)(F.lds + MISC_OFF) + 8;
            if (did) xcd_barrier(bar, F.tid);
            did = run_step(F, kp, step, false);
        }
        if (did && step + 1 < hi) {
            XcdBarrier bar; bar.bar = (unsigned*)(kp->ws + WS_CTL) + CW_BAR; bar.x = xb_xcc_id(); bar.st = (volatile LAS unsigned*)(F.lds + MISC_OFF) + 8;
            xcd_barrier(bar, F.tid);
        }
    }
}

extern "C" void kernel_launch(void* const* d_in, const int* in_sizes, int n_in, void* d_out, int out_size, void* d_ws, size_t ws_size, hipStream_t stream) {
    static int grid = 0;
    if (grid == 0) {
        if (n_in != N_IN || out_size != NLAT * DM || ws_size < WS_END) { fprintf(stderr, "kernel_launch: unexpected shapes: n_in %d out %d ws %zu (need >= %zu)\n", n_in, out_size, ws_size, (size_t)WS_END); grid = -1; return; }
        int dev = 0, cus = 0, per_cu = 0;
        if (hipGetDevice(&dev) != hipSuccess || hipDeviceGetAttribute(&cus, hipDeviceAttributeMultiprocessorCount, dev) != hipSuccess) { grid = -1; return; }
        if (hipFuncSetAttribute((const void*)mega_fwd, hipFuncAttributeMaxDynamicSharedMemorySize, LDS_BYTES) != hipSuccess) { fprintf(stderr, "kernel_launch: hipFuncSetAttribute failed\n"); grid = -1; return; }
        if (hipOccupancyMaxActiveBlocksPerMultiprocessor(&per_cu, (const void*)mega_fwd, NWAVES * 64, LDS_BYTES) != hipSuccess || per_cu < 1) { fprintf(stderr, "kernel_launch: occupancy query says %d\n", per_cu); (void)hipGetLastError(); grid = -1; return; }
        grid = cus;
    }
    if (grid < 0) return;
    (void)hipMemsetAsync((char*)d_ws + WS_CTL, 0, CTL_ZERO_BYTES, stream);
    Args a{};
    for (int i = 0; i < N_IN; ++i) a.in[i] = (const float*)d_in[i];
    a.out = (float*)d_out; a.ws = (unsigned char*)d_ws;
#if MK_MULTI
    for (int s = 0; s < NSTEPS; ++s) { a.lo = s; a.hi = s + 1; hipLaunchKernelGGL(mega_fwd, dim3(grid), dim3(NWAVES * 64), LDS_BYTES, stream, a); }
#else
    a.lo = 0; a.hi = NSTEPS;
    void* kargs[] = {&a};
    hipError_t e = hipLaunchCooperativeKernel((const void*)mega_fwd, dim3(grid), dim3(NWAVES * 64), kargs, LDS_BYTES, stream);
    if (e != hipSuccess) { fprintf(stderr, "kernel_launch: cooperative launch failed: %s\n", hipGetErrorString(e)); (void)hipGetLastError();
        hipLaunchKernelGGL(mega_fwd, dim3(grid), dim3(NWAVES * 64), LDS_BYTES, stream, a); }
#endif
}
```

```cpp
#include <hip/hip_runtime.h>
#include <hip/hip_bf16.h>
#include <cstdio>
#include <cstdint>

#ifndef MK_MULTI
#define MK_MULTI 0
#endif
#ifndef PEER_SCALE
#define PEER_SCALE 1.0f
#endif
#ifndef REPL
#define REPL 15
#endif
#ifndef PREPREP
#define PREPREP 0
#endif
#ifndef GVAR
#define GVAR 0
#endif
#ifndef EMASK
#define EMASK 0xffffffff
#endif
#ifndef REPK
#define REPK 0
#endif
#ifndef TOPK_REF
#define TOPK_REF 0
#endif
#ifndef GATHER_REF
#define GATHER_REF 0
#endif
#ifndef ZB
#define ZB 0
#endif

template <int M> __device__ __forceinline__ unsigned shx_u(unsigned v) {
    if (M == 1) return (unsigned)__builtin_amdgcn_mov_dpp((int)v, 0xB1, 0xf, 0xf, true);
    if (M == 2) return (unsigned)__builtin_amdgcn_mov_dpp((int)v, 0x4E, 0xf, 0xf, true);
    if (M == 8) return (unsigned)__builtin_amdgcn_mov_dpp((int)v, 0x128, 0xf, 0xf, true);
    return (unsigned)__builtin_amdgcn_ds_swizzle((int)v, (M << 10) | 0x1f);
}
template <int M> __device__ __forceinline__ float shx(float v) { return __uint_as_float(shx_u<M>(__float_as_uint(v))); }
__device__ __forceinline__ unsigned shx32_u(unsigned v, bool upper) {
    auto r = __builtin_amdgcn_permlane32_swap(v, v, false, false); return upper ? r[0] : r[1]; }
__device__ __forceinline__ float shx32(float v, bool upper) { return __uint_as_float(shx32_u(__float_as_uint(v), upper)); }
__device__ __forceinline__ float bperm(int srcLane, float v) { return __uint_as_float((unsigned)__builtin_amdgcn_ds_bpermute(srcLane << 2, (int)__float_as_uint(v))); }
__device__ __forceinline__ int bperm_i(int srcLane, int v) { return __builtin_amdgcn_ds_bpermute(srcLane << 2, v); }
namespace pg8 {
#define PG8_LAS __attribute__((address_space(3)))
typedef unsigned short bf16_t;
typedef short bf16x8 __attribute__((ext_vector_type(8)));
typedef float f32x4 __attribute__((ext_vector_type(4)));
typedef float f32x2 __attribute__((ext_vector_type(2)));
typedef unsigned u32x4 __attribute__((ext_vector_type(4)));
typedef unsigned u32x2 __attribute__((ext_vector_type(2)));
constexpr int BM = 256, BK = 64, HALF = 128, HTB = HALF * BK * 2, STAGE_BYTES = 8 * HTB, NXCD = 8, WGM = 8;

__host__ __device__ __forceinline__ int lds_byte(int r, int c) { const int st = (r >> 4) * 2 + (c >> 5), rr = r & 15, cc = c & 31, ob = rr * 64 + cc * 2; return st * 1024 + (ob ^ (((ob >> 9) & 1) << 5)); }
__host__ __device__ __forceinline__ void stage_rc(int b, int& R, int& C) { const int st = b / 1024, sb = b % 1024, swz = sb ^ (((sb >> 9) & 1) << 5); R = (st >> 1) * 16 + swz / 64; C = (st & 1) * 32 + (swz % 64) / 2; }
__host__ __device__ __forceinline__ int perm32(int rho) { const int n = rho >> 4, i = rho & 15; return 8 * (i >> 2) + 4 * n + (i & 3); }

struct Unit { int pm, pn; };
struct Gemm { const bf16_t* A; const bf16_t* Bt; int lda, ldb, K, nM, nN; long a_pm, a_pn, b_pm, b_pn; };

struct StaticOrder {
    int nM, nN, nwg, G, c;
    __host__ __device__ void init(int nM_, int nN_, int G_, int c_) { nM = nM_; nN = nN_; nwg = nM * nN; G = G_; c = c_; }
    __host__ __device__ bool next(int i, Unit& u) const {
        const long L = (long)i * G + c; if (L >= nwg) return false;
        int wgid = (int)L; { const int q = nwg / NXCD, r = nwg % NXCD, xcd = wgid % NXCD, off = wgid / NXCD; wgid = (xcd < r ? xcd * (q + 1) : r * (q + 1) + (xcd - r) * q) + off; }
        const int nig = WGM * nN, gid = wgid / nig, fm = gid * WGM, gsz = (nM - fm) < WGM ? (nM - fm) : WGM;
        u.pm = fm + ((wgid % nig) % gsz); u.pn = (wgid % nig) / gsz; return true;
    }
};

__device__ __forceinline__ unsigned cvt_pk_bf16(float lo, float hi) { unsigned r; asm volatile("v_cvt_pk_bf16_f32 %0, %1, %2" : "=v"(r) : "v"(lo), "v"(hi)); return r; }
__device__ __forceinline__ f32x2 gelu_pk(f32x2 v) {
    const f32x2 av = __builtin_elementwise_abs(v), d = av * 0.2316418882f + 1.0f;
    f32x2 t; t.x = __builtin_amdgcn_rcpf(d.x); t.y = __builtin_amdgcn_rcpf(d.y);
    f32x2 q = t * 0.5307027145f + (-0.7265760135f); q = q * t + 0.7107068705f; q = q * t + (-0.142248368f); q = q * t + 0.127414796f; q = q * t;
    const f32x2 s = (v * v) * (-0.72134752044f);
    f32x2 e; e.x = __builtin_amdgcn_exp2f(s.x); e.y = __builtin_amdgcn_exp2f(s.y);
    const f32x2 m = v * (q * e), r = v - m;
    f32x2 o; o.x = v.x < 0.f ? m.x : r.x; o.y = v.y < 0.f ? m.y : r.y; return o;
}
__device__ __forceinline__ float gelu1(float v) { f32x2 r = gelu_pk((f32x2){v, v}); return r.x; }
__device__ __forceinline__ f32x4 gelu4(f32x4 v) { f32x2 a = gelu_pk((f32x2){v[0], v[1]}), b = gelu_pk((f32x2){v[2], v[3]}); return (f32x4){a.x, a.y, b.x, b.y}; }

struct EpiAny {
    int type;
    bool perm;
    void* O; int ldc; int act; const float* mul; long o_pm, o_pn;
    const float* srcLat; const float* srcCtx; void* X; const void* Xsrc; const float* modl; int nlat; int chunk;
    float* SS;
    float gs;
    __device__ __forceinline__ void bf16_store(const f32x4 (&acc)[2][2][4][2], const Unit& u, int wr, int wc, int fr, int fq) const {
        bf16_t* base = (bf16_t*)O + u.pm * o_pm + u.pn * o_pn;
        const int row0 = wr * 64 + fr, col0 = wc * 32 + 8 * fq;
        f32x4 mv[2][2];
#pragma unroll
        for (int bj = 0; bj < 2; ++bj)
#pragma unroll
            for (int n = 0; n < 2; ++n) mv[bj][n] = mul ? *(const f32x4*)(mul + u.pn * BM + col0 + bj * HALF + 4 * n) : (f32x4){1.f, 1.f, 1.f, 1.f};
#pragma unroll
        for (int ai = 0; ai < 2; ++ai)
#pragma unroll
            for (int m = 0; m < 4; ++m) { bf16_t* rowp = base + (size_t)(row0 + ai * HALF + m * 16) * ldc + col0;
#pragma unroll
                for (int bj = 0; bj < 2; ++bj) { f32x4 v0 = acc[ai][bj][m][0], v1 = acc[ai][bj][m][1];
                    if (act == 1) { v0 = gelu4(v0); v1 = gelu4(v1); }
                    v0 = v0 * mv[bj][0]; v1 = v1 * mv[bj][1];
                    u32x4 w;
                    if (act == 2) {
                        w.x = __builtin_bit_cast(unsigned, __builtin_amdgcn_cvt_pkrtz(v0[0], v0[1])); w.y = __builtin_bit_cast(unsigned, __builtin_amdgcn_cvt_pkrtz(v0[2], v0[3]));
                        w.z = __builtin_bit_cast(unsigned, __builtin_amdgcn_cvt_pkrtz(v1[0], v1[1])); w.w = __builtin_bit_cast(unsigned, __builtin_amdgcn_cvt_pkrtz(v1[2], v1[3]));
                    } else { w.x = cvt_pk_bf16(v0[0], v0[1]); w.y = cvt_pk_bf16(v0[2], v0[3]); w.z = cvt_pk_bf16(v1[0], v1[1]); w.w = cvt_pk_bf16(v1[2], v1[3]); }
                    *(u32x4*)(rowp + bj * HALF) = w; } }
    }
    __device__ __forceinline__ void f32_store(const f32x4 (&acc)[2][2][4][2], const Unit& u, int wr, int wc, int fr, int fq) const {
        float* C = (float*)O;
        const int row0 = u.pm * BM + wr * 64 + fr, col0 = u.pn * BM + wc * 32 + 4 * fq;
#pragma unroll
        for (int ai = 0; ai < 2; ++ai)
#pragma unroll
            for (int m = 0; m < 4; ++m) { float* rowp = C + (size_t)(row0 + ai * HALF + m * 16) * ldc + col0;
#pragma unroll
                for (int bj = 0; bj < 2; ++bj)
#pragma unroll
                    for (int n = 0; n < 2; ++n) *(f32x4*)(rowp + bj * HALF + n * 16) = acc[ai][bj][m][n]; }
    }
    __device__ __forceinline__ void resid(const f32x4 (&acc)[2][2][4][2], const Unit& u, int wr, int wc, int fr, int fq) const {
        const int rowt = u.pm * BM; const int mr = rowt < nlat ? (rowt >> 11) : 8;
        const float* gp = modl + mr * 6144 + chunk * 1024;
        bf16_t* xp = (bf16_t*)X + (size_t)rowt * 1024;
        const int row0 = wr * 64 + fr, col0 = u.pn * BM + wc * 32 + 8 * fq;
        f32x4 gv[2][2];
#pragma unroll
        for (int bj = 0; bj < 2; ++bj)
#pragma unroll
            for (int n = 0; n < 2; ++n) gv[bj][n] = *(const f32x4*)(gp + col0 + bj * HALF + n * 4) * gs;
        if (srcLat) {
            const float* sp = rowt < nlat ? srcLat + (size_t)rowt * 1024 : srcCtx + (size_t)(rowt - nlat) * 1024;
#pragma unroll
            for (int ai = 0; ai < 2; ++ai)
#pragma unroll
                for (int m = 0; m < 4; ++m) { const size_t off = (size_t)(row0 + ai * HALF + m * 16) * 1024 + col0;
#pragma unroll
                    for (int bj = 0; bj < 2; ++bj) { const f32x4 s0 = *(const f32x4*)(sp + off + bj * HALF), s1 = *(const f32x4*)(sp + off + bj * HALF + 4);
                        const f32x4 y0 = s0 + gv[bj][0] * acc[ai][bj][m][0], y1 = s1 + gv[bj][1] * acc[ai][bj][m][1];
                        u32x4 w; w.x = cvt_pk_bf16(y0[0], y0[1]); w.y = cvt_pk_bf16(y0[2], y0[3]); w.z = cvt_pk_bf16(y1[0], y1[1]); w.w = cvt_pk_bf16(y1[2], y1[3]);
                        *(u32x4*)(xp + off + bj * HALF) = w; }
                    if (m & 1) asm volatile("" ::: "memory"); }
        } else {
            const bf16_t* sp = (const bf16_t*)Xsrc + (size_t)rowt * 1024;
#pragma unroll
            for (int ai = 0; ai < 2; ++ai)
#pragma unroll
                for (int m = 0; m < 4; ++m) { const size_t off = (size_t)(row0 + ai * HALF + m * 16) * 1024 + col0;
#pragma unroll
                    for (int bj = 0; bj < 2; ++bj) { const u32x4 sv = *(const u32x4*)(sp + off + bj * HALF);
                        const f32x4 s0 = {__uint_as_float(sv.x << 16), __uint_as_float(sv.x & 0xffff0000u), __uint_as_float(sv.y << 16), __uint_as_float(sv.y & 0xffff0000u)};
                        const f32x4 s1 = {__uint_as_float(sv.z << 16), __uint_as_float(sv.z & 0xffff0000u), __uint_as_float(sv.w << 16), __uint_as_float(sv.w & 0xffff0000u)};
                        const f32x4 y0 = s0 + gv[bj][0] * acc[ai][bj][m][0], y1 = s1 + gv[bj][1] * acc[ai][bj][m][1];
                        u32x4 w; w.x = cvt_pk_bf16(y0[0], y0[1]); w.y = cvt_pk_bf16(y0[2], y0[3]); w.z = cvt_pk_bf16(y1[0], y1[1]); w.w = cvt_pk_bf16(y1[2], y1[3]);
                        *(u32x4*)(xp + off + bj * HALF) = w; }
                    if (m & 1) asm volatile("" ::: "memory"); }
        }
    }
    __device__ __forceinline__ void swapv(const f32x4 (&acc)[2][2][4][2], const Unit& u, int wr, int wc, int fr, int fq) const {
        bf16_t* base = (bf16_t*)O + (size_t)u.pm * BM * ldc + (size_t)u.pn * BM;
        const int row0 = wr * 64 + fr, col0 = wc * 32 + 8 * fq;
        float cs[16];
#pragma unroll
        for (int i = 0; i < 16; ++i) cs[i] = 0.f;
#pragma unroll
        for (int ai = 0; ai < 2; ++ai)
#pragma unroll
            for (int m = 0; m < 4; ++m) { bf16_t* rowp = base + (size_t)(row0 + ai * HALF + m * 16) * ldc + col0;
#pragma unroll
                for (int bj = 0; bj < 2; ++bj) { const f32x4 v0 = gelu4(acc[ai][bj][m][0]), v1 = gelu4(acc[ai][bj][m][1]);
#pragma unroll
                    for (int e = 0; e < 4; ++e) { cs[bj * 8 + e] += v0[e] * v0[e]; cs[bj * 8 + 4 + e] += v1[e] * v1[e]; }
                    u32x4 w; w.x = cvt_pk_bf16(v0[0], v0[1]); w.y = cvt_pk_bf16(v0[2], v0[3]); w.z = cvt_pk_bf16(v1[0], v1[1]); w.w = cvt_pk_bf16(v1[2], v1[3]);
                    *(u32x4*)(rowp + bj * HALF) = w; } }
        const bool b3 = fr & 8, b2 = fr & 4, b1 = fr & 2, b0 = fr & 1;
        float d[8], e4[4], f2[2];
#pragma unroll
        for (int i = 0; i < 8; ++i) { const float mine = b3 ? cs[8 + i] : cs[i], send = b3 ? cs[i] : cs[8 + i]; d[i] = mine + shx<8>(send); }
#pragma unroll
        for (int i = 0; i < 4; ++i) { const float mine = b2 ? d[4 + i] : d[i], send = b2 ? d[i] : d[4 + i]; e4[i] = mine + shx<4>(send); }
#pragma unroll
        for (int i = 0; i < 2; ++i) { const float mine = b1 ? e4[2 + i] : e4[i], send = b1 ? e4[i] : e4[2 + i]; f2[i] = mine + shx<2>(send); }
        const float tot = (b0 ? f2[1] : f2[0]) + shx<1>(b0 ? f2[0] : f2[1]);
        const int ci = fr;
        const int col = u.pn * BM + (ci >> 3) * HALF + wc * 32 + 8 * fq + (ci & 7);
        SS[(size_t)(u.pm * 2 + wr) * ldc + col] = tot;
    }
    __device__ __forceinline__ void operator()(const f32x4 (&acc)[2][2][4][2], const Unit& u, int wr, int wc, int fr, int fq) const {
        if (type == 0) bf16_store(acc, u, wr, wc, fr, fq);
        else if (type == 1) f32_store(acc, u, wr, wc, fr, fq);
        else if (type == 2) resid(acc, u, wr, wc, fr, fq);
        else swapv(acc, u, wr, wc, fr, fq);
    }
};

template <bool ALIGN_EPI = true>
__device__ __forceinline__ void gemm_phase(PG8_LAS unsigned char* lds, const Gemm g, const StaticOrder& S, const EpiAny& E, const int tid) {
    const int wid = __builtin_amdgcn_readfirstlane(tid >> 6), lane = tid & 63, wr = wid >> 2, wc = wid & 3, fr = lane & 15, fq = lane >> 4;
    const int nt = g.K / BK;
    unsigned voffA[2], voffB[2];
#pragma unroll
    for (int i = 0; i < 2; ++i) { int R, C; stage_rc(tid * 16 + i * 8192, R, C); const int Rb = E.perm ? ((R & ~31) + perm32(R & 31)) : R;
        voffA[i] = (unsigned)(R * g.lda + C) * 2u; voffB[i] = (unsigned)(Rb * g.ldb + C) * 2u; }
    const size_t kstep = (size_t)(BK * 2);
    const size_t hA = (size_t)HALF * g.lda * 2, hB = (size_t)HALF * g.ldb * 2;
    const unsigned ldsw = (unsigned)wid * 1024u;
    const int aoff = lds_byte(wr * 64 + fr, fq * 8), boff = lds_byte(wc * 32 + fr, fq * 8);
#define PG8_SA(b, h) (((b) * 2 + (h)) * HTB)
#define PG8_SB(b, h) ((4 + (b) * 2 + (h)) * HTB)
#define PG8_STAGE(bufoff, gbase, voff) do { _Pragma("unroll") for (int _i = 0; _i < 2; ++_i) \
        __builtin_amdgcn_global_load_lds((const unsigned*)((const char*)(gbase) + (voff)[_i]), (PG8_LAS unsigned*)(lds + (bufoff) + ldsw + _i * 8192), 16, 0, 0); } while (0)
#define PG8_LDA(dst, b, h) do { _Pragma("unroll") for (int m = 0; m < 4; ++m) _Pragma("unroll") for (int k = 0; k < 2; ++k) dst[m][k] = *(const PG8_LAS bf16x8*)(lds + PG8_SA(b, h) + aoff + m * 2048 + k * 1024); } while (0)
#define PG8_LDB(dst, b, h) do { _Pragma("unroll") for (int n = 0; n < 2; ++n) _Pragma("unroll") for (int k = 0; k < 2; ++k) dst[n][k] = *(const PG8_LAS bf16x8*)(lds + PG8_SB(b, h) + boff + n * 2048 + k * 1024); } while (0)
#define PG8_MMA(ai, bj, At, Bt) do { __builtin_amdgcn_s_setprio(1); _Pragma("unroll") for (int m = 0; m < 4; ++m) _Pragma("unroll") for (int n = 0; n < 2; ++n) _Pragma("unroll") for (int k = 0; k < 2; ++k) \
        acc[ai][bj][m][n] = __builtin_amdgcn_mfma_f32_16x16x32_bf16(Bt[n][k], At[m][k], acc[ai][bj][m][n], 0, 0, 0); __builtin_amdgcn_s_setprio(0); } while (0)
#define PG8_WAIT_V(n) asm volatile("s_waitcnt vmcnt(" #n ")" ::: "memory")
#define PG8_WAIT_L(n) asm volatile("s_waitcnt lgkmcnt(" #n ")" ::: "memory")
#define PG8_BAR __builtin_amdgcn_s_barrier()
#define PG8_SCHED __builtin_amdgcn_sched_barrier(0)
#define PG8_PA(u) ((const char*)g.A + 2 * ((long)(u).pm * g.a_pm + (long)(u).pn * g.a_pn))
#define PG8_PB(u) ((const char*)g.Bt + 2 * ((long)(u).pm * g.b_pm + (long)(u).pn * g.b_pn))
    Unit cur, nxt; int ui = 0;
    if (!S.next(0, cur)) return;
    f32x4 acc[2][2][4][2];
#pragma unroll
    for (int a = 0; a < 2; ++a)
#pragma unroll
        for (int b = 0; b < 2; ++b)
#pragma unroll
            for (int m = 0; m < 4; ++m)
#pragma unroll
                for (int n = 0; n < 2; ++n) acc[a][b][m][n] = (f32x4){0.f, 0.f, 0.f, 0.f};
    bf16x8 At[4][2], B0[2][2], B1[2][2];
    const char* cA = PG8_PA(cur); const char* cB = PG8_PB(cur);
    PG8_STAGE(PG8_SB(0, 0), cB, voffB); PG8_STAGE(PG8_SB(0, 1), cB + hB, voffB); PG8_STAGE(PG8_SA(0, 0), cA, voffA); PG8_STAGE(PG8_SA(0, 1), cA + hA, voffA);
    if (wr == 1) PG8_BAR;
    PG8_WAIT_V(2); PG8_BAR;
    PG8_STAGE(PG8_SB(1, 0), cB + kstep, voffB); PG8_STAGE(PG8_SA(1, 0), cA + kstep, voffA); PG8_STAGE(PG8_SB(1, 1), cB + hB + kstep, voffB);
    PG8_WAIT_V(6); PG8_BAR;
    for (;;) {
        const bool has_next = S.next(ui + 1, nxt);
        const char* nA = has_next ? PG8_PA(nxt) : cA; const char* nB = has_next ? PG8_PB(nxt) : cB;
        for (int t = 0; t < nt; t += 2) {
            const bool last = (t == nt - 2);
            const char* a1 = cA + (size_t)(t + 1) * kstep;
            const char* a2 = last ? nA : cA + (size_t)(t + 2) * kstep; const char* b2 = last ? nB : cB + (size_t)(t + 2) * kstep;
            const char* a3 = a2 + kstep; const char* b3 = b2 + kstep;
            PG8_LDB(B0, 0, 0); PG8_LDB(B1, 0, 1); PG8_SCHED; PG8_LDA(At, 0, 0); PG8_STAGE(PG8_SA(1, 1), a1 + hA, voffA);
            PG8_WAIT_V(8); PG8_WAIT_L(0); PG8_BAR; PG8_MMA(0, 0, At, B0); PG8_MMA(0, 1, At, B1); PG8_BAR; PG8_SCHED;
            PG8_LDA(At, 0, 1); PG8_STAGE(PG8_SB(0, 0), b2, voffB); PG8_STAGE(PG8_SB(0, 1), b2 + hB, voffB); PG8_STAGE(PG8_SA(0, 0), a2, voffA);
            PG8_WAIT_V(8); PG8_WAIT_L(0); PG8_BAR; PG8_MMA(1, 0, At, B0); PG8_MMA(1, 1, At, B1); PG8_BAR; PG8_SCHED;
            PG8_LDB(B0, 1, 0); PG8_LDB(B1, 1, 1); PG8_SCHED; PG8_LDA(At, 1, 0); PG8_STAGE(PG8_SA(0, 1), a2 + hA, voffA);
            PG8_WAIT_V(8); PG8_WAIT_L(0); PG8_BAR; PG8_MMA(0, 0, At, B0); PG8_MMA(0, 1, At, B1); PG8_BAR; PG8_SCHED;
            PG8_LDA(At, 1, 1); PG8_STAGE(PG8_SB(1, 0), b3, voffB); PG8_STAGE(PG8_SB(1, 1), b3 + hB, voffB); PG8_STAGE(PG8_SA(1, 0), a3, voffA);
            PG8_WAIT_V(8); PG8_WAIT_L(0); PG8_BAR; PG8_MMA(1, 0, At, B0); PG8_MMA(1, 1, At, B1); PG8_BAR; PG8_SCHED;
        }
        if constexpr (ALIGN_EPI) { if (wr == 0) PG8_BAR; }
        { int el = (int)__builtin_amdgcn_mbcnt_hi(~0u, __builtin_amdgcn_mbcnt_lo(~0u, 0u)); asm volatile("" : "+v"(el));
          E(acc, cur, wr, wc, el & 15, el >> 4); }
        if (!has_next) break;
#pragma unroll
        for (int a = 0; a < 2; ++a)
#pragma unroll
            for (int b = 0; b < 2; ++b)
#pragma unroll
                for (int m = 0; m < 4; ++m)
#pragma unroll
                    for (int n = 0; n < 2; ++n) acc[a][b][m][n] = (f32x4){0.f, 0.f, 0.f, 0.f};
        cur = nxt; cA = nA; cB = nB; ++ui;
        if constexpr (ALIGN_EPI) { if (wr == 1) PG8_BAR; }
    }
    PG8_WAIT_V(0);
    if constexpr (!ALIGN_EPI) { if (wr == 0) PG8_BAR; }
    PG8_BAR;
#undef PG8_SA
#undef PG8_SB
#undef PG8_STAGE
#undef PG8_LDA
#undef PG8_LDB
#undef PG8_MMA
#undef PG8_WAIT_V
#undef PG8_WAIT_L
#undef PG8_BAR
#undef PG8_SCHED
#undef PG8_PA
#undef PG8_PB
}
}

namespace attn {
using bf16 = __hip_bfloat16;
constexpr int D = 128, NW = 8, QBLK = 32, KVBLK = 64;
constexpr float SCALE = 0.088388347648318440f;
constexpr float THR = 8.f;
constexpr int LDQ = 1024, LDK = 256, LDO = 1024;
constexpr size_t SHM_V = KVBLK * D * 2, SHM_K = KVBLK * D * 2, SHM_ATTN = 2 * SHM_V + 2 * SHM_K + NW * 64 * 4;
using bf16x8 = __attribute__((ext_vector_type(8))) short;
using s16x4  = __attribute__((ext_vector_type(4))) short;
using f32x16 = __attribute__((ext_vector_type(16))) float;
using u32x4  = __attribute__((ext_vector_type(4))) unsigned;
#define KSWZ(row, colB) ((row) * 256 + ((colB) ^ (((row) & 7) << 4)))
#define SBAR() __builtin_amdgcn_sched_barrier(0)
__device__ __forceinline__ int crow(int r, int hi) { return (r & 3) + 8 * (r >> 2) + 4 * hi; }
__device__ __forceinline__ unsigned cvtpk(float lo, float hi) { unsigned r; asm volatile("v_cvt_pk_bf16_f32 %0, %1, %2" : "=v"(r) : "v"(lo), "v"(hi)); return r; }
__device__ __forceinline__ void partialSM(f32x16& p0, f32x16& p1, float& m_reg, float& mn, float& alpha) {
  constexpr float C = SCALE * 1.4426950408889634f;
  float pmax = p0[0]; for (int r = 1; r < 16; ++r) pmax = fmaxf(pmax, p0[r]); for (int r = 0; r < 16; ++r) pmax = fmaxf(pmax, p1[r]);
  { auto rr = __builtin_amdgcn_permlane32_swap(__float_as_uint(pmax), __float_as_uint(pmax), false, false);
    pmax = fmaxf(__uint_as_float(rr[0]), __uint_as_float(rr[1])); }
  if (__builtin_expect(__all(pmax - m_reg <= THR / SCALE), 1)) { mn = m_reg; alpha = 1.f; }
  else { mn = fmaxf(m_reg, pmax); alpha = __builtin_amdgcn_exp2f((m_reg - mn) * C); m_reg = mn; }
  float mnC = -mn * C;
  for (int r = 0; r < 16; ++r) p0[r] = fmaf(p0[r], C, mnC); for (int r = 0; r < 16; ++r) p1[r] = fmaf(p1[r], C, mnC);
  for (int r = 0; r < 16; ++r) p0[r] = __builtin_amdgcn_exp2f(p0[r]);
}
__device__ __forceinline__ void finishSM(f32x16& p0, f32x16& p1, float alpha, float& l_reg, bf16x8& pa0, bf16x8& pa1, bf16x8& pa2, bf16x8& pa3) {
  for (int r = 0; r < 16; ++r) p1[r] = __builtin_amdgcn_exp2f(p1[r]);
  float ps = 0; for (int r = 0; r < 16; ++r) ps += p0[r]; for (int r = 0; r < 16; ++r) ps += p1[r];
  { auto rr = __builtin_amdgcn_permlane32_swap(__float_as_uint(ps), __float_as_uint(ps), false, false);
    ps = __uint_as_float(rr[0]) + __uint_as_float(rr[1]); }
  l_reg = l_reg * alpha + ps;
#define PK4(P, BASE, OUT) do { unsigned a0 = cvtpk(P[BASE + 0], P[BASE + 1]), a1 = cvtpk(P[BASE + 2], P[BASE + 3]);   \
    unsigned b0 = cvtpk(P[BASE + 4], P[BASE + 5]), b1 = cvtpk(P[BASE + 6], P[BASE + 7]);                              \
    auto r0 = __builtin_amdgcn_permlane32_swap(a0, b0, false, false); auto r1 = __builtin_amdgcn_permlane32_swap(a1, b1, false, false); \
    u32x4 w = {r0[0], r1[0], r0[1], r1[1]}; OUT = *reinterpret_cast<bf16x8*>(&w); } while (0)
  PK4(p0, 0, pa0); PK4(p0, 8, pa1); PK4(p1, 0, pa2); PK4(p1, 8, pa3);
#undef PK4
}
__device__ __forceinline__ void qkt(f32x16& p0, f32x16& p1, const bf16* Ks, const bf16x8* qr, int r32, int hi) {
  p0 = f32x16{}; p1 = f32x16{};
  for (int d0 = 0; d0 < 8; ++d0) { int cb = (d0 * 16 + hi * 8) * 2;
    bf16x8 b0 = *reinterpret_cast<const bf16x8*>((const char*)Ks + KSWZ(r32, cb));
    bf16x8 b1 = *reinterpret_cast<const bf16x8*>((const char*)Ks + KSWZ(32 + r32, cb));
    p0 = __builtin_amdgcn_mfma_f32_32x32x16_bf16(b0, qr[d0], p0, 0, 0, 0);
    p1 = __builtin_amdgcn_mfma_f32_32x32x16_bf16(b1, qr[d0], p1, 0, 0, 0); }
}
__device__ __forceinline__ int v_st(int k, int c) { const int kk = (k & ~0xC) | ((k & 4) << 1) | ((k & 8) >> 1); return ((kk >> 3) * 4 + (c >> 5)) * 512 + ((kk & 7) * 32 + (c & 31)) * 2; }
__device__ __forceinline__ int v_rd_base(int lane) { return ((lane & 3) << 3) | (((lane >> 2) & 3) << 6) | (((lane >> 4) & 1) << 5) | (((lane >> 5) & 1) << 8); }
constexpr int v_rd_off(int d0, int ks, int half) { return d0 * 512 + ks * 4096 + half * 2048; }
template <int OFF> __device__ __forceinline__ s16x4 tr_read(int vb) {
  s16x4 r; asm volatile("ds_read_b64_tr_b16 %0, %1 offset:%2" : "=&v"(r) : "v"(vb), "i"(OFF) : "memory"); return r;
}
template <int D0> __device__ __forceinline__ void pv_one(f32x16& od, int vb, bf16x8 pa0, bf16x8 pa1, bf16x8 pa2, bf16x8 pa3) {
  const s16x4 l0 = tr_read<v_rd_off(D0, 0, 0)>(vb), h0 = tr_read<v_rd_off(D0, 0, 1)>(vb), l1 = tr_read<v_rd_off(D0, 1, 0)>(vb), h1 = tr_read<v_rd_off(D0, 1, 1)>(vb);
  const s16x4 l2 = tr_read<v_rd_off(D0, 2, 0)>(vb), h2 = tr_read<v_rd_off(D0, 2, 1)>(vb), l3 = tr_read<v_rd_off(D0, 3, 0)>(vb), h3 = tr_read<v_rd_off(D0, 3, 1)>(vb);
  asm volatile("s_waitcnt lgkmcnt(0)" ::: "memory"); SBAR();
#define PK(L, H) (bf16x8){L[0], L[1], L[2], L[3], H[0], H[1], H[2], H[3]}
  od = __builtin_amdgcn_mfma_f32_32x32x16_bf16(pa0, PK(l0, h0), od, 0, 0, 0);
  od = __builtin_amdgcn_mfma_f32_32x32x16_bf16(pa1, PK(l1, h1), od, 0, 0, 0);
  od = __builtin_amdgcn_mfma_f32_32x32x16_bf16(pa2, PK(l2, h2), od, 0, 0, 0);
  od = __builtin_amdgcn_mfma_f32_32x32x16_bf16(pa3, PK(l3, h3), od, 0, 0, 0);
#undef PK
}
__device__ __forceinline__ void pv_d0(f32x16* o, int vb, bf16x8 pa0, bf16x8 pa1, bf16x8 pa2, bf16x8 pa3) {
  pv_one<0>(o[0], vb, pa0, pa1, pa2, pa3); pv_one<1>(o[1], vb, pa0, pa1, pa2, pa3); pv_one<2>(o[2], vb, pa0, pa1, pa2, pa3); pv_one<3>(o[3], vb, pa0, pa1, pa2, pa3);
}
__device__ __forceinline__ void attn_dense_body(const bf16* __restrict__ Qb, const bf16* __restrict__ Kh, const bf16* __restrict__ Vh,
                                                bf16* __restrict__ Ob, int seq, char* lds, const int tid) {
  const int wid = tid >> 6, lane = tid & 63, r32 = lane & 31, hi = lane >> 5;
  bf16* V_lds = (bf16*)lds; bf16* K_lds = (bf16*)(lds + 2 * SHM_V);
  float* ws = (float*)(lds + 2 * SHM_V + 2 * SHM_K) + wid * 64; float* li_l = ws; float* al_l = ws + 32;
  float m_reg = -1e30f, l_reg = 0; f32x16 o[4] = {}; bf16x8 qr[8];
  const bf16* Qw = Qb + (long)(wid * QBLK + r32) * LDQ + hi * 8;
#pragma unroll
  for (int d0 = 0; d0 < 8; ++d0) qr[d0] = *reinterpret_cast<const bf16x8*>(Qw + d0 * 16);
  const int sr = tid >> 4, sc = (tid & 15) * 8, vst0 = v_st(sr, sc), vst1 = v_st(32 + sr, sc);
  const int vb0 = (int)(uintptr_t)V_lds + v_rd_base(lane);
  struct { bf16x8 vs0, vs1, ks0, ks1; } sr_[1];
#define SLOAD(i, k0) do { sr_[i].vs0 = *reinterpret_cast<const bf16x8*>(&Vh[(long)((k0) + sr) * LDK + sc]); sr_[i].vs1 = *reinterpret_cast<const bf16x8*>(&Vh[(long)((k0) + 32 + sr) * LDK + sc]); \
    sr_[i].ks0 = *reinterpret_cast<const bf16x8*>(&Kh[(long)((k0) + sr) * LDK + sc]); sr_[i].ks1 = *reinterpret_cast<const bf16x8*>(&Kh[(long)((k0) + 32 + sr) * LDK + sc]); } while (0)
#define SWRITE(b, i) do { *(bf16x8*)((char*)V_lds + (b) * SHM_V + vst0) = sr_[i].vs0;          \
    *(bf16x8*)((char*)V_lds + (b) * SHM_V + vst1) = sr_[i].vs1; int kc = sc * 2;               \
    *(bf16x8*)((char*)K_lds + (b) * SHM_K + KSWZ(sr, kc)) = sr_[i].ks0;                       \
    *(bf16x8*)((char*)K_lds + (b) * SHM_K + KSWZ(32 + sr, kc)) = sr_[i].ks1; } while (0)
#define SWAIT() asm volatile("s_waitcnt vmcnt(0)" ::: "memory")
#define RESC(a) do { if (__any((a) < 1.f)) { if (hi == 0) al_l[r32] = (a); asm volatile("s_waitcnt lgkmcnt(0)" ::: "memory"); \
    for (int d = 0; d < 4; ++d) for (int r = 0; r < 16; ++r) o[d][r] *= al_l[crow(r, hi)]; } } while (0)
  f32x16 pA0, pA1, pB0, pB1; float mnA, mnB, alA, alB; bf16x8 pa0, pa1, pa2, pa3; const int NT = seq / KVBLK;
  constexpr int SE = 0, SO = 0;
  SLOAD(SE, 0); asm volatile("s_waitcnt vmcnt(0)" ::: "memory"); SWRITE(0, SE); __syncthreads();
  qkt(pA0, pA1, K_lds, qr, r32, hi); partialSM(pA0, pA1, m_reg, mnA, alA);
  SLOAD(SO, KVBLK);
  SWAIT(); SWRITE(1, SO); __syncthreads();
  for (int j = 1; j + 1 < NT; j += 2) {
    SBAR(); qkt(pB0, pB1, (bf16*)((char*)K_lds + SHM_K), qr, r32, hi);
    finishSM(pA0, pA1, alA, l_reg, pa0, pa1, pa2, pa3); SBAR();
    SLOAD(SO, (j + 1) * KVBLK); SBAR();
    pv_d0(o, vb0, pa0, pa1, pa2, pa3); partialSM(pB0, pB1, m_reg, mnB, alB);
    __syncthreads(); SWAIT(); SWRITE(0, SE);
    RESC(alB); __syncthreads();
    SBAR(); qkt(pA0, pA1, K_lds, qr, r32, hi);
    finishSM(pB0, pB1, alB, l_reg, pa0, pa1, pa2, pa3); SBAR();
    SLOAD(SE, (j + 2) * KVBLK); SBAR();
    pv_d0(o, vb0 + (int)SHM_V, pa0, pa1, pa2, pa3); partialSM(pA0, pA1, m_reg, mnA, alA);
    __syncthreads(); SWAIT(); SWRITE(1, SO);
    RESC(alA); __syncthreads();
  }
  SBAR(); qkt(pB0, pB1, (bf16*)((char*)K_lds + SHM_K), qr, r32, hi);
  finishSM(pA0, pA1, alA, l_reg, pa0, pa1, pa2, pa3); SBAR();
  pv_d0(o, vb0, pa0, pa1, pa2, pa3); partialSM(pB0, pB1, m_reg, mnB, alB);
  __syncthreads(); RESC(alB);
  finishSM(pB0, pB1, alB, l_reg, pa0, pa1, pa2, pa3); SBAR();
  pv_d0(o, vb0 + (int)SHM_V, pa0, pa1, pa2, pa3);
  if (hi == 0) li_l[r32] = l_reg; asm volatile("s_waitcnt lgkmcnt(0)" ::: "memory");
  float rli[16];
#pragma unroll
  for (int r = 0; r < 16; ++r) rli[r] = __builtin_amdgcn_rcpf(li_l[crow(r, hi)]);
  unsigned short* Ow = (unsigned short*)Ob + (long)(wid * QBLK) * LDO;
#pragma unroll
  for (int r = 0; r < 16; ++r) { int orow = crow(r, hi);
    for (int d0 = 0; d0 < 4; ++d0) { const unsigned pk = cvtpk(o[d0][r] * rli[r], 0.f); Ow[(long)orow * LDO + d0 * 32 + r32] = (unsigned short)(pk & 0xffffu); } }
  __syncthreads();
#undef SLOAD
#undef SWRITE
#undef SWAIT
#undef RESC
}
#undef KSWZ
#undef SBAR
}

constexpr int NWAVES = 8;
constexpr int DM = 1024, NB = 8, SEQ = 2048, CTXL = 256, NLAT = NB * SEQ, NCTX = NB * CTXL, NTOK = NLAT + NCTX;
constexpr int DEPTH = 4, MODW = 6 * DM;
constexpr float EPS = 1e-6f;
constexpr int SGUW = 2048, NEXP = 16384, KVROWS = SEQ + CTXL;

constexpr size_t MiB = 1u << 20;
constexpr size_t WS_CTL = 0, CTL_ZERO_BYTES = 1 * MiB;
constexpr size_t WS_MOD = 1 * MiB;
constexpr size_t WS_SS = 2 * MiB;
constexpr size_t WS_X = 4 * MiB;
constexpr size_t WS_H = 76 * MiB;
constexpr size_t WS_Z = 112 * MiB;
constexpr size_t WS_G = 256 * MiB;
constexpr size_t WS_SG = 328 * MiB;
constexpr size_t WS_WSGUIN = 346 * MiB;
constexpr size_t WS_WSGUOUT = 362 * MiB;
constexpr size_t WS_WPOOLIN = 370 * MiB, WS_WPOOLOUT = 372 * MiB, WS_WGRP = 374 * MiB, WS_WQKV = 375 * MiB, WS_WO = 378 * MiB;
constexpr size_t WS_WPQ = 380 * MiB;
constexpr size_t WS_KB = 396 * MiB;
constexpr size_t WS_TU = 400 * MiB;
constexpr size_t WS_TV = 464 * MiB;
constexpr size_t WS_SU = 528 * MiB, WS_SV = 529 * MiB;
constexpr size_t WS_IDX = 530 * MiB;
constexpr size_t WS_SHQ = 539 * MiB;
constexpr size_t WS_H8 = 540 * MiB;
constexpr size_t WS_END = 558 * MiB;
constexpr int CW_BAR = 4096;

constexpr int RING_BYTES = 131072;
constexpr int LDSCTL_OFF = RING_BYTES, MISC_OFF = LDSCTL_OFF + 320, WSLOT_OFF = LDSCTL_OFF + 1024;
constexpr int LDS_BYTES = 147456;

#define GAS __attribute__((address_space(1)))
#define LAS __attribute__((address_space(3)))
typedef unsigned short bf16;
typedef unsigned v4u __attribute__((ext_vector_type(4)));
typedef unsigned v2u __attribute__((ext_vector_type(2)));
typedef float f32x4 __attribute__((ext_vector_type(4)));
typedef short bf16x8 __attribute__((ext_vector_type(8)));
typedef __bf16 bf2 __attribute__((ext_vector_type(2)));
#define LDS_WAIT() asm volatile("s_waitcnt lgkmcnt(0)" ::: "memory")
__device__ __forceinline__ unsigned f2bf(float f) { unsigned u = __builtin_bit_cast(unsigned, f); return (u + 0x7fffu + ((u >> 16) & 1u)) >> 16; }
__device__ __forceinline__ unsigned pk2(float lo, float hi) { return pg8::cvt_pk_bf16(lo, hi); }
__device__ __forceinline__ float dot2bf(unsigned a, unsigned b, float c) { asm("v_dot2c_f32_bf16 %0, %1, %2" : "+v"(c) : "v"(a), "v"(b)); return c; }
typedef _Float16 h2_t __attribute__((ext_vector_type(2)));
__device__ __forceinline__ unsigned h2u(h2_t v) { return __builtin_bit_cast(unsigned, v); }
__device__ __forceinline__ h2_t u2h(unsigned v) { return __builtin_bit_cast(h2_t, v); }
__device__ __forceinline__ float bflo(unsigned u) { return __uint_as_float(u << 16); }
__device__ __forceinline__ float bfhi(unsigned u) { return __uint_as_float(u & 0xffff0000u); }

#define XB_TMO      128
#define XB_XCNT(j)  (256  + 64 * (j))
#define XB_XSUB(j)  (1280 + 64 * (j))
#define XB_XGEN(j)  (2304 + 64 * (j))
#define XB_TOP      3328
#define XB_TOPGEN   3392
#define XCD_BAR_WORDS 3456
#define XB_SPIN_CAP (1u << 22)
__device__ __forceinline__ unsigned xb_ld(unsigned* p)              { return __hip_atomic_load(p, __ATOMIC_RELAXED, __HIP_MEMORY_SCOPE_AGENT); }
__device__ __forceinline__ unsigned xb_add(unsigned* p, unsigned v) { return __hip_atomic_fetch_add(p, v, __ATOMIC_RELAXED, __HIP_MEMORY_SCOPE_AGENT); }
__device__ __forceinline__ unsigned xb_xcc_id() { return (unsigned)__builtin_amdgcn_s_getreg((3 << 11) | 20) & 0xFu; }
#define XB_SPIN(cond, bar) do { unsigned _sp = 0; while (cond) { __builtin_amdgcn_s_sleep(1); \
    if ((++_sp & 255u) == 0u) { if (xb_ld(&(bar)[XB_TMO])) break; if (_sp > XB_SPIN_CAP) { atomicAdd(&(bar)[XB_TMO], 1u); break; } } } } while (0)
struct XcdBarrier { unsigned* bar; unsigned x; volatile LAS unsigned* st; };
__device__ __forceinline__ XcdBarrier xcd_barrier_post(unsigned* bar, volatile LAS unsigned* st) {
    XcdBarrier b; b.bar = bar; b.x = xb_xcc_id(); b.st = st;
    if (threadIdx.x == 0) (void)xb_add(&bar[XB_XCNT(b.x)], 1u);
    return b;
}
__device__ __forceinline__ void xcd_barrier_complete(unsigned* bar, unsigned x, unsigned& nloc, unsigned& nx) {
    const unsigned G = gridDim.x * gridDim.y * gridDim.z;
    unsigned sum, cnt, mine, sp = 0u;
    for (;;) {
        sum = 0u; cnt = 0u; mine = 0u;
#pragma unroll
        for (unsigned j = 0; j < 16; ++j) { const unsigned c = xb_ld(&bar[XB_XCNT(j)]); sum += c; cnt += (c > 0u) ? 1u : 0u; mine = (j == x) ? c : mine; }
        if (sum == G) break;
        __builtin_amdgcn_s_sleep(1);
        if ((++sp & 255u) == 0u) { if (xb_ld(&bar[XB_TMO])) break; if (sp > XB_SPIN_CAP) { atomicAdd(&bar[XB_TMO], 1u); break; } }
    }
    nloc = mine > 0u ? mine : 1u; nx = cnt > 0u ? cnt : 1u;
}
__device__ __forceinline__ void xcd_barrier(const XcdBarrier& b, const int tid) {
    asm volatile("s_waitcnt vmcnt(0)" ::: "memory");
    __syncthreads();
    if (tid == 0) {
        unsigned* bar = b.bar;
        __builtin_amdgcn_s_waitcnt(0);
        unsigned nloc = b.st[0], nx = b.st[1];
        if (nloc == 0u) { xcd_barrier_complete(bar, b.x, nloc, nx); b.st[0] = nloc; b.st[1] = nx; }
        const unsigned old = xb_add(&bar[XB_XSUB(b.x)], 1u);
        const unsigned gen = old / nloc;
        if (old + 1u == (gen + 1u) * nloc) {
            __builtin_amdgcn_fence(__ATOMIC_RELEASE, "agent");
            asm volatile("s_waitcnt vmcnt(0)" ::: "memory");
            const unsigned og = xb_add(&bar[XB_TOP], 1u);
            const unsigned tg = og / nx;
            if (og + 1u == (tg + 1u) * nx) xb_add(&bar[XB_TOPGEN], 1u);
            else XB_SPIN(xb_ld(&bar[XB_TOPGEN]) == tg, bar);
            __builtin_amdgcn_fence(__ATOMIC_ACQUIRE, "agent");
            xb_add(&bar[XB_XGEN(b.x)], 1u);
            asm volatile("s_waitcnt vmcnt(0)" ::: "memory");
        } else {
            XB_SPIN(xb_ld(&bar[XB_XGEN(b.x)]) == gen, bar);
            __builtin_amdgcn_fence(__ATOMIC_ACQUIRE, "agent");
            asm volatile("s_waitcnt vmcnt(0)" ::: "memory");
        }
    }
    __syncthreads();
}

enum { I_X = 0, I_C, I_CTX, I_CCTX, I_ADAW, I_ADAB, I_N1G, I_N2G, I_SGU_WIN, I_SGU_VG, I_SGU_WS, I_SGU_BS, I_SGU_WOUT, I_POOL_WIN, I_POOL_WGRP, I_POOL_SCALE, I_POOL_WOUT,
       I_ATT_WQKV, I_ATT_QG, I_ATT_KG, I_ATT_WO, I_PEER_WQ, I_PEER_K1, I_PEER_K2, I_PEER_U, I_PEER_V, I_FINAL_G, N_IN };
struct Args { const float* in[N_IN]; float* out; unsigned char* ws; int lo, hi; };
typedef const __attribute__((address_space(4))) Args* KArgs;
#define ws_ (A->ws)

struct Frame {
    LAS unsigned char* lds;
    int tid, lane, wave, vcu, G, bx;
};

__device__ __forceinline__ float wave_sum(float v) {
    v += shx<1>(v); v += shx<2>(v); v += shx<4>(v); v += shx<8>(v); v += shx<16>(v);
    { auto r = __builtin_amdgcn_permlane32_swap(__float_as_uint(v), __float_as_uint(v), false, false); v = __uint_as_float(r[0]) + __uint_as_float(r[1]); }
    return v;
}

__device__ __forceinline__ void p0_transpose_item(const float* W, int K, int N, bf16* WT, LAS float* scr, int item, int lane) {
    const int nblk = N / 32, kb = item / nblk, nb = item % nblk, k0 = 64 * kb, n0 = 32 * nb;
#pragma unroll 8
    for (int i = 0; i < 32; ++i) { const int kk = 2 * i + (lane >> 5); scr[kk * 33 + (lane & 31)] = W[(size_t)(k0 + kk) * N + n0 + (lane & 31)]; }
    LDS_WAIT(); asm volatile("" ::: "memory");
    const int c = lane & 7;
#pragma unroll
    for (int j = 0; j < 4; ++j) { const int n = (lane >> 3) + 8 * j; const LAS float* s = scr + (8 * c) * 33 + n;
        v4u o; o.x = pk2(s[0 * 33], s[1 * 33]); o.y = pk2(s[2 * 33], s[3 * 33]); o.z = pk2(s[4 * 33], s[5 * 33]); o.w = pk2(s[6 * 33], s[7 * 33]);
        *(v4u*)(WT + (size_t)(n0 + n) * K + k0 + 8 * c) = o; }
    LDS_WAIT(); asm volatile("" ::: "memory");
}
__device__ __forceinline__ float silu(float v) { return v / (1.f + __expf(-v)); }

__device__ __forceinline__ void op_prep(Frame& F, KArgs A) {
    unsigned char* ws = ws_;
    for (int rep_ = 0; rep_ < 1 + ((PREPREP >> 0) & 1); ++rep_) {
        LAS float* S = (LAS float*)F.lds;
        LAS float* Pp = (LAS float*)(F.lds + 40960);
        for (int e = F.tid; e < 9 * 1024; e += NWAVES * 64) { const int r = e >> 10, k = e & 1023; S[e] = silu(r < 8 ? A->in[I_C][r * 1024 + k] : A->in[I_CCTX][k]); }
        __syncthreads();
        for (int task = F.vcu; task < DEPTH * 48; task += F.G) {
            const int i = task / 48, cg = task % 48, col = cg * 128 + 2 * F.lane;
            const float* W = A->in[I_ADAW] + (size_t)i * 1024 * MODW + col;
            float acc[9][2];
#pragma unroll
            for (int r = 0; r < 9; ++r) { acc[r][0] = 0.f; acc[r][1] = 0.f; }
            const int k0 = F.wave * 128;
#pragma unroll 8
            for (int k = k0; k < k0 + 128; ++k) { const pg8::f32x2 w = __builtin_nontemporal_load((const pg8::f32x2*)(W + (size_t)k * MODW));
#pragma unroll
                for (int r = 0; r < 9; ++r) { const float sv = S[r * 1024 + k]; acc[r][0] += sv * w.x; acc[r][1] += sv * w.y; } }
#pragma unroll
            for (int r = 0; r < 9; ++r) *(LAS pg8::f32x2*)(Pp + (F.wave * 9 + r) * 128 + 2 * F.lane) = (pg8::f32x2){acc[r][0], acc[r][1]};
            __syncthreads();
            for (int e = F.tid; e < 9 * 128; e += NWAVES * 64) { const int r = e >> 7, l = e & 127; float sacc = 0.f;
#pragma unroll
                for (int w = 0; w < 8; ++w) sacc += Pp[(w * 9 + r) * 128 + l];
                const int c2 = cg * 128 + l;
                ((float*)(ws + WS_MOD))[((size_t)i * 9 + r) * MODW + c2] = sacc + A->in[I_ADAB][(size_t)i * MODW + c2]; }
            __syncthreads();
        }
    }
    __syncthreads();
    const int gw = F.vcu * NWAVES + F.wave, NGW = F.G * NWAVES;
    const long gt = (long)F.vcu * (NWAVES * 64) + F.tid, NGT = (long)F.G * NWAVES * 64;
    for (int rep_ = 0; rep_ < 1 + ((PREPREP >> 1) & 1); ++rep_) {
        LAS float* scr = (LAS float*)(F.lds + F.wave * 16384);
        constexpr int IT_SIN = (1024 / 64) * (4096 / 32), IT_SOUT = (2048 / 64) * (1024 / 32), IT_SQ = (1024 / 64) * (1024 / 32), IT_GRP = (256 / 64) * (256 / 32),
                      IT_QKV = (1024 / 64) * (1536 / 32);
        constexpr int NITEMS = 2 * IT_SIN + 2 * IT_SOUT + 2 * IT_SQ + 4 * IT_GRP + IT_QKV + IT_SQ;
        for (int it = gw; it < NITEMS; it += NGW) {
            int r = it;
            if (r < 2 * IT_SIN) { const int j = r / IT_SIN; p0_transpose_item(A->in[I_SGU_WIN] + (size_t)j * 1024 * 4096, 1024, 4096, (bf16*)(ws + WS_WSGUIN) + (size_t)j * 4096 * 1024, scr, r % IT_SIN, F.lane); continue; } r -= 2 * IT_SIN;
            if (r < 2 * IT_SOUT) { const int j = r / IT_SOUT; p0_transpose_item(A->in[I_SGU_WOUT] + (size_t)j * 2048 * 1024, 2048, 1024, (bf16*)(ws + WS_WSGUOUT) + (size_t)j * 1024 * 2048, scr, r % IT_SOUT, F.lane); continue; } r -= 2 * IT_SOUT;
            if (r < IT_SQ) { p0_transpose_item(A->in[I_POOL_WIN], 1024, 1024, (bf16*)(ws + WS_WPOOLIN), scr, r, F.lane); continue; } r -= IT_SQ;
            if (r < IT_SQ) { p0_transpose_item(A->in[I_POOL_WOUT], 1024, 1024, (bf16*)(ws + WS_WPOOLOUT), scr, r, F.lane); continue; } r -= IT_SQ;
            if (r < 4 * IT_GRP) { const int j = r / IT_GRP; p0_transpose_item(A->in[I_POOL_WGRP] + (size_t)j * 65536, 256, 256, (bf16*)(ws + WS_WGRP) + (size_t)j * 65536, scr, r % IT_GRP, F.lane); continue; } r -= 4 * IT_GRP;
            if (r < IT_QKV) { p0_transpose_item(A->in[I_ATT_WQKV], 1024, 1536, (bf16*)(ws + WS_WQKV), scr, r, F.lane); continue; } r -= IT_QKV;
            { p0_transpose_item(A->in[I_ATT_WO], 1024, 1024, (bf16*)(ws + WS_WO), scr, r, F.lane); }
        }
        for (long ch = gt; ch < (long)DEPTH * 1024 * 2048 / 8; ch += NGT) {
            const int d8 = (int)(ch & 31), h = (int)(ch >> 5) & 7, kk = (int)(ch >> 8) & 1023, i = (int)(ch >> 18);
            const float* src = A->in[I_PEER_WQ] + ((size_t)i * 1024 + kk) * 2048 + h * 256 + d8 * 8;
            const f32x4 a = *(const f32x4*)src, b = *(const f32x4*)(src + 4);
            v4u o; o.x = pk2(a[0], a[1]); o.y = pk2(a[2], a[3]); o.z = pk2(b[0], b[1]); o.w = pk2(b[2], b[3]);
            *(v4u*)((bf16*)(ws + WS_G) + (((size_t)(i * 8 + h) * 1024 + kk) * 256 + d8 * 8)) = o;
        }
    }
    for (long ch = gt; ch < (long)DEPTH * 8 * 256 * 32; ch += NGT) {
        const int d0 = (int)(ch & 31) * 8, n = (int)(ch >> 5) & 255, ih = (int)(ch >> 13);
        v4u o = {0u, 0u, 0u, 0u};
        const float* src = nullptr;
        if (n < 128 && d0 < 128) src = A->in[I_PEER_K1] + ((size_t)ih * 128 + n) * 128 + d0;
        else if (n >= 128 && d0 >= 128) src = A->in[I_PEER_K2] + ((size_t)ih * 128 + (n - 128)) * 128 + (d0 - 128);
        if (src) { const f32x4 a = *(const f32x4*)src, b = *(const f32x4*)(src + 4); o.x = pk2(a[0], a[1]); o.y = pk2(a[2], a[3]); o.z = pk2(b[0], b[1]); o.w = pk2(b[2], b[3]); }
        *(v4u*)((bf16*)(ws + WS_KB) + ch * 8) = o;
    }
    for (int rep_ = 0; rep_ < 1 + ((PREPREP >> 3) & 1); ++rep_)
    for (int row0 = gw * 4; row0 < 2 * DEPTH * NEXP; row0 += NGW * 4) {
        const bool isU = row0 < DEPTH * NEXP; const int r0 = isU ? row0 : row0 - DEPTH * NEXP;
        const float* sp = (isU ? A->in[I_PEER_U] : A->in[I_PEER_V]) + (size_t)r0 * DM;
        f32x4 v[4][4]; float am[4];
#pragma unroll
        for (int q = 0; q < 4; ++q)
#pragma unroll
            for (int j = 0; j < 4; ++j) v[q][j] = __builtin_nontemporal_load((const f32x4*)(sp + (size_t)q * DM) + F.lane + 64 * j);
#pragma unroll
        for (int q = 0; q < 4; ++q) { float m = 0.f;
#pragma unroll
            for (int j = 0; j < 4; ++j) m = fmaxf(m, fmaxf(fmaxf(fabsf(v[q][j].x), fabsf(v[q][j].y)), fmaxf(fabsf(v[q][j].z), fabsf(v[q][j].w))));
            am[q] = m; }
#pragma unroll
        for (int q = 0; q < 4; ++q) { float m = am[q]; m = fmaxf(m, shx<1>(m)); m = fmaxf(m, shx<2>(m)); m = fmaxf(m, shx<4>(m)); m = fmaxf(m, shx<8>(m)); m = fmaxf(m, shx<16>(m));
            auto r = __builtin_amdgcn_permlane32_swap(__float_as_uint(m), __float_as_uint(m), false, false); am[q] = fmaxf(__uint_as_float(r[0]), __uint_as_float(r[1])); }
        {
            const int lyr = r0 >> 14;
            unsigned char* tb4 = ws + (isU ? WS_TU : WS_TV) + (size_t)lyr * NEXP * 512;
            const unsigned bias = isU ? 0x8888u : 0x8080u;
#pragma unroll
            for (int q = 0; q < 4; ++q) { const int e = (r0 + q) & (NEXP - 1);
                float ss = 0.f;
#pragma unroll
                for (int j = 0; j < 4; ++j) ss += (v[q][j].x * v[q][j].x + v[q][j].y * v[q][j].y) + (v[q][j].z * v[q][j].z + v[q][j].w * v[q][j].w);
                ss = wave_sum(ss);
                float sc = fmaxf(0.3352f * __builtin_sqrtf(ss * (1.f / DM)), am[q] * (1.f / 16.f)); if (!(sc > 0.f)) sc = 1.f;
                const float inv = 1.f / sc;
#pragma unroll
                for (int j = 0; j < 4; ++j) { unsigned w = 0u;
#pragma unroll
                    for (int i = 0; i < 4; ++i) { const float t = __builtin_fminf(__builtin_fmaxf(v[q][j][i] * inv + 8.f, 0.f), 15.5f); w |= (unsigned)t << (4 * i); }
                    *(unsigned short*)(tb4 + (size_t)j * (NEXP * 128) + (size_t)e * 128 + 2 * F.lane) = (unsigned short)(w ^ bias); }
                if (F.lane == 0) ((float*)(ws + (isU ? WS_SU : WS_SV)))[r0 + q] = sc; }
        }
    }
}

__device__ __forceinline__ float wave_max(float v) {
    v = fmaxf(v, shx<1>(v)); v = fmaxf(v, shx<2>(v)); v = fmaxf(v, shx<4>(v)); v = fmaxf(v, shx<8>(v)); v = fmaxf(v, shx<16>(v));
    { auto r = __builtin_amdgcn_permlane32_swap(__float_as_uint(v), __float_as_uint(v), false, false); v = fmaxf(__uint_as_float(r[0]), __uint_as_float(r[1])); }
    return v;
}
__device__ __forceinline__ void op_modulate(Frame& F, KArgs A, const float* srcLat, const float* srcCtx, const bf16* srcX, const float* gain, const float* modl, int ch_shift, int nrows, bool fin, bool hq = false) {
    const int gw = F.vcu * NWAVES + F.wave, NGW = F.G * NWAVES;
    bf16* H = (bf16*)(ws_ + WS_H);
    for (int row = gw; row < nrows; row += NGW) {
        const int mr = row < NLAT ? (row >> 11) : 8;
        const float* sh = modl + mr * MODW + ch_shift * DM; const float* sc = sh + DM;
        f32x4 v[4]; float s = 0.f;
        if (srcX) { const v2u* xr = (const v2u*)(srcX + (size_t)row * DM);
#pragma unroll
            for (int j = 0; j < 4; ++j) { const v2u q = xr[F.lane + 64 * j]; v[j] = (f32x4){bflo(q.x), bfhi(q.x), bflo(q.y), bfhi(q.y)}; }
        } else { const float* xr = row < NLAT ? srcLat + (size_t)row * DM : srcCtx + (size_t)(row - NLAT) * DM;
#pragma unroll
            for (int j = 0; j < 4; ++j) v[j] = *((const f32x4*)xr + F.lane + 64 * j); }
#pragma unroll
        for (int j = 0; j < 4; ++j) s += (v[j].x * v[j].x + v[j].y * v[j].y) + (v[j].z * v[j].z + v[j].w * v[j].w);
        const float rstd = __builtin_amdgcn_rsqf(wave_sum(s) * (1.f / DM) + EPS);
        if (fin) {
            f32x4* o16 = (f32x4*)(A->out + (size_t)row * DM) + F.lane;
#pragma unroll
            for (int j = 0; j < 4; ++j) { const f32x4 g = *((const f32x4*)gain + F.lane + 64 * j); o16[64 * j] = v[j] * rstd * g; }
            continue;
        }
        v2u* o8 = (v2u*)(H + (size_t)row * DM) + F.lane;
        float m = 0.f;
#pragma unroll
        for (int j = 0; j < 4; ++j) { const f32x4 g = *((const f32x4*)gain + F.lane + 64 * j), a = *((const f32x4*)sc + F.lane + 64 * j), b = *((const f32x4*)sh + F.lane + 64 * j);
            const f32x4 y = v[j] * rstd * g * (a + 1.f) + b; v2u w; w.x = pk2(y[0], y[1]); w.y = pk2(y[2], y[3]); o8[64 * j] = w;
            if (hq) { v[j] = y; m = fmaxf(m, fmaxf(fmaxf(fabsf(y[0]), fabsf(y[1])), fmaxf(fabsf(y[2]), fabsf(y[3])))); } }
        if (hq) {
            m = wave_max(m);
            const float inv = m > 0.f ? 119.f / m : 0.f;
            unsigned short* hp = (unsigned short*)(ws_ + WS_H8) + (size_t)row * 512 + F.lane;
#pragma unroll
            for (int j = 0; j < 4; ++j) { unsigned pa = 0u, pb = 0u;
#pragma unroll
                for (int i = 0; i < 4; ++i) { int q = (int)__builtin_rintf(v[j][i] * inv); q = q > 119 ? 119 : (q < -119 ? -119 : q);
                    const int b = ((q + 8) & 15) - 8, a = (q - b) >> 4; pa |= ((unsigned)a & 15u) << (4 * i); pb |= ((unsigned)b & 15u) << (4 * i); }
                hp[j * 128] = (unsigned short)pa; hp[j * 128 + 64] = (unsigned short)pb; }
            if (F.lane == 0) ((float*)(ws_ + WS_SHQ))[row] = m * (1.f / 119.f);
        }
    }
}

__device__ __forceinline__ void op_spatial(Frame& F, KArgs A, int j, int nrows) {
    const float* Ws = A->in[I_SGU_WS] + (size_t)j * 8 * 128 * 128; const float* vgain = A->in[I_SGU_VG] + (size_t)j * SGUW; const float* bs = A->in[I_SGU_BS] + (size_t)j * 8 * 128;
    const bf16* ZU = (const bf16*)(ws_ + WS_Z); const bf16* VT = ZU + (size_t)NTOK * SGUW; bf16* GT = (bf16*)(ws_ + WS_G); const float* SS = (const float*)(ws_ + WS_SS);
    LAS unsigned char* lA = F.lds;
    LAS unsigned char* lB = F.lds + 34816;
    LAS float* lR = (LAS float*)(F.lds + 34816 + 69632);
    const int nunits = (nrows / 128) * 8;
    const int wr = F.wave >> 2, wc = F.wave & 3, fr = F.lane & 15, fq = F.lane >> 4;
    int u = F.vcu;
    if (u >= nunits) return;
    const int g = u & 7;
    if ((F.G & 7) != 0) {
    }
    const unsigned tid = (unsigned)F.tid;
    f32x4 wsr[4][2];
#pragma unroll
    for (int it = 0; it < 4; ++it) { const unsigned e = it * 512u + tid, p = e >> 4, q0 = (e & 15u) * 8u; const float* sp = Ws + ((size_t)g * 128 + p) * 128 + q0; wsr[it][0] = *(const f32x4*)sp; wsr[it][1] = *(const f32x4*)(sp + 4); }
    const unsigned erow = tid >> 5, d0 = (tid & 31u) * 8u;
    const f32x4 vg0 = *(const f32x4*)(vgain + g * 256 + d0), vg1 = *(const f32x4*)(vgain + g * 256 + d0 + 4);
    float bsr[8];
#pragma unroll
    for (int ps = 0; ps < 8; ++ps) bsr[ps] = bs[g * 128 + ps * 16 + erow];
    v4u breg[8];
#define SP_PREFETCH(uu) do { const int _c = (uu) >> 3, _g = (uu) & 7; \
        _Pragma("unroll") for (int it = 0; it < 8; ++it) { const unsigned e = it * 512u + tl, d = e >> 4, q0 = (e & 15u) * 8u; breg[it] = *(const v4u*)(VT + (size_t)(_g * 256 + d) * NTOK + _c * 128 + q0); } } while (0)
    unsigned tl = tid; asm volatile("" : "+v"(tl));
    SP_PREFETCH(u);
    for (; u < nunits; u += F.G) {
        const int c = u >> 3;
        tl = tid; asm volatile("" : "+v"(tl));
        if (tid < 128u) { float sq = 0.f;
#pragma unroll
            for (int sl = 0; sl < 16; ++sl) sq += SS[(size_t)sl * NTOK + c * 128 + tid];
            lR[tid] = __builtin_amdgcn_rsqf(sq * (1.f / SGUW) + EPS); }
        __syncthreads();
#pragma unroll
        for (int it = 0; it < 4; ++it) { const unsigned e = it * 512u + tid, p = e >> 4, q0 = (e & 15u) * 8u; const f32x4 a = wsr[it][0], bq = wsr[it][1];
            v4u o; o.x = pk2(a[0] * lR[q0], a[1] * lR[q0 + 1]); o.y = pk2(a[2] * lR[q0 + 2], a[3] * lR[q0 + 3]); o.z = pk2(bq[0] * lR[q0 + 4], bq[1] * lR[q0 + 5]); o.w = pk2(bq[2] * lR[q0 + 6], bq[3] * lR[q0 + 7]);
            *(LAS v4u*)(lA + p * 272 + q0 * 2) = o; }
#pragma unroll
        for (int it = 0; it < 8; ++it) { const unsigned e = it * 512u + tid, d = e >> 4, q0 = (e & 15u) * 8u; *(LAS v4u*)(lB + d * 272 + q0 * 2) = breg[it]; }
        __syncthreads();
        { const int un = (u + F.G < nunits) ? u + F.G : u; SP_PREFETCH(un); }
        v4u zu[8];
        const size_t rowbase = (size_t)(c * 128) * SGUW + g * 256 + d0;
#pragma unroll
        for (int ps = 0; ps < 8; ++ps) zu[ps] = *(const v4u*)(ZU + rowbase + (size_t)(ps * 16 + erow) * SGUW);
        f32x4 acc[4][4];
#pragma unroll
        for (int m = 0; m < 4; ++m)
#pragma unroll
            for (int n = 0; n < 4; ++n) acc[m][n] = (f32x4){0.f, 0.f, 0.f, 0.f};
#pragma unroll
        for (int k = 0; k < 4; ++k) {
            bf16x8 af[4], bfr[4];
#pragma unroll
            for (int m = 0; m < 4; ++m) af[m] = *(const LAS bf16x8*)(lA + (wr * 64 + m * 16 + fr) * 272 + (k * 32 + fq * 8) * 2);
#pragma unroll
            for (int n = 0; n < 4; ++n) bfr[n] = *(const LAS bf16x8*)(lB + (wc * 64 + n * 16 + fr) * 272 + (k * 32 + fq * 8) * 2);
#pragma unroll
            for (int m = 0; m < 4; ++m)
#pragma unroll
                for (int n = 0; n < 4; ++n) acc[m][n] = __builtin_amdgcn_mfma_f32_16x16x32_bf16(bfr[n], af[m], acc[m][n], 0, 0, 0);
        }
        __syncthreads();
#pragma unroll
        for (int m = 0; m < 4; ++m)
#pragma unroll
            for (int n = 0; n < 4; ++n) { v2u w; w.x = pk2(acc[m][n][0], acc[m][n][1]); w.y = pk2(acc[m][n][2], acc[m][n][3]);
                *(LAS v2u*)(lB + (wr * 64 + m * 16 + fr) * 528 + (wc * 64 + n * 16 + 4 * fq) * 2) = w; }
        __syncthreads();
#pragma unroll
        for (int ps = 0; ps < 8; ++ps) { const unsigned p = ps * 16u + erow; const v4u sv = *(const LAS v4u*)(lB + p * 528 + d0 * 2); const v4u z = zu[ps]; const float bsv = bsr[ps];
            v4u o;
            o.x = pk2(bflo(z.x) * (bflo(sv.x) * vg0[0] + bsv), bfhi(z.x) * (bfhi(sv.x) * vg0[1] + bsv)); o.y = pk2(bflo(z.y) * (bflo(sv.y) * vg0[2] + bsv), bfhi(z.y) * (bfhi(sv.y) * vg0[3] + bsv));
            o.z = pk2(bflo(z.z) * (bflo(sv.z) * vg1[0] + bsv), bfhi(z.z) * (bfhi(sv.z) * vg1[1] + bsv)); o.w = pk2(bflo(z.w) * (bflo(sv.w) * vg1[2] + bsv), bfhi(z.w) * (bfhi(sv.w) * vg1[3] + bsv));
            *(v4u*)(GT + rowbase + (size_t)p * SGUW) = o; }
    }
#undef SP_PREFETCH
}

__device__ __forceinline__ void op_pool(Frame& F, KArgs A, int nrows) {
    const bf16* ZP = (const bf16*)(ws_ + WS_Z); bf16* P = (bf16*)(ws_ + WS_G);
    const long gt = (long)F.vcu * (NWAVES * 64) + F.tid, NGT = (long)F.G * NWAVES * 64;
    constexpr int RUN = 32;
    for (long e = gt; e < (long)(nrows / RUN) * 128; e += NGT) {
        const int run = (int)(e >> 7), c0 = (int)(e & 127) * 8, g = c0 >> 8, half = 1 << g;
        const int row0 = run * RUN;
        int pos0, L; if (row0 < NLAT) { pos0 = row0 & (SEQ - 1); L = SEQ; } else { pos0 = (row0 - NLAT) & (CTXL - 1); L = CTXL; }
        const bf16* zb = ZP + (size_t)(row0 - pos0) * DM + c0;
        float s[8];
#pragma unroll
        for (int i = 0; i < 8; ++i) s[i] = 0.f;
#define POOL_ACC(sgn, vv) do { const v4u _v = (vv); s[0] += (sgn) * bflo(_v.x); s[1] += (sgn) * bfhi(_v.x); s[2] += (sgn) * bflo(_v.y); s[3] += (sgn) * bfhi(_v.y); \
        s[4] += (sgn) * bflo(_v.z); s[5] += (sgn) * bfhi(_v.z); s[6] += (sgn) * bflo(_v.w); s[7] += (sgn) * bfhi(_v.w); } while (0)
#pragma unroll
        for (int w = 0; w < 16; ++w) { const int t = pos0 - half + w; const bool in = (w < 2 * half) && t >= 0 && t < L; const int tc = min(max(t, 0), L - 1);
            const v4u v = *(const v4u*)(zb + (size_t)tc * DM); const float f = in ? 1.f : 0.f; POOL_ACC(f, v); }
#pragma unroll 8
        for (int i = 0; i < RUN; ++i) {
            const int pos = pos0 + i;
            const int lo = max(pos - half, 0), hi = min(pos + half, L);
            const v4u z = *(const v4u*)(zb + (size_t)pos * DM); const float ic = 1.f / (float)(hi - lo);
            v4u o; o.x = pk2(s[0] * ic - bflo(z.x), s[1] * ic - bfhi(z.x)); o.y = pk2(s[2] * ic - bflo(z.y), s[3] * ic - bfhi(z.y));
            o.z = pk2(s[4] * ic - bflo(z.z), s[5] * ic - bfhi(z.z)); o.w = pk2(s[6] * ic - bflo(z.w), s[7] * ic - bfhi(z.w));
            *(v4u*)(P + (size_t)(row0 + i) * DM + c0) = o;
            const int tin = pos + half, tout = pos - half;
            const v4u vin = *(const v4u*)(zb + (size_t)min(tin, L - 1) * DM), vout = *(const v4u*)(zb + (size_t)max(tout, 0) * DM);
            POOL_ACC(tin < L ? 1.f : 0.f, vin); POOL_ACC(tout >= 0 ? -1.f : 0.f, vout);
        }
#undef POOL_ACC
    }
}

__device__ __forceinline__ void op_qknorm(Frame& F, KArgs A, int nrows) {
    const bf16* R = (const bf16*)(ws_ + WS_Z);
    bf16* QB = (bf16*)(ws_ + WS_G); bf16* KBUF = QB + (size_t)NTOK * DM; bf16* VBUF = KBUF + (size_t)NB * KVROWS * 256;
    const float* qg = A->in[I_ATT_QG]; const float* kg = A->in[I_ATT_KG];
    LAS float* tab = (LAS float*)F.lds;
    for (int e = F.tid; e < 64 * 32; e += NWAVES * 64) { const int pos = e >> 5, f = e & 31; const float fr = __expf(-(float)f * (9.210340371976184f / 32.f)); float sn, cs; sincosf((float)pos * fr, &sn, &cs); tab[e * 2] = cs; tab[e * 2 + 1] = sn; }
    __syncthreads();
    const int gw = F.vcu * NWAVES + F.wave, NGW = F.G * NWAVES;
    const int hl = F.lane >> 4, j = F.lane & 15;
    for (int row = gw; row < nrows; row += NGW) {
        const bool lat = row < NLAT; int b, pos; if (lat) { b = row >> 11; pos = row & (SEQ - 1); } else { b = (row - NLAT) >> 8; pos = (row - NLAT) & (CTXL - 1); }
        const int krow = b * KVROWS + (lat ? pos : SEQ + pos);
        const bf16* rr = R + (size_t)row * 1536;
#pragma unroll
        for (int pass = 0; pass < 3; ++pass) {
            const int head = pass * 4 + hl;
            const bool act = head < 10;
            float x[8];
            { v4u v = {0u, 0u, 0u, 0u}; if (act) v = *(const v4u*)(rr + head * 128 + j * 8);
              x[0] = bflo(v.x); x[1] = bfhi(v.x); x[2] = bflo(v.y); x[3] = bfhi(v.y); x[4] = bflo(v.z); x[5] = bfhi(v.z); x[6] = bflo(v.w); x[7] = bfhi(v.w); }
            float ss = 0.f;
#pragma unroll
            for (int i = 0; i < 8; ++i) ss += x[i] * x[i];
            ss += shx<1>(ss); ss += shx<2>(ss); ss += shx<4>(ss); ss += shx<8>(ss);
            const float rstd = __builtin_amdgcn_rsqf(ss * (1.f / 128.f) + EPS);
            const float* gn = (head < 8 ? qg : kg) + j * 8;
#pragma unroll
            for (int i = 0; i < 8; ++i) x[i] = x[i] * rstd * gn[i];
            float y[8];
#pragma unroll
            for (int i = 0; i < 8; ++i) { const float other = shx<4>(x[i]);
                const int dd = j * 8 + i, f = dd & 31, axis = dd >> 6, second = (dd >> 5) & 1;
                const int p = axis ? (pos & 63) : (pos >> 6);
                const float cs = tab[(p * 32 + f) * 2], sn = tab[(p * 32 + f) * 2 + 1];
                y[i] = lat ? (second ? x[i] * cs + other * sn : x[i] * cs - other * sn) : x[i]; }
            if (act) { v4u o; o.x = pk2(y[0], y[1]); o.y = pk2(y[2], y[3]); o.z = pk2(y[4], y[5]); o.w = pk2(y[6], y[7]);
                if (head < 8) *(v4u*)(QB + (size_t)row * DM + head * 128 + j * 8) = o;
                else *(v4u*)(KBUF + (size_t)krow * 256 + (head - 8) * 128 + j * 8) = o; }
        }
        if (F.lane < 32) *(v4u*)(VBUF + (size_t)krow * 256 + F.lane * 8) = *(const v4u*)(rr + 1280 + F.lane * 8);
    }
}

__device__ __forceinline__ void op_attn(Frame& F, KArgs A) {
    const attn::bf16* QB = (const attn::bf16*)(ws_ + WS_G); const attn::bf16* KBUF = QB + (size_t)NTOK * DM; const attn::bf16* VBUF = KBUF + (size_t)NB * KVROWS * 256;
    attn::bf16* OB = (attn::bf16*)(ws_ + WS_H);
    for (int u = F.vcu; u < 576; u += F.G) {
        int b, hq, rowbase, kbase, seq;
        if (u < 512) { b = u >> 6; hq = (u >> 3) & 7; rowbase = b * SEQ + (u & 7) * 256; kbase = b * KVROWS; seq = KVROWS; }
        else { const int v = u - 512; b = v >> 3; hq = v & 7; rowbase = NLAT + b * CTXL; kbase = b * KVROWS + SEQ; seq = CTXL; }
        const size_t qo = (size_t)rowbase * DM + hq * 128, ko = (size_t)kbase * 256 + (hq >> 2) * 128;
        attn::attn_dense_body(QB + qo, KBUF + ko, VBUF + ko, OB + qo, seq, (char*)F.lds, F.tid);
    }
}

__device__ __forceinline__ unsigned fkey(float v) { const unsigned u = __float_as_uint(v); return (u & 0x80000000u) ? ~u : (u | 0x80000000u); }
__device__ __forceinline__ float keyf(unsigned k) { return __uint_as_float((k & 0x80000000u) ? (k & 0x7fffffffu) : ~k); }
#define ROR_MAX(m, n) m = max(m, (unsigned)__builtin_amdgcn_update_dpp(0, (int)(m), 0x120 + (n), 0xf, 0xf, false))
__device__ __forceinline__ unsigned row_max16(unsigned m) { ROR_MAX(m, 1); ROR_MAX(m, 2); ROR_MAX(m, 4); ROR_MAX(m, 8); return m; }
__device__ __forceinline__ float row_sum16(float v) {
    v += __uint_as_float((unsigned)__builtin_amdgcn_update_dpp(0, (int)__float_as_uint(v), 0x121, 0xf, 0xf, false));
    v += __uint_as_float((unsigned)__builtin_amdgcn_update_dpp(0, (int)__float_as_uint(v), 0x122, 0xf, 0xf, false));
    v += __uint_as_float((unsigned)__builtin_amdgcn_update_dpp(0, (int)__float_as_uint(v), 0x124, 0xf, 0xf, false));
    v += __uint_as_float((unsigned)__builtin_amdgcn_update_dpp(0, (int)__float_as_uint(v), 0x128, 0xf, 0xf, false));
    return v;
}
#define CE(a, b) do { const unsigned _x = max(a, b), _y = min(a, b); a = _x; b = _y; } while (0)
__device__ __forceinline__ void op_topk(Frame& F, KArgs A, int layer, int nrows) {
    const unsigned short* SC = (const unsigned short*)(ws_ + WS_Z);   int* IDX = (int*)(ws_ + WS_IDX); pg8::f32x2* SG = (pg8::f32x2*)(ws_ + WS_SG); const float* SHQ = (const float*)(ws_ + WS_SHQ);
    const float* SU = (const float*)(ws_ + WS_SU) + (size_t)layer * NEXP; const float* SV = (const float*)(ws_ + WS_SV) + (size_t)layer * NEXP;
    const int gw = F.vcu * NWAVES + F.wave, NGW = F.G * NWAVES;
    const int rowi = F.lane >> 4, l16 = F.lane & 15, half = rowi & 1, pr = rowi >> 1;
    constexpr int NS = 4;
    const int npairs = nrows * 8;
    LAS unsigned* lk = (LAS unsigned*)(F.lds + F.wave * 12288);
    LAS unsigned* lres = lk + NS * 64 * 10;
    LAS unsigned* lbest = lres + NS * 4 * 16;
    v4u va[NS];
    { const int pb = gw * (2 * NS);
#pragma unroll
      for (int u = 0; u < NS; ++u) { const int th = min(pb + 2 * u + pr, npairs - 1); const unsigned short* sp = SC + (size_t)th * 256 + half * 128;
          va[u] = *(const v4u*)(sp + 8 * l16); } }
    for (int pb = gw * (2 * NS); pb < npairs; pb += NGW * (2 * NS)) {
        unsigned head[NS], hoff[NS], res[NS];
#pragma unroll
        for (int u = 0; u < NS; ++u) {
            unsigned k[8];
#pragma unroll
            for (int i = 0; i < 4; ++i) { const h2_t hv = u2h(va[u][i]);
                k[2 * i] = (fkey((float)hv.x) & ~127u) | (unsigned)(8 * l16 + 2 * i); k[2 * i + 1] = (fkey((float)hv.y) & ~127u) | (unsigned)(8 * l16 + 2 * i + 1); }
            CE(k[0], k[1]); CE(k[2], k[3]); CE(k[4], k[5]); CE(k[6], k[7]);
            CE(k[0], k[2]); CE(k[1], k[3]); CE(k[4], k[6]); CE(k[5], k[7]);
            CE(k[1], k[2]); CE(k[5], k[6]); CE(k[0], k[4]); CE(k[3], k[7]);
            CE(k[1], k[5]); CE(k[2], k[6]);
            CE(k[1], k[4]); CE(k[3], k[6]);
            CE(k[2], k[4]); CE(k[3], k[5]);
            CE(k[3], k[4]);
            LAS unsigned* lp = lk + (u * 64 + F.lane) * 10;
#pragma unroll
            for (int j = 0; j < 4; ++j) *(LAS v2u*)(lp + 2 * j) = (v2u){k[2 * j], k[2 * j + 1]};
            *(LAS v2u*)(lp + 8) = (v2u){0u, 0u};
            head[u] = k[0]; hoff[u] = (unsigned)((u * 64 + F.lane) * 40); res[u] = 0u;
        }
        { const int pn = pb + NGW * (2 * NS);
#pragma unroll
          for (int u = 0; u < NS; ++u) { const int th = min(pn + 2 * u + pr, npairs - 1); const unsigned short* sp = SC + (size_t)th * 256 + half * 128;
              va[u] = *(const v4u*)(sp + 8 * l16); } }
#pragma unroll
        for (int it = 0; it < 16; ++it) {
            unsigned m[NS];
#pragma unroll
            for (int u = 0; u < NS; ++u) m[u] = head[u];
#pragma unroll
            for (int u = 0; u < NS; ++u) ROR_MAX(m[u], 1);
#pragma unroll
            for (int u = 0; u < NS; ++u) ROR_MAX(m[u], 2);
#pragma unroll
            for (int u = 0; u < NS; ++u) ROR_MAX(m[u], 4);
#pragma unroll
            for (int u = 0; u < NS; ++u) ROR_MAX(m[u], 8);
#pragma unroll
            for (int u = 0; u < NS; ++u) {
                lres[(u * 4 + rowi) * 16 + it] = m[u];
                hoff[u] += (head[u] == m[u]) ? 4u : 0u;
                head[u] = *(const LAS unsigned*)((const LAS unsigned char*)lk + hoff[u]);
            }
        }
        float val[NS]; int kid[NS];
#pragma unroll
        for (int u = 0; u < NS; ++u) { res[u] = lres[(u * 4 + rowi) * 16 + l16]; val[u] = keyf(res[u] & ~127u); kid[u] = (int)(res[u] & 127u); }
        const int rowbase = rowi * 16, src1 = half ? rowbase - 16 : rowbase, src2 = half ? rowbase : rowbase + 16;
        const int srcx = half ? rowbase - 16 : rowbase + 16;
        float v1[2], v2r[2]; int p[2]; unsigned ck[2], best[2];
#pragma unroll
        for (int g = 0; g < 2; ++g) {
            const float v1o = bperm(src1 + l16, val[2 * g + 1]); v1[g] = half ? v1o : val[2 * g];
            const float cp = bperm(srcx + l16, val[2 * g + 1]);
            v2r[g] = half ? val[2 * g] : cp;
            p[g] = 0; best[g] = 0u;
        }
#pragma unroll
        for (int g = 0; g < 2; ++g) { const float v20 = bperm(srcx, v2r[g]); ck[g] = (fkey(v1[g] + v20) & ~255u) | (unsigned)(l16 * 16); }
#pragma unroll
        for (int it = 0; it < 16; ++it) {
            unsigned mm[2] = {ck[0], ck[1]};
            ROR_MAX(mm[0], 1); ROR_MAX(mm[1], 1); ROR_MAX(mm[0], 2); ROR_MAX(mm[1], 2); ROR_MAX(mm[0], 4); ROR_MAX(mm[1], 4); ROR_MAX(mm[0], 8); ROR_MAX(mm[1], 8);
#pragma unroll
            for (int g = 0; g < 2; ++g) {
                const unsigned m = mm[g];
                lbest[(g * 4 + rowi) * 16 + it] = m;
                const bool win = (ck[g] == m);
                p[g] += win ? 1 : 0;
                const int pc = min(p[g], 15);
                const float v2p = bperm(srcx + pc, v2r[g]);
                const unsigned nk = (p[g] > 15) ? 0u : ((fkey(v1[g] + v2p) & ~255u) | (unsigned)(l16 * 16 + pc));
                ck[g] = win ? nk : ck[g];
            }
        }
#pragma unroll
        for (int g = 0; g < 2; ++g) {
            const int th = pb + 2 * (2 * g + half) + pr;
            best[g] = lbest[(g * 4 + rowi) * 16 + l16];
            const int cid = (int)(best[g] & 255u); const float bsum = keyf(best[g] & ~255u);
            const int e1a = bperm_i(src1 + (cid >> 4), kid[2 * g]), e1b = bperm_i(src1 + (cid >> 4), kid[2 * g + 1]);
            const int e2a = bperm_i(src2 + (cid & 15), kid[2 * g]), e2b = bperm_i(src2 + (cid & 15), kid[2 * g + 1]);
            const int e1 = half ? e1b : e1a, e2 = half ? e2b : e2a;
            const float mx = bperm(rowbase, bsum);
            const float ex = __expf(bsum - mx);
            const float den = row_sum16(ex);
            if (th < npairs) { const int eid = e1 * 128 + e2; IDX[(size_t)th * 16 + l16] = eid;
                SG[(size_t)th * 16 + l16] = (pg8::f32x2){SU[eid] * (SHQ[th >> 3] * 16.f), (ex / den) * SV[eid]}; }
        }
    }
}

__device__ __forceinline__ void fmac(float& d, float a, float b) { asm("v_fmac_f32 %0, %1, %2" : "+v"(d) : "v"(a), "v"(b)); }
#define FP8_LO(w) __builtin_amdgcn_cvt_pk_f32_fp8((int)(w), false)
#define FP8_HI(w) __builtin_amdgcn_cvt_pk_f32_fp8((int)(w), true)
#define DOT16(a, r) do { pg8::f32x2 _f; \
    _f = FP8_LO((r).x); a += _f.x * hf[0] + _f.y * hf[1];   _f = FP8_HI((r).x); a += _f.x * hf[2] + _f.y * hf[3]; \
    _f = FP8_LO((r).y); a += _f.x * hf[4] + _f.y * hf[5];   _f = FP8_HI((r).y); a += _f.x * hf[6] + _f.y * hf[7]; \
    _f = FP8_LO((r).z); a += _f.x * hf[8] + _f.y * hf[9];   _f = FP8_HI((r).z); a += _f.x * hf[10] + _f.y * hf[11]; \
    _f = FP8_LO((r).w); a += _f.x * hf[12] + _f.y * hf[13]; _f = FP8_HI((r).w); a += _f.x * hf[14] + _f.y * hf[15]; } while (0)
#define AXPY16(w, r) do { pg8::f32x2 _f; \
    _f = FP8_LO((r).x); fmac(fo[0], (w), _f.x); fmac(fo[1], (w), _f.y);   _f = FP8_HI((r).x); fmac(fo[2], (w), _f.x); fmac(fo[3], (w), _f.y); \
    _f = FP8_LO((r).y); fmac(fo[4], (w), _f.x); fmac(fo[5], (w), _f.y);   _f = FP8_HI((r).y); fmac(fo[6], (w), _f.x); fmac(fo[7], (w), _f.y); \
    _f = FP8_LO((r).z); fmac(fo[8], (w), _f.x); fmac(fo[9], (w), _f.y);   _f = FP8_HI((r).z); fmac(fo[10], (w), _f.x); fmac(fo[11], (w), _f.y); \
    _f = FP8_LO((r).w); fmac(fo[12], (w), _f.x); fmac(fo[13], (w), _f.y); _f = FP8_HI((r).w); fmac(fo[14], (w), _f.x); fmac(fo[15], (w), _f.y); } while (0)
#define DOT16V(a, r, H_) do { pg8::f32x2 _f; \
    _f = FP8_LO((r).x); fmac(a, _f.x, H_[0]); fmac(a, _f.y, H_[1]);   _f = FP8_HI((r).x); fmac(a, _f.x, H_[2]); fmac(a, _f.y, H_[3]); \
    _f = FP8_LO((r).y); fmac(a, _f.x, H_[4]); fmac(a, _f.y, H_[5]);   _f = FP8_HI((r).y); fmac(a, _f.x, H_[6]); fmac(a, _f.y, H_[7]); \
    _f = FP8_LO((r).z); fmac(a, _f.x, H_[8]); fmac(a, _f.y, H_[9]);   _f = FP8_HI((r).z); fmac(a, _f.x, H_[10]); fmac(a, _f.y, H_[11]); \
    _f = FP8_LO((r).w); fmac(a, _f.x, H_[12]); fmac(a, _f.y, H_[13]); _f = FP8_HI((r).w); fmac(a, _f.x, H_[14]); fmac(a, _f.y, H_[15]); } while (0)
#define CVH_LO(w) __builtin_bit_cast(h2_t, __builtin_amdgcn_cvt_scalef32_pk_f16_fp8((w), 1.0f, false))
#define CVH_HI(w) __builtin_bit_cast(h2_t, __builtin_amdgcn_cvt_scalef32_pk_f16_fp8((w), 1.0f, true))
#define DOT16H(a, r, Hh) do { \
    a = __builtin_amdgcn_fdot2(CVH_LO((r).x), Hh[0], a, false); a = __builtin_amdgcn_fdot2(CVH_HI((r).x), Hh[1], a, false); \
    a = __builtin_amdgcn_fdot2(CVH_LO((r).y), Hh[2], a, false); a = __builtin_amdgcn_fdot2(CVH_HI((r).y), Hh[3], a, false); \
    a = __builtin_amdgcn_fdot2(CVH_LO((r).z), Hh[4], a, false); a = __builtin_amdgcn_fdot2(CVH_HI((r).z), Hh[5], a, false); \
    a = __builtin_amdgcn_fdot2(CVH_LO((r).w), Hh[6], a, false); a = __builtin_amdgcn_fdot2(CVH_HI((r).w), Hh[7], a, false); } while (0)
#define AXPY16H(wh, r) do { \
    fo[0] = __builtin_elementwise_fma(CVH_LO((r).x), (wh), fo[0]); fo[1] = __builtin_elementwise_fma(CVH_HI((r).x), (wh), fo[1]); \
    fo[2] = __builtin_elementwise_fma(CVH_LO((r).y), (wh), fo[2]); fo[3] = __builtin_elementwise_fma(CVH_HI((r).y), (wh), fo[3]); \
    fo[4] = __builtin_elementwise_fma(CVH_LO((r).z), (wh), fo[4]); fo[5] = __builtin_elementwise_fma(CVH_HI((r).z), (wh), fo[5]); \
    fo[6] = __builtin_elementwise_fma(CVH_LO((r).w), (wh), fo[6]); fo[7] = __builtin_elementwise_fma(CVH_HI((r).w), (wh), fo[7]); } while (0)
__device__ __forceinline__ h2_t pkh(float a, float b) { return __builtin_bit_cast(h2_t, __builtin_amdgcn_cvt_pkrtz(a, b)); }
#define CVL(d, w) asm volatile("v_cvt_scalef32_pk_f16_fp8 %0, %1, 1.0" : "=v"(d) : "v"(w))
#define CVU(d, w) asm volatile("v_cvt_scalef32_pk_f16_fp8 %0, %1, 1.0 op_sel:[1,0,0]" : "=v"(d) : "v"(w))
#define D2H(a, x, h) asm volatile("v_dot2c_f32_f16 %0, %1, %2" : "+v"(a) : "v"(x), "v"(h))
#define PKF(f, x, w) asm volatile("v_pk_fma_f16 %0, %1, %2, %0" : "+v"(f) : "v"(x), "v"(w))
#define DOT2ROWS(accA, accB, ra, rb, hu) do { unsigned _t0, _t1, _t2, _t3, _t4, _t5, _t6, _t7, _s0, _s1, _s2, _s3, _s4, _s5, _s6, _s7; float _a2 = 0.f, _b2 = 0.f; \
    CVL(_t0, (ra).x); CVU(_t1, (ra).x); CVL(_t2, (ra).y); CVU(_t3, (ra).y); CVL(_t4, (ra).z); CVU(_t5, (ra).z); CVL(_t6, (ra).w); CVU(_t7, (ra).w); \
    CVL(_s0, (rb).x); CVU(_s1, (rb).x); CVL(_s2, (rb).y); CVU(_s3, (rb).y); CVL(_s4, (rb).z); CVU(_s5, (rb).z); CVL(_s6, (rb).w); CVU(_s7, (rb).w); \
    D2H(accA, _t0, hu[0]); D2H(accB, _s0, hu[0]); D2H(_a2, _t1, hu[1]); D2H(_b2, _s1, hu[1]); D2H(accA, _t2, hu[2]); D2H(accB, _s2, hu[2]); D2H(_a2, _t3, hu[3]); D2H(_b2, _s3, hu[3]); \
    D2H(accA, _t4, hu[4]); D2H(accB, _s4, hu[4]); D2H(_a2, _t5, hu[5]); D2H(_b2, _s5, hu[5]); D2H(accA, _t6, hu[6]); D2H(accB, _s6, hu[6]); \
      \
    asm volatile("v_dot2c_f32_f16 %2, %4, %6\n\tv_dot2c_f32_f16 %3, %5, %6\n\ts_nop 2\n\tv_add_f32 %0, %0, %2\n\tv_add_f32 %1, %1, %3" \
        : "+v"(accA), "+v"(accB), "+v"(_a2), "+v"(_b2) : "v"(_t7), "v"(_s7), "v"(hu[7])); } while (0)
#define AXPYROW(fu, wu, r) do { unsigned _t0, _t1, _t2, _t3, _t4, _t5, _t6, _t7; \
    CVL(_t0, (r).x); CVU(_t1, (r).x); CVL(_t2, (r).y); CVU(_t3, (r).y); CVL(_t4, (r).z); CVU(_t5, (r).z); CVL(_t6, (r).w); CVU(_t7, (r).w); \
    PKF(fu[0], _t0, wu); PKF(fu[1], _t1, wu); PKF(fu[2], _t2, wu); PKF(fu[3], _t3, wu); PKF(fu[4], _t4, wu); PKF(fu[5], _t5, wu); PKF(fu[6], _t6, wu); PKF(fu[7], _t7, wu); } while (0)
#define C4B0(d, w) asm volatile("v_cvt_scalef32_pk_f16_fp4 %0, %1, 1.0" : "=v"(d) : "v"(w))
#define C4B1(d, w) asm volatile("v_cvt_scalef32_pk_f16_fp4 %0, %1, 1.0 op_sel:[1,0,0]" : "=v"(d) : "v"(w))
#define C4B2(d, w) asm volatile("v_cvt_scalef32_pk_f16_fp4 %0, %1, 1.0 op_sel:[0,1,0]" : "=v"(d) : "v"(w))
#define C4B3(d, w) asm volatile("v_cvt_scalef32_pk_f16_fp4 %0, %1, 1.0 op_sel:[1,1,0]" : "=v"(d) : "v"(w))
#define C4ROW(T, r) do { C4B0(T[0], (r).x); C4B1(T[1], (r).x); C4B2(T[2], (r).x); C4B3(T[3], (r).x); C4B0(T[4], (r).y); C4B1(T[5], (r).y); C4B2(T[6], (r).y); C4B3(T[7], (r).y); \
    C4B0(T[8], (r).z); C4B1(T[9], (r).z); C4B2(T[10], (r).z); C4B3(T[11], (r).z); C4B0(T[12], (r).w); C4B1(T[13], (r).w); C4B2(T[14], (r).w); C4B3(T[15], (r).w); } while (0)
#define DOT2ROWS4(accA, accB, ra, rb, hu) do { unsigned _t[16], _s[16]; float _a2 = 0.f, _b2 = 0.f; C4ROW(_t, ra); C4ROW(_s, rb); \
    _Pragma("unroll") for (int _i = 0; _i < 14; _i += 2) { D2H(accA, _t[_i], hu[_i]); D2H(accB, _s[_i], hu[_i]); D2H(_a2, _t[_i + 1], hu[_i + 1]); D2H(_b2, _s[_i + 1], hu[_i + 1]); } \
    D2H(accA, _t[14], hu[14]); D2H(accB, _s[14], hu[14]); \
    asm volatile("v_dot2c_f32_f16 %2, %4, %6\n\tv_dot2c_f32_f16 %3, %5, %6\n\ts_nop 2\n\tv_add_f32 %0, %0, %2\n\tv_add_f32 %1, %1, %3" \
        : "+v"(accA), "+v"(accB), "+v"(_a2), "+v"(_b2) : "v"(_t[15]), "v"(_s[15]), "v"(hu[15])); } while (0)
#define AXPYROW4(fu, wu, r) do { unsigned _t[16]; C4ROW(_t, r); _Pragma("unroll") for (int _i = 0; _i < 16; ++_i) PKF(fu[_i], _t[_i], wu); } while (0)
__device__ __forceinline__ void slice_map(Frame& F, KArgs A, int& x0, int& nsl, int& w0, int& NW_) {
    if ((F.G % 8) != 0) { x0 = 0; nsl = 8; w0 = F.vcu * NWAVES + F.wave; NW_ = F.G * NWAVES; return; }
    unsigned* bar = (unsigned*)(ws_ + WS_CTL) + CW_BAR; bool even = true;
#pragma unroll
    for (int j = 0; j < 8; ++j) even = even && (xb_ld(&bar[XB_XCNT(j)]) == (unsigned)(F.G >> 3));
    const unsigned rk = ((volatile LAS unsigned*)(F.lds + MISC_OFF))[12], xcc = ((volatile LAS unsigned*)(F.lds + MISC_OFF))[13];
    const int sl = even ? (int)__builtin_amdgcn_readfirstlane(xcc) : (F.bx & 7), sub = even ? (int)__builtin_amdgcn_readfirstlane(rk) : (F.bx >> 3);
    x0 = sl; nsl = 1; w0 = sub * NWAVES + F.wave; NW_ = (F.G >> 3) * NWAVES;
}
__device__ __forceinline__ void slice_map4(Frame& F, KArgs A, int& x0, int& nsl, int& w0, int& NW_) {
    slice_map(F, A, x0, nsl, w0, NW_);
    if (nsl == 8) { nsl = 4; return; }
    const int sl = x0; x0 = sl >> 1; w0 += (sl & 1) * NW_; NW_ *= 2;
}
#define G_LOAD_E(E_, tt) do { const int* _ip = IDX + (size_t)(tt) * 128; _Pragma("unroll") for (int q = 0; q < 4; ++q) E_[q] = *(const v4u*)(_ip + 16u * gg + 4u * q); } while (0)
#define G_LOAD_R8(R_, Ea, Eb, tsl_) do { \
    R_[0] = *(const v4u*)((tsl_) + ((Ea).x * 128u + 16u * pp)); R_[1] = *(const v4u*)((tsl_) + ((Ea).y * 128u + 16u * pp)); \
    R_[2] = *(const v4u*)((tsl_) + ((Ea).z * 128u + 16u * pp)); R_[3] = *(const v4u*)((tsl_) + ((Ea).w * 128u + 16u * pp)); \
    R_[4] = *(const v4u*)((tsl_) + ((Eb).x * 128u + 16u * pp)); R_[5] = *(const v4u*)((tsl_) + ((Eb).y * 128u + 16u * pp)); \
    R_[6] = *(const v4u*)((tsl_) + ((Eb).z * 128u + 16u * pp)); R_[7] = *(const v4u*)((tsl_) + ((Eb).w * 128u + 16u * pp)); } while (0)
#define G_RING(r_, n_) ((r_) + (n_) >= 3 ? (r_) + (n_) - 3 : (r_) + (n_))
#define G_LOAD_R8L(R_, Ea, Eb, tsl_) do { \
    R_[0] = *(const v4u*)((tsl_) + ((Ea).x * 128u + 16u * pp)); R_[1] = *(const v4u*)((tsl_) + ((Ea).y * 128u + 16u * pp)); \
    R_[2] = *(const v4u*)((tsl_) + ((Ea).z * 128u + 16u * pp)); R_[3] = *(const v4u*)((tsl_) + ((Ea).w * 128u + 16u * pp)); \
    R_[4] = *(const v4u*)((tsl_) + ((Eb).x * 128u + 16u * pp)); R_[5] = *(const v4u*)((tsl_) + ((Eb).y * 128u + 16u * pp)); \
    R_[6] = *(const v4u*)((tsl_) + ((Eb).z * 128u + 16u * pp)); R_[7] = *(const v4u*)((tsl_) + ((Eb).w * 128u + 16u * pp)); } while (0)
__device__ __forceinline__ void op_gather_u(Frame& F, KArgs A, int layer, int nrows, bool dry) {
    const unsigned char* TU = ws_ + WS_TU + (size_t)layer * NEXP * 512;
    const int* IDX = (const int*)(ws_ + WS_IDX); const unsigned* HQ = (const unsigned*)(ws_ + WS_H8);
    unsigned* PACT = (unsigned*)(ws_ + (dry ? WS_G : WS_Z));
    int x0, nsl, w0, NW_; slice_map4(F, A, x0, nsl, w0, NW_);
    const unsigned pp0 = (unsigned)F.lane & 7u, gg0 = (unsigned)F.lane >> 3, ll0 = (unsigned)F.lane;
    const bool b0 = F.lane & 1, b1 = F.lane & 2, b2 = F.lane & 4;
    LAS unsigned* lE = (LAS unsigned*)(F.lds + F.wave * 4096 + 1024);
    LAS unsigned* lH = (LAS unsigned*)(F.lds + F.wave * 4096 + 2560);
    for (int xs = 0; xs < nsl; ++xs) {
        const int x = x0 + xs;
        const unsigned char* tsl = TU + (size_t)x * (NEXP * 128);
        const unsigned* Hx = HQ + x * 64;
        int t = w0;
        if (t >= nrows) continue;
        const int tlast = t + ((nrows - 1 - t) / NW_) * NW_;
        unsigned pp = pp0, gg = gg0, ll = ll0; asm volatile("" : "+v"(pp), "+v"(gg), "+v"(ll));
        v4u R0[8], R1[8]; v2u eraw; unsigned hraw;
#define G1_GLOAD(tt) do { const int _t = (tt) < tlast ? (tt) : tlast; eraw = *(const v2u*)(IDX + (size_t)_t * 128 + 2u * ll); hraw = Hx[(size_t)_t * 256 + ll]; } while (0)
#define G1_LWRITE(r_) do { *(LAS v2u*)(lE + (r_) * 128 + 2u * ll) = eraw; lH[(r_) * 64 + ll] = hraw; } while (0)
        G1_GLOAD(t); G1_LWRITE(0); G1_GLOAD(t + NW_); G1_LWRITE(1); G1_GLOAD(t + 2 * NW_);
        { const v4u e0 = *(const LAS v4u*)(lE + 16u * gg), e1 = *(const LAS v4u*)(lE + 16u * gg + 4u); G_LOAD_R8L(R0, e0, e1, tsl); }
        int r = 0;
        while (t < nrows) {
            const int tn = t + NW_;
            pp = pp0; gg = gg0; ll = ll0; asm volatile("" : "+v"(pp), "+v"(gg), "+v"(ll));
            const unsigned k0 = 16u * gg + ((pp & 1u) << 3) + ((pp & 2u) << 1) + ((pp & 4u) >> 1);
            const int r1 = G_RING(r, 1), r2 = G_RING(r, 2);
            G1_LWRITE(r2);
            G1_GLOAD(t + 3 * NW_);
            const v4u ea0 = *(const LAS v4u*)(lE + r * 128 + 16u * gg + 8u), ea1 = *(const LAS v4u*)(lE + r * 128 + 16u * gg + 12u);
            const v4u eb0 = *(const LAS v4u*)(lE + r1 * 128 + 16u * gg), eb1 = *(const LAS v4u*)(lE + r1 * 128 + 16u * gg + 4u);
            const v4u ha = *(const LAS v4u*)(lH + r * 64 + 4u * pp), hb = *(const LAS v4u*)(lH + r * 64 + 32u + 4u * pp);
            G_LOAD_R8L(R1, ea0, ea1, tsl);
            int hs;
            { int sa = __builtin_amdgcn_sdot8((int)ha.x, 0x11111111, 0, false); sa = __builtin_amdgcn_sdot8((int)ha.y, 0x11111111, sa, false); sa = __builtin_amdgcn_sdot8((int)ha.z, 0x11111111, sa, false); sa = __builtin_amdgcn_sdot8((int)ha.w, 0x11111111, sa, false);
              int sb = __builtin_amdgcn_sdot8((int)hb.x, 0x11111111, 0, false); sb = __builtin_amdgcn_sdot8((int)hb.y, 0x11111111, sb, false); sb = __builtin_amdgcn_sdot8((int)hb.z, 0x11111111, sb, false); sb = __builtin_amdgcn_sdot8((int)hb.w, 0x11111111, sb, false);
              hs = (sa << 4) + sb; }
            unsigned a[16];
#define G1_ROW(R_) ({ int _a = __builtin_amdgcn_sdot8((int)(R_).x, (int)ha.x, 0, false), _b = __builtin_amdgcn_sdot8((int)(R_).x, (int)hb.x, 0, false); \
            _a = __builtin_amdgcn_sdot8((int)(R_).y, (int)ha.y, _a, false); _b = __builtin_amdgcn_sdot8((int)(R_).y, (int)hb.y, _b, false); \
            _a = __builtin_amdgcn_sdot8((int)(R_).z, (int)ha.z, _a, false); _b = __builtin_amdgcn_sdot8((int)(R_).z, (int)hb.z, _b, false); \
            _a = __builtin_amdgcn_sdot8((int)(R_).w, (int)ha.w, _a, false); _b = __builtin_amdgcn_sdot8((int)(R_).w, (int)hb.w, _b, false); \
            (unsigned)((((_a << 4) + _b) << 1) + hs); })
#pragma unroll
            for (int i = 0; i < 8; ++i) a[i] = G1_ROW(R0[i]);
            G_LOAD_R8L(R0, eb0, eb1, tsl);
#pragma unroll
            for (int i = 0; i < 8; ++i) a[8 + i] = G1_ROW(R1[i]);
#undef G1_ROW
            unsigned a8[8], a4[4], a2[2];
#pragma unroll
            for (int i = 0; i < 8; ++i) { const unsigned mine = b0 ? a[8 + i] : a[i], send = b0 ? a[i] : a[8 + i]; a8[i] = mine + shx_u<1>(send); }
#pragma unroll
            for (int i = 0; i < 4; ++i) { const unsigned mine = b1 ? a8[4 + i] : a8[i], send = b1 ? a8[i] : a8[4 + i]; a4[i] = mine + shx_u<2>(send); }
#pragma unroll
            for (int i = 0; i < 2; ++i) { const unsigned mine = b2 ? a4[2 + i] : a4[i], send = b2 ? a4[i] : a4[2 + i]; a2[i] = mine + shx_u<4>(send); }
            PACT[((size_t)x * NTOK + t) * 64 + (k0 >> 1)] = h2u(pkh((float)(int)a2[0] * (1.f / 32.f), (float)(int)a2[1] * (1.f / 32.f)));
            r = r1; t = tn;
        }
#undef G1_GLOAD
#undef G1_LWRITE
        LDS_WAIT(); asm volatile("" ::: "memory");
    }
}
#define G2_TR4(y0, y1, y2, y3, x0, x1, x2, x3) do { const unsigned _t0 = __builtin_amdgcn_perm(x1, x0, 0x05010400u), _t1 = __builtin_amdgcn_perm(x1, x0, 0x07030602u), \
    _t2 = __builtin_amdgcn_perm(x3, x2, 0x05010400u), _t3 = __builtin_amdgcn_perm(x3, x2, 0x07030602u); \
    y0 = __builtin_amdgcn_perm(_t2, _t0, 0x05040100u); y1 = __builtin_amdgcn_perm(_t2, _t0, 0x07060302u); y2 = __builtin_amdgcn_perm(_t3, _t1, 0x05040100u); y3 = __builtin_amdgcn_perm(_t3, _t1, 0x07060302u); } while (0)
#define G2_QUAD(Ra, Rb, Rc, Rd, W_) do { _Pragma("unroll") for (int _d = 0; _d < 4; ++_d) { unsigned _y0, _y1, _y2, _y3; G2_TR4(_y0, _y1, _y2, _y3, (Ra)[_d], (Rb)[_d], (Rc)[_d], (Rd)[_d]); \
    aT[4 * _d] = __builtin_amdgcn_sdot4((int)_y0, (int)(W_), aT[4 * _d], false); aL[4 * _d] = __builtin_amdgcn_sdot4((int)(_y0 & 0x0f0f0f0fu), (int)(W_), aL[4 * _d], false); \
    aT[4 * _d + 1] = __builtin_amdgcn_sdot4((int)_y1, (int)(W_), aT[4 * _d + 1], false); aL[4 * _d + 1] = __builtin_amdgcn_sdot4((int)(_y1 & 0x0f0f0f0fu), (int)(W_), aL[4 * _d + 1], false); \
    aT[4 * _d + 2] = __builtin_amdgcn_sdot4((int)_y2, (int)(W_), aT[4 * _d + 2], false); aL[4 * _d + 2] = __builtin_amdgcn_sdot4((int)(_y2 & 0x0f0f0f0fu), (int)(W_), aL[4 * _d + 2], false); \
    aT[4 * _d + 3] = __builtin_amdgcn_sdot4((int)_y3, (int)(W_), aT[4 * _d + 3], false); aL[4 * _d + 3] = __builtin_amdgcn_sdot4((int)(_y3 & 0x0f0f0f0fu), (int)(W_), aL[4 * _d + 3], false); } } while (0)
#define G2_D0(d, y, w) asm volatile("v_dot4_i32_i8 %0, %1, %2, 0" : "=v"(d) : "v"(y), "v"(w))
#define G2_QUAD0(Ra, Rb, Rc, Rd, W_) do { _Pragma("unroll") for (int _d = 0; _d < 4; ++_d) { unsigned _y0, _y1, _y2, _y3; G2_TR4(_y0, _y1, _y2, _y3, (Ra)[_d], (Rb)[_d], (Rc)[_d], (Rd)[_d]); \
    const unsigned _m0 = _y0 & 0x0f0f0f0fu, _m1 = _y1 & 0x0f0f0f0fu, _m2 = _y2 & 0x0f0f0f0fu, _m3 = _y3 & 0x0f0f0f0fu; \
    G2_D0(aT[4 * _d], _y0, W_); G2_D0(aL[4 * _d], _m0, W_); G2_D0(aT[4 * _d + 1], _y1, W_); G2_D0(aL[4 * _d + 1], _m1, W_); \
    G2_D0(aT[4 * _d + 2], _y2, W_); G2_D0(aL[4 * _d + 2], _m2, W_); G2_D0(aT[4 * _d + 3], _y3, W_); G2_D0(aL[4 * _d + 3], _m3, W_); } } while (0)
__device__ __forceinline__ void op_gather_v(Frame& F, KArgs A, int layer, int nrows, bool dry) {
    const unsigned char* TV = ws_ + WS_TV + (size_t)layer * NEXP * 512;
    const int* IDX = (const int*)(ws_ + WS_IDX); const f32x4* SG = (const f32x4*)(ws_ + WS_SG); const unsigned* PACT = (const unsigned*)(ws_ + WS_Z);
    unsigned* X = (unsigned*)(ws_ + WS_X); unsigned* Xw = dry ? (unsigned*)(ws_ + WS_Z + 80 * MiB) : X;
    const float* modl = (const float*)(ws_ + WS_MOD) + (size_t)layer * 9 * MODW;
    LAS unsigned* wl = (LAS unsigned*)(F.lds + F.wave * 4096);
    LAS unsigned* lE = (LAS unsigned*)(F.lds + F.wave * 4096 + 1024);
    int x0, nsl, w0, NW_; slice_map4(F, A, x0, nsl, w0, NW_);
    const unsigned pp0 = (unsigned)F.lane & 7u, gg0 = (unsigned)F.lane >> 3, ll0 = (unsigned)F.lane;
    const bool b3 = F.lane & 8, b4 = F.lane & 16, b5 = F.lane & 32;
    for (int xs = 0; xs < nsl; ++xs) {
        const int x = x0 + xs;
        const unsigned char* tsl = TV + (size_t)x * (NEXP * 128);
        int t = w0;
        if (t >= nrows) continue;
        const int tlast = t + ((nrows - 1 - t) / NW_) * NW_;
        v4u R0[8], R1[8]; v2u eraw;
        unsigned pp = pp0, gg = gg0, ll = ll0; asm volatile("" : "+v"(pp), "+v"(gg), "+v"(ll));
        unsigned pw[4]; f32x4 psg;
        float swc, swn;
#define G2_LOAD_W(tt) do { const int _t = (tt) < tlast ? (tt) : tlast; const unsigned* _pa = PACT + (size_t)_t * 64; \
        _Pragma("unroll") for (int xx = 0; xx < 4; ++xx) pw[xx] = _pa[(size_t)xx * NTOK * 64 + ll]; \
        psg = SG[(size_t)_t * 64 + ll]; } while (0)
#define G2_MAKE_W(buf, sw_) do { float s0 = 0.f, s1 = 0.f; _Pragma("unroll") for (int xx = 0; xx < 4; ++xx) { const h2_t _h = u2h(pw[xx]); s0 += (float)_h.x; s1 += (float)_h.y; } \
        const float _w0 = pg8::gelu1(s0 * psg.x) * psg.y, _w1 = pg8::gelu1(s1 * psg.z) * psg.w; \
        const float _m = wave_max(fmaxf(fabsf(_w0), fabsf(_w1))), _inv = _m > 0.f ? 127.f / _m : 0.f; \
        const int _q0 = (int)__builtin_rintf(_w0 * _inv), _q1 = (int)__builtin_rintf(_w1 * _inv); \
        *((LAS unsigned short*)(wl + (buf) * 32) + ll) = (unsigned short)(((unsigned)_q0 & 255u) | (((unsigned)_q1 & 255u) << 8)); sw_ = _m * (1.f / 127.f); } while (0)
#define G2_GLOAD(tt) do { const int _t = (tt) < tlast ? (tt) : tlast; eraw = *(const v2u*)(IDX + (size_t)_t * 128 + 2u * ll); } while (0)
#define G2_LWRITE(r_) do { *(LAS v2u*)(lE + (r_) * 128 + 2u * ll) = eraw; } while (0)
        G2_GLOAD(t); G2_LWRITE(0); G2_GLOAD(t + NW_); G2_LWRITE(1); G2_GLOAD(t + 2 * NW_);
        G2_LOAD_W(t);
        { const v4u e0 = *(const LAS v4u*)(lE + 16u * gg), e1 = *(const LAS v4u*)(lE + 16u * gg + 4u); G_LOAD_R8L(R0, e0, e1, tsl); }
        G2_MAKE_W(0, swc);
        int buf = 0, r = 0;
        while (t < nrows) {
            const int tn = t + NW_; const int mr = t < NLAT ? (t >> 11) : 8;
            pp = pp0; gg = gg0; ll = ll0; asm volatile("" : "+v"(pp), "+v"(gg), "+v"(ll));
            const unsigned colb = (unsigned)x * 256u + 32u * pp + ((gg & 1u) << 4) + ((gg & 2u) << 2) + (gg & 4u);
            const int r1 = G_RING(r, 1), r2 = G_RING(r, 2);
            G2_LWRITE(r2);
            G2_GLOAD(t + 3 * NW_);
            const v4u ea0 = *(const LAS v4u*)(lE + r * 128 + 16u * gg + 8u), ea1 = *(const LAS v4u*)(lE + r * 128 + 16u * gg + 12u);
            const v4u eb0 = *(const LAS v4u*)(lE + r1 * 128 + 16u * gg), eb1 = *(const LAS v4u*)(lE + r1 * 128 + 16u * gg + 4u);
            G_LOAD_R8L(R1, ea0, ea1, tsl);
            G2_LOAD_W(tn);
            const f32x4 gt2 = *(const f32x4*)(modl + mr * MODW + 5 * DM + colb);
            const v2u xo = *(const v2u*)(X + (((size_t)t * DM + colb) >> 1));
            LDS_WAIT(); asm volatile("" ::: "memory");
            const v4u wq = *(const LAS v4u*)(wl + buf * 32 + 4u * gg);
            int aT[16], aL[16];
            G2_QUAD0(R0[0], R0[1], R0[2], R0[3], wq.x); G2_QUAD(R0[4], R0[5], R0[6], R0[7], wq.y);
            G_LOAD_R8L(R0, eb0, eb1, tsl);
            G2_QUAD(R1[0], R1[1], R1[2], R1[3], wq.z); G2_QUAD(R1[4], R1[5], R1[6], R1[7], wq.w);
            int sw = __builtin_amdgcn_sdot4((int)wq.x, 0x01010101, 0, false); sw = __builtin_amdgcn_sdot4((int)wq.y, 0x01010101, sw, false);
            sw = __builtin_amdgcn_sdot4((int)wq.z, 0x01010101, sw, false); sw = __builtin_amdgcn_sdot4((int)wq.w, 0x01010101, sw, false);
            sw += (int)shx_u<8>((unsigned)sw); sw += (int)shx_u<16>((unsigned)sw); sw += (int)shx32_u((unsigned)sw, b5);
            unsigned T8[8], T4[4], T2[2], L8[8], L4[4], L2[2];
#pragma unroll
            for (int i = 0; i < 8; ++i) { const unsigned mt = (unsigned)(b3 ? aT[8 + i] : aT[i]), st = (unsigned)(b3 ? aT[i] : aT[8 + i]); T8[i] = mt + shx_u<8>(st);
                                          const unsigned ml = (unsigned)(b3 ? aL[8 + i] : aL[i]), sl = (unsigned)(b3 ? aL[i] : aL[8 + i]); L8[i] = ml + shx_u<8>(sl); }
#pragma unroll
            for (int i = 0; i < 4; ++i) { const unsigned mt = b4 ? T8[4 + i] : T8[i], st = b4 ? T8[i] : T8[4 + i]; T4[i] = mt + shx_u<16>(st);
                                          const unsigned ml = b4 ? L8[4 + i] : L8[i], sl = b4 ? L8[i] : L8[4 + i]; L4[i] = ml + shx_u<16>(sl); }
#pragma unroll
            for (int i = 0; i < 2; ++i) { const unsigned mt = b5 ? T4[2 + i] : T4[i], st = b5 ? T4[i] : T4[2 + i]; T2[i] = mt + shx32_u(st, b5);
                                          const unsigned ml = b5 ? L4[2 + i] : L4[i], sl = b5 ? L4[i] : L4[2 + i]; L2[i] = ml + shx32_u(sl, b5); }
            const float hsc = 0.5f * swc;
            const float o0 = (float)(2 * (int)L2[0] - 15 * sw) * hsc, o1 = (float)((((int)T2[0] - (int)L2[0]) >> 3) + sw) * hsc;
            const float o2 = (float)(2 * (int)L2[1] - 15 * sw) * hsc, o3 = (float)((((int)T2[1] - (int)L2[1]) >> 3) + sw) * hsc;
            { v2u xn; xn.x = pk2(bflo(xo.x) + gt2[0] * o0, bfhi(xo.x) + gt2[1] * o1); xn.y = pk2(bflo(xo.y) + gt2[2] * o2, bfhi(xo.y) + gt2[3] * o3);
              *(v2u*)(Xw + (((size_t)t * DM + colb) >> 1)) = xn; }
            G2_MAKE_W(1 - buf, swn);
            swc = swn;
            buf = 1 - buf; r = r1; t = tn;
        }
#undef G2_LOAD_W
#undef G2_MAKE_W
#undef G2_GLOAD
#undef G2_LWRITE
        LDS_WAIT(); asm volatile("" ::: "memory");
    }
}

constexpr int SPL = 11;
constexpr int NSTEPS = 2 + SPL * DEPTH;
#ifndef DIS
#define DIS 0
#endif
#ifndef ZB
#define ZB 0
#endif
#define EN(n) (!((DIS >> (n)) & 1))
__device__ __forceinline__ bool run_step(Frame& F, KArgs A, int step, bool dry) {
    unsigned char* ws = ws_;
    bf16* X = (bf16*)(ws + WS_X); const float* MOD = (const float*)(ws + WS_MOD);
    bf16* H = (bf16*)(ws + WS_H);
    if (step == 0) { if (EN(0)) op_prep(F, A); return true; }
    if (step == 1) { if (EN(1)) op_modulate(F, A, A->in[I_X], A->in[I_CTX], nullptr, A->in[I_N1G], MOD, 0, NTOK, false); }
    const int layer = (step - 2) / SPL, k = (step - 2) % SPL, kind = layer % 3, jj = layer / 3;
    const int nrows = (layer == DEPTH - 1) ? NLAT : NTOK, nM = nrows / 256;
    const float* modl = MOD + (size_t)layer * 9 * MODW;
    if (k == 1) { if (kind == 0) { if (EN(4)) op_spatial(F, A, jj, nrows); } else if (kind == 1) { if (EN(5)) op_pool(F, A, nrows); } else { if (EN(6)) op_qknorm(F, A, nrows); } return true; }
    if (k == 2 && kind == 0) return false;
    if (k == 2 && kind == 2) { if (EN(8)) op_attn(F, A); return true; }
    if (k == 4) { if (EN(10)) op_modulate(F, A, nullptr, nullptr, X, A->in[I_N2G] + layer * DM, modl, 3, nrows, false, true); return true; }
    if (k == 7) { if (EN(13)) op_topk(F, A, layer, nrows); return true; }
    if (k == 8) { if (EN(14)) op_gather_u(F, A, layer, nrows, dry); return true; }
    if (k == 9) { if (EN(14)) op_gather_v(F, A, layer, nrows, dry); return true; }
    if (k == 10) {
        if (layer == DEPTH - 1) op_modulate(F, A, nullptr, nullptr, X, A->in[I_FINAL_G], modl, 0, NLAT, true);
        else op_modulate(F, A, nullptr, nullptr, X, A->in[I_N1G] + (layer + 1) * DM, modl + 9 * MODW, 0, (layer == DEPTH - 2) ? NLAT : NTOK, false);
        return true; }
    if (k == 6) return false;
    const int nrep = (k == 0 && kind == 0) ? 2 : 1;
    for (int rep = 0; rep < nrep; ++rep) {
        pg8::Gemm g; pg8::EpiAny E;
        g.A = H; g.lda = DM; g.K = DM; g.nM = nM; g.nN = 4; g.a_pm = 256 * DM; g.a_pn = 0; g.Bt = H; g.ldb = DM; g.b_pm = 0; g.b_pn = 256 * DM;
        E.type = 0; E.perm = true; E.O = (void*)(ws + WS_Z); E.ldc = DM; E.act = 0; E.mul = nullptr; E.o_pm = 0; E.o_pn = 256;
        E.srcLat = nullptr; E.srcCtx = nullptr; E.X = (void*)X; E.Xsrc = (const void*)X; E.modl = modl; E.nlat = NLAT; E.chunk = 2; E.SS = (float*)(ws + WS_SS); if (dry) E.X = (void*)(ws + WS_Z); E.gs = ((ZB >> kind) & 1) ? 0.f : 1.f;
        if (k < 0) {
            g.A = (const bf16*)(ws + WS_KB); g.lda = 256; g.K = 256; g.nM = DEPTH * 8; g.nN = 4; g.a_pm = 65536; g.a_pn = 0;
            g.Bt = (const bf16*)(ws + WS_G); g.ldb = 256; g.b_pm = 1024 * 256; g.b_pn = 65536;
            E.O = (void*)(ws + WS_WPQ); E.ldc = DM;
        } else if (k == 0) {
            if (kind == 0 && rep == 0) { g.Bt = (const bf16*)(ws + WS_WSGUIN) + (size_t)jj * 4096 * 1024; g.nN = 8; E.ldc = SGUW; E.act = 1; }
            else if (kind == 0) {
                g.A = (const bf16*)(ws + WS_WSGUIN) + (size_t)jj * 4096 * 1024 + (size_t)2048 * 1024; g.nM = 8; g.nN = nM; g.Bt = H;
                E.type = 3; E.O = (void*)((bf16*)(ws + WS_Z) + (size_t)NTOK * SGUW); E.ldc = NTOK; }
            else if (kind == 1) { g.Bt = (const bf16*)(ws + WS_WPOOLIN); g.nN = 4; E.ldc = DM; }
            else { g.Bt = (const bf16*)(ws + WS_WQKV); g.nN = 6; E.ldc = 1536; }
        } else if (k == 2) {
            g.A = (const bf16*)(ws + WS_G); g.K = 256; g.a_pn = 256; g.Bt = (const bf16*)(ws + WS_WGRP); g.ldb = 256; g.b_pn = 65536;
            E.O = (void*)H; E.ldc = DM; E.mul = A->in[I_POOL_SCALE];
        } else if (k == 3) {
            if (kind == 0) { g.A = (const bf16*)(ws + WS_G); g.lda = SGUW; g.K = SGUW; g.Bt = (const bf16*)(ws + WS_WSGUOUT) + (size_t)jj * 1024 * 2048; }
            else if (kind == 1) { g.Bt = (const bf16*)(ws + WS_WPOOLOUT); }
            else { g.Bt = (const bf16*)(ws + WS_WO); }
            g.ldb = g.K; g.a_pm = 256 * (long)g.lda; g.b_pn = 256 * (long)g.ldb;
            E.type = 2; E.perm = true; E.srcLat = layer == 0 ? A->in[I_X] : nullptr; E.srcCtx = layer == 0 ? A->in[I_CTX] : nullptr;
        } else {
            g.nN = 8; g.Bt = (const bf16*)(ws + WS_WPQ) + (size_t)layer * 2048 * 1024; E.act = 2; E.O = (void*)(ws + WS_Z); E.ldc = 2048;
        }
        E.o_pm = 256 * (long)E.ldc;
        pg8::StaticOrder S; S.init(g.nM, g.nN, F.G, F.bx);
        if (EN(2)) pg8::gemm_phase<true>(F.lds, g, S, E, F.tid);
    }
    return true;
}

__global__ void __launch_bounds__(NWAVES * 64, 2) mega_fwd(Args args) {
    extern __shared__ __attribute__((aligned(16))) unsigned char lds[];
    for (int u = threadIdx.x; u < (LDS_BYTES - LDSCTL_OFF) / 4; u += NWAVES * 64) ((LAS unsigned*)((LAS unsigned char*)lds + LDSCTL_OFF))[u] = 0u;
    __syncthreads();
    { const unsigned hw = (unsigned)__builtin_amdgcn_s_getreg((5 << 11) | 4) & 63u;
      if ((threadIdx.x & 63) == 0) ((LAS unsigned*)((LAS unsigned char*)lds + WSLOT_OFF))[hw] = threadIdx.x >> 6; }
    const int lo = args.lo, hi = args.hi;
    if (hi - lo > 1 && threadIdx.x == 0) {
        const unsigned xcc = xb_xcc_id(); const unsigned rk = xb_add((unsigned*)(args.ws + WS_CTL) + CW_BAR + XB_XCNT(xcc), 1u);
        ((LAS unsigned*)((LAS unsigned char*)lds + MISC_OFF))[12] = rk; ((LAS unsigned*)((LAS unsigned char*)lds + MISC_OFF))[13] = xcc; }
    __syncthreads();
    for (int step = lo; step < hi; ++step) {
        KArgs kp = (KArgs)__builtin_amdgcn_kernarg_segment_ptr();
        asm volatile("" : "+s"(kp));
        int g_ = gridDim.x, bx_ = blockIdx.x; unsigned lo_ = 0;
        asm volatile("" : "+s"(g_), "+s"(bx_), "+s"(lo_));
        Frame F;
        F.lds = (LAS unsigned char*)lds + lo_;
        const unsigned hw = (unsigned)__builtin_amdgcn_s_getreg((5 << 11) | 4) & 63u;
        F.wave = __builtin_amdgcn_readfirstlane(((volatile LAS unsigned*)(F.lds + WSLOT_OFF))[hw]);
        F.lane = (int)__builtin_amdgcn_mbcnt_hi(~0u, __builtin_amdgcn_mbcnt_lo(~0u, 0u)); asm volatile("" : "+v"(F.lane));
        F.tid = F.wave * 64 + F.lane;
        F.G = g_; F.bx = bx_; F.vcu = (g_ % 8 == 0) ? (bx_ % 8) * (g_ / 8) + bx_ / 8 : bx_;
        const int kcls = step < 2 ? 11 + step : (step - 2) % SPL;
        bool dry = ((REPK >> kcls) & 1) != 0 && (step < 2 || ((REPL >> ((step - 2) / SPL)) & 1));
        bool did = run_step(F, kp, step, dry);
        if (dry) {
            XcdBarrier bar; bar.bar = (unsigned*)(kp->ws + WS_CTL) + CW_BAR; bar.x = xb_xcc_id(); bar.st = (volatile LAS unsigned*)(F.lds + MISC_OFF) + 8;
            if (did) xcd_barrier(bar, F.tid);
            did = run_step(F, kp, step, false);
        }
        if (did && step + 1 < hi) {
            XcdBarrier bar; bar.bar = (unsigned*)(kp->ws + WS_CTL) + CW_BAR; bar.x = xb_xcc_id(); bar.st = (volatile LAS unsigned*)(F.lds + MISC_OFF) + 8;
            xcd_barrier(bar, F.tid);
        }
    }
}

extern "C" void kernel_launch(void* const* d_in, const int* in_sizes, int n_in, void* d_out, int out_size, void* d_ws, size_t ws_size, hipStream_t stream) {
    static int grid = 0;
    if (grid == 0) {
        if (n_in != N_IN || out_size != NLAT * DM || ws_size < WS_END) { fprintf(stderr, "kernel_launch: unexpected shapes: n_in %d out %d ws %zu (need >= %zu)\n", n_in, out_size, ws_size, (size_t)WS_END); grid = -1; return; }
        int dev = 0, cus = 0, per_cu = 0;
        if (hipGetDevice(&dev) != hipSuccess || hipDeviceGetAttribute(&cus, hipDeviceAttributeMultiprocessorCount, dev) != hipSuccess) { grid = -1; return; }
        if (hipFuncSetAttribute((const void*)mega_fwd, hipFuncAttributeMaxDynamicSharedMemorySize, LDS_BYTES) != hipSuccess) { fprintf(stderr, "kernel_launch: hipFuncSetAttribute failed\n"); grid = -1; return; }
        if (hipOccupancyMaxActiveBlocksPerMultiprocessor(&per_cu, (const void*)mega_fwd, NWAVES * 64, LDS_BYTES) != hipSuccess || per_cu < 1) { fprintf(stderr, "kernel_launch: occupancy query says %d\n", per_cu); (void)hipGetLastError(); grid = -1; return; }
        grid = cus;
    }
    if (grid < 0) return;
    (void)hipMemsetAsync((char*)d_ws + WS_CTL, 0, CTL_ZERO_BYTES, stream);
    Args a{};
    for (int i = 0; i < N_IN; ++i) a.in[i] = (const float*)d_in[i];
    a.out = (float*)d_out; a.ws = (unsigned char*)d_ws;
#if MK_MULTI
    for (int s = 0; s < NSTEPS; ++s) { a.lo = s; a.hi = s + 1; hipLaunchKernelGGL(mega_fwd, dim3(grid), dim3(NWAVES * 64), LDS_BYTES, stream, a); }
#else
    a.lo = 0; a.hi = NSTEPS;
    void* kargs[] = {&a};
    hipError_t e = hipLaunchCooperativeKernel((const void*)mega_fwd, dim3(grid), dim3(NWAVES * 64), kargs, LDS_BYTES, stream);
    if (e != hipSuccess) { fprintf(stderr, "kernel_launch: cooperative launch failed: %s\n", hipGetErrorString(e)); (void)hipGetLastError();
        hipLaunchKernelGGL(mega_fwd, dim3(grid), dim3(NWAVES * 64), LDS_BYTES, stream, a); }
#endif
}
```

```cpp
#include <hip/hip_runtime.h>
#include <hip/hip_bf16.h>
#include <cstdio>
#include <cstdint>

#ifndef MK_MULTI
#define MK_MULTI 0
#endif
#ifndef PEER_SCALE
#define PEER_SCALE 1.0f
#endif
#ifndef REPL
#define REPL 15
#endif
#ifndef PREPREP
#define PREPREP 0
#endif
#ifndef GVAR
#define GVAR 0
#endif
#ifndef EMASK
#define EMASK 0xffffffff
#endif
#ifndef REPK
#define REPK 0
#endif
#ifndef TOPK_REF
#define TOPK_REF 0
#endif
#ifndef GATHER_REF
#define GATHER_REF 0
#endif
#ifndef ZB
#define ZB 0
#endif

template <int M> __device__ __forceinline__ unsigned shx_u(unsigned v) {
    if (M == 1) return (unsigned)__builtin_amdgcn_mov_dpp((int)v, 0xB1, 0xf, 0xf, true);
    if (M == 2) return (unsigned)__builtin_amdgcn_mov_dpp((int)v, 0x4E, 0xf, 0xf, true);
    if (M == 8) return (unsigned)__builtin_amdgcn_mov_dpp((int)v, 0x128, 0xf, 0xf, true);
    return (unsigned)__builtin_amdgcn_ds_swizzle((int)v, (M << 10) | 0x1f);
}
template <int M> __device__ __forceinline__ float shx(float v) { return __uint_as_float(shx_u<M>(__float_as_uint(v))); }
__device__ __forceinline__ unsigned shx32_u(unsigned v, bool upper) {
    auto r = __builtin_amdgcn_permlane32_swap(v, v, false, false); return upper ? r[0] : r[1]; }
__device__ __forceinline__ float shx32(float v, bool upper) { return __uint_as_float(shx32_u(__float_as_uint(v), upper)); }
__device__ __forceinline__ float bperm(int srcLane, float v) { return __uint_as_float((unsigned)__builtin_amdgcn_ds_bpermute(srcLane << 2, (int)__float_as_uint(v))); }
__device__ __forceinline__ int bperm_i(int srcLane, int v) { return __builtin_amdgcn_ds_bpermute(srcLane << 2, v); }
namespace pg8 {
#define PG8_LAS __attribute__((address_space(3)))
typedef unsigned short bf16_t;
typedef short bf16x8 __attribute__((ext_vector_type(8)));
typedef float f32x4 __attribute__((ext_vector_type(4)));
typedef float f32x2 __attribute__((ext_vector_type(2)));
typedef unsigned u32x4 __attribute__((ext_vector_type(4)));
typedef unsigned u32x2 __attribute__((ext_vector_type(2)));
typedef int i32x4 __attribute__((ext_vector_type(4)));
constexpr int BM = 256, BK = 64, HALF = 128, HTB = HALF * BK * 2, STAGE_BYTES = 8 * HTB, NXCD = 8, WGM = 8;

__host__ __device__ __forceinline__ int lds_byte(int r, int c) { const int st = (r >> 4) * 2 + (c >> 5), rr = r & 15, cc = c & 31, ob = rr * 64 + cc * 2; return st * 1024 + (ob ^ (((ob >> 9) & 1) << 5)); }
__host__ __device__ __forceinline__ void stage_rc(int b, int& R, int& C) { const int st = b / 1024, sb = b % 1024, swz = sb ^ (((sb >> 9) & 1) << 5); R = (st >> 1) * 16 + swz / 64; C = (st & 1) * 32 + (swz % 64) / 2; }
__host__ __device__ __forceinline__ int perm32(int rho) { const int n = rho >> 4, i = rho & 15; return 8 * (i >> 2) + 4 * n + (i & 3); }

struct Unit { int pm, pn; };
struct Gemm { const bf16_t* A; const bf16_t* Bt; int lda, ldb, K, nM, nN; long a_pm, a_pn, b_pm, b_pn; };

struct StaticOrder {
    int nM, nN, nwg, G, c;
    __host__ __device__ void init(int nM_, int nN_, int G_, int c_) { nM = nM_; nN = nN_; nwg = nM * nN; G = G_; c = c_; }
    __host__ __device__ bool next(int i, Unit& u) const {
        const long L = (long)i * G + c; if (L >= nwg) return false;
        int wgid = (int)L; { const int q = nwg / NXCD, r = nwg % NXCD, xcd = wgid % NXCD, off = wgid / NXCD; wgid = (xcd < r ? xcd * (q + 1) : r * (q + 1) + (xcd - r) * q) + off; }
        const int nig = WGM * nN, gid = wgid / nig, fm = gid * WGM, gsz = (nM - fm) < WGM ? (nM - fm) : WGM;
        u.pm = fm + ((wgid % nig) % gsz); u.pn = (wgid % nig) / gsz; return true;
    }
};

__device__ __forceinline__ unsigned cvt_pk_bf16(float lo, float hi) { unsigned r; asm volatile("v_cvt_pk_bf16_f32 %0, %1, %2" : "=v"(r) : "v"(lo), "v"(hi)); return r; }
__device__ __forceinline__ f32x2 gelu_pk(f32x2 v) {
    const f32x2 av = __builtin_elementwise_abs(v), d = av * 0.2316418882f + 1.0f;
    f32x2 t; t.x = __builtin_amdgcn_rcpf(d.x); t.y = __builtin_amdgcn_rcpf(d.y);
    f32x2 q = t * 0.5307027145f + (-0.7265760135f); q = q * t + 0.7107068705f; q = q * t + (-0.142248368f); q = q * t + 0.127414796f; q = q * t;
    const f32x2 s = (v * v) * (-0.72134752044f);
    f32x2 e; e.x = __builtin_amdgcn_exp2f(s.x); e.y = __builtin_amdgcn_exp2f(s.y);
    const f32x2 m = v * (q * e), r = v - m;
    f32x2 o; o.x = v.x < 0.f ? m.x : r.x; o.y = v.y < 0.f ? m.y : r.y; return o;
}
__device__ __forceinline__ float gelu1(float v) { f32x2 r = gelu_pk((f32x2){v, v}); return r.x; }
__device__ __forceinline__ f32x4 gelu4(f32x4 v) { f32x2 a = gelu_pk((f32x2){v[0], v[1]}), b = gelu_pk((f32x2){v[2], v[3]}); return (f32x4){a.x, a.y, b.x, b.y}; }

struct EpiAny {
    int type;
    bool perm;
    void* O; int ldc; int act; const float* mul; long o_pm, o_pn;
    const float* srcLat; const float* srcCtx; void* X; const void* Xsrc; const float* modl; int nlat; int chunk;
    float* SS;
    const float* rsc; const float* csc;
    float gs;
    __device__ __forceinline__ void bf16_store(const f32x4 (&acc)[2][2][4][2], const Unit& u, int wr, int wc, int fr, int fq) const {
        bf16_t* base = (bf16_t*)O + u.pm * o_pm + u.pn * o_pn;
        const int row0 = wr * 64 + fr, col0 = wc * 32 + 8 * fq;
        f32x4 mv[2][2];
#pragma unroll
        for (int bj = 0; bj < 2; ++bj)
#pragma unroll
            for (int n = 0; n < 2; ++n) mv[bj][n] = mul ? *(const f32x4*)(mul + u.pn * BM + col0 + bj * HALF + 4 * n) : (f32x4){1.f, 1.f, 1.f, 1.f};
#pragma unroll
        for (int ai = 0; ai < 2; ++ai)
#pragma unroll
            for (int m = 0; m < 4; ++m) { bf16_t* rowp = base + (size_t)(row0 + ai * HALF + m * 16) * ldc + col0;
#pragma unroll
                for (int bj = 0; bj < 2; ++bj) { f32x4 v0 = acc[ai][bj][m][0], v1 = acc[ai][bj][m][1];
                    if (act == 1) { v0 = gelu4(v0); v1 = gelu4(v1); }
                    v0 = v0 * mv[bj][0]; v1 = v1 * mv[bj][1];
                    u32x4 w;
                    if (act == 2) {
                        w.x = __builtin_bit_cast(unsigned, __builtin_amdgcn_cvt_pkrtz(v0[0], v0[1])); w.y = __builtin_bit_cast(unsigned, __builtin_amdgcn_cvt_pkrtz(v0[2], v0[3]));
                        w.z = __builtin_bit_cast(unsigned, __builtin_amdgcn_cvt_pkrtz(v1[0], v1[1])); w.w = __builtin_bit_cast(unsigned, __builtin_amdgcn_cvt_pkrtz(v1[2], v1[3]));
                    } else { w.x = cvt_pk_bf16(v0[0], v0[1]); w.y = cvt_pk_bf16(v0[2], v0[3]); w.z = cvt_pk_bf16(v1[0], v1[1]); w.w = cvt_pk_bf16(v1[2], v1[3]); }
                    *(u32x4*)(rowp + bj * HALF) = w; } }
    }
    __device__ __forceinline__ void i8_scale(f32x4 (&acc)[2][2][4][2], const Unit& u, int wr, int wc, int fr, int fq) const {
        const int row0 = u.pm * BM + wr * 64 + fr, col0 = u.pn * BM + wc * 32 + 8 * fq;
        f32x4 cv[2][2]; float rs[2][4];
#pragma unroll
        for (int bj = 0; bj < 2; ++bj)
#pragma unroll
            for (int n = 0; n < 2; ++n) cv[bj][n] = *(const f32x4*)(csc + col0 + bj * HALF + 4 * n);
#pragma unroll
        for (int ai = 0; ai < 2; ++ai)
#pragma unroll
            for (int m = 0; m < 4; ++m) rs[ai][m] = rsc[row0 + ai * HALF + m * 16];
#pragma unroll
        for (int ai = 0; ai < 2; ++ai)
#pragma unroll
            for (int m = 0; m < 4; ++m)
#pragma unroll
                for (int bj = 0; bj < 2; ++bj)
#pragma unroll
                    for (int n = 0; n < 2; ++n) { const i32x4 iv = __builtin_bit_cast(i32x4, acc[ai][bj][m][n]);
                        const f32x4 fv = {(float)iv[0], (float)iv[1], (float)iv[2], (float)iv[3]};
                        acc[ai][bj][m][n] = fv * rs[ai][m] * cv[bj][n]; }
    }
    __device__ __forceinline__ void f32_store(const f32x4 (&acc)[2][2][4][2], const Unit& u, int wr, int wc, int fr, int fq) const {
        float* C = (float*)O;
        const int row0 = u.pm * BM + wr * 64 + fr, col0 = u.pn * BM + wc * 32 + 4 * fq;
#pragma unroll
        for (int ai = 0; ai < 2; ++ai)
#pragma unroll
            for (int m = 0; m < 4; ++m) { float* rowp = C + (size_t)(row0 + ai * HALF + m * 16) * ldc + col0;
#pragma unroll
                for (int bj = 0; bj < 2; ++bj)
#pragma unroll
                    for (int n = 0; n < 2; ++n) *(f32x4*)(rowp + bj * HALF + n * 16) = acc[ai][bj][m][n]; }
    }
    __device__ __forceinline__ void resid(const f32x4 (&acc)[2][2][4][2], const Unit& u, int wr, int wc, int fr, int fq) const {
        const int rowt = u.pm * BM; const int mr = rowt < nlat ? (rowt >> 11) : 8;
        const float* gp = modl + mr * 6144 + chunk * 1024;
        bf16_t* xp = (bf16_t*)X + (size_t)rowt * 1024;
        const int row0 = wr * 64 + fr, col0 = u.pn * BM + wc * 32 + 8 * fq;
        f32x4 gv[2][2];
#pragma unroll
        for (int bj = 0; bj < 2; ++bj)
#pragma unroll
            for (int n = 0; n < 2; ++n) gv[bj][n] = *(const f32x4*)(gp + col0 + bj * HALF + n * 4) * gs;
        if (srcLat) {
            const float* sp = rowt < nlat ? srcLat + (size_t)rowt * 1024 : srcCtx + (size_t)(rowt - nlat) * 1024;
#pragma unroll
            for (int ai = 0; ai < 2; ++ai)
#pragma unroll
                for (int mp = 0; mp < 2; ++mp) {
                    f32x4 sf[2][2][2];
#pragma unroll
                    for (int mm = 0; mm < 2; ++mm) { const size_t off = (size_t)(row0 + ai * HALF + (2 * mp + mm) * 16) * 1024 + col0;
#pragma unroll
                        for (int bj = 0; bj < 2; ++bj) { sf[mm][bj][0] = *(const f32x4*)(sp + off + bj * HALF); sf[mm][bj][1] = *(const f32x4*)(sp + off + bj * HALF + 4); } }
                    asm volatile("" ::: "memory");
#pragma unroll
                    for (int mm = 0; mm < 2; ++mm) { const int m = 2 * mp + mm; const size_t off = (size_t)(row0 + ai * HALF + m * 16) * 1024 + col0;
#pragma unroll
                        for (int bj = 0; bj < 2; ++bj) {
                            const f32x4 y0 = sf[mm][bj][0] + gv[bj][0] * acc[ai][bj][m][0], y1 = sf[mm][bj][1] + gv[bj][1] * acc[ai][bj][m][1];
                            u32x4 w; w.x = cvt_pk_bf16(y0[0], y0[1]); w.y = cvt_pk_bf16(y0[2], y0[3]); w.z = cvt_pk_bf16(y1[0], y1[1]); w.w = cvt_pk_bf16(y1[2], y1[3]);
                            *(u32x4*)(xp + off + bj * HALF) = w; } }
                    asm volatile("" ::: "memory"); }
        } else {
            const bf16_t* sp = (const bf16_t*)Xsrc + (size_t)rowt * 1024;
#pragma unroll
            for (int ai = 0; ai < 2; ++ai) {
                u32x4 sv[4][2];
#pragma unroll
                for (int m = 0; m < 4; ++m) { const size_t off = (size_t)(row0 + ai * HALF + m * 16) * 1024 + col0;
#pragma unroll
                    for (int bj = 0; bj < 2; ++bj) sv[m][bj] = *(const u32x4*)(sp + off + bj * HALF); }
                asm volatile("" ::: "memory");
#pragma unroll
                for (int m = 0; m < 4; ++m) { const size_t off = (size_t)(row0 + ai * HALF + m * 16) * 1024 + col0;
#pragma unroll
                    for (int bj = 0; bj < 2; ++bj) { const u32x4 v = sv[m][bj];
                        const f32x4 s0 = {__uint_as_float(v.x << 16), __uint_as_float(v.x & 0xffff0000u), __uint_as_float(v.y << 16), __uint_as_float(v.y & 0xffff0000u)};
                        const f32x4 s1 = {__uint_as_float(v.z << 16), __uint_as_float(v.z & 0xffff0000u), __uint_as_float(v.w << 16), __uint_as_float(v.w & 0xffff0000u)};
                        const f32x4 y0 = s0 + gv[bj][0] * acc[ai][bj][m][0], y1 = s1 + gv[bj][1] * acc[ai][bj][m][1];
                        u32x4 w; w.x = cvt_pk_bf16(y0[0], y0[1]); w.y = cvt_pk_bf16(y0[2], y0[3]); w.z = cvt_pk_bf16(y1[0], y1[1]); w.w = cvt_pk_bf16(y1[2], y1[3]);
                        *(u32x4*)(xp + off + bj * HALF) = w; } }
                asm volatile("" ::: "memory"); }
        }
    }
    __device__ __forceinline__ void swapv(const f32x4 (&acc)[2][2][4][2], const Unit& u, int wr, int wc, int fr, int fq) const {
        bf16_t* base = (bf16_t*)O + (size_t)u.pm * BM * ldc + (size_t)u.pn * BM;
        const int row0 = wr * 64 + fr, col0 = wc * 32 + 8 * fq;
        float cs[16];
#pragma unroll
        for (int i = 0; i < 16; ++i) cs[i] = 0.f;
#pragma unroll
        for (int ai = 0; ai < 2; ++ai)
#pragma unroll
            for (int m = 0; m < 4; ++m) { bf16_t* rowp = base + (size_t)(row0 + ai * HALF + m * 16) * ldc + col0;
#pragma unroll
                for (int bj = 0; bj < 2; ++bj) { const f32x4 v0 = gelu4(acc[ai][bj][m][0]), v1 = gelu4(acc[ai][bj][m][1]);
#pragma unroll
                    for (int e = 0; e < 4; ++e) { cs[bj * 8 + e] += v0[e] * v0[e]; cs[bj * 8 + 4 + e] += v1[e] * v1[e]; }
                    u32x4 w; w.x = cvt_pk_bf16(v0[0], v0[1]); w.y = cvt_pk_bf16(v0[2], v0[3]); w.z = cvt_pk_bf16(v1[0], v1[1]); w.w = cvt_pk_bf16(v1[2], v1[3]);
                    *(u32x4*)(rowp + bj * HALF) = w; } }
        const bool b3 = fr & 8, b2 = fr & 4, b1 = fr & 2, b0 = fr & 1;
        float d[8], e4[4], f2[2];
#pragma unroll
        for (int i = 0; i < 8; ++i) { const float mine = b3 ? cs[8 + i] : cs[i], send = b3 ? cs[i] : cs[8 + i]; d[i] = mine + shx<8>(send); }
#pragma unroll
        for (int i = 0; i < 4; ++i) { const float mine = b2 ? d[4 + i] : d[i], send = b2 ? d[i] : d[4 + i]; e4[i] = mine + shx<4>(send); }
#pragma unroll
        for (int i = 0; i < 2; ++i) { const float mine = b1 ? e4[2 + i] : e4[i], send = b1 ? e4[i] : e4[2 + i]; f2[i] = mine + shx<2>(send); }
        const float tot = (b0 ? f2[1] : f2[0]) + shx<1>(b0 ? f2[0] : f2[1]);
        const int ci = fr;
        const int col = u.pn * BM + (ci >> 3) * HALF + wc * 32 + 8 * fq + (ci & 7);
        SS[(size_t)(u.pm * 2 + wr) * ldc + col] = tot;
    }
    __device__ __forceinline__ void operator()(const f32x4 (&acc)[2][2][4][2], const Unit& u, int wr, int wc, int fr, int fq) const {
        if (type == 0) bf16_store(acc, u, wr, wc, fr, fq);
        else if (type == 1) f32_store(acc, u, wr, wc, fr, fq);
        else if (type == 2) resid(acc, u, wr, wc, fr, fq);
        else swapv(acc, u, wr, wc, fr, fq);
    }
};

template <bool ALIGN_EPI = true, bool I8 = false>
__device__ __forceinline__ void gemm_phase(PG8_LAS unsigned char* lds, const Gemm g, const StaticOrder& S, const EpiAny& E, const int tid) {
    const int wid = __builtin_amdgcn_readfirstlane(tid >> 6), lane = tid & 63, wr = wid >> 2, wc = wid & 3, fr = lane & 15, fq = lane >> 4;
    const int nt = g.K / BK;
    unsigned voffA[2], voffB[2];
#pragma unroll
    for (int i = 0; i < 2; ++i) { int R, C; stage_rc(tid * 16 + i * 8192, R, C); const int Rb = E.perm ? ((R & ~31) + perm32(R & 31)) : R;
        voffA[i] = (unsigned)(R * g.lda + C) * 2u; voffB[i] = (unsigned)(Rb * g.ldb + C) * 2u; }
    const size_t kstep = (size_t)(BK * 2);
    const size_t hA = (size_t)HALF * g.lda * 2, hB = (size_t)HALF * g.ldb * 2;
    const unsigned ldsw = (unsigned)wid * 1024u;
    const int aoff = lds_byte(wr * 64 + fr, fq * 8), boff = lds_byte(wc * 32 + fr, fq * 8);
#define PG8_SA(b, h) (((b) * 2 + (h)) * HTB)
#define PG8_SB(b, h) ((4 + (b) * 2 + (h)) * HTB)
#define PG8_STAGE(bufoff, gbase, voff) do { _Pragma("unroll") for (int _i = 0; _i < 2; ++_i) \
        __builtin_amdgcn_global_load_lds((const unsigned*)((const char*)(gbase) + (voff)[_i]), (PG8_LAS unsigned*)(lds + (bufoff) + ldsw + _i * 8192), 16, 0, 0); } while (0)
#define PG8_LDA(dst, b, h) do { _Pragma("unroll") for (int m = 0; m < 4; ++m) _Pragma("unroll") for (int k = 0; k < 2; ++k) dst[m][k] = *(const PG8_LAS bf16x8*)(lds + PG8_SA(b, h) + aoff + m * 2048 + k * 1024); } while (0)
#define PG8_LDB(dst, b, h) do { _Pragma("unroll") for (int n = 0; n < 2; ++n) _Pragma("unroll") for (int k = 0; k < 2; ++k) dst[n][k] = *(const PG8_LAS bf16x8*)(lds + PG8_SB(b, h) + boff + n * 2048 + k * 1024); } while (0)
#define PG8_MMA(ai, bj, At, Bt) do { __builtin_amdgcn_s_setprio(1); _Pragma("unroll") for (int m = 0; m < 4; ++m) _Pragma("unroll") for (int n = 0; n < 2; ++n) _Pragma("unroll") for (int k = 0; k < 2; ++k) \
        { if constexpr (I8) acc[ai][bj][m][n] = __builtin_bit_cast(f32x4, __builtin_amdgcn_mfma_i32_16x16x64_i8(__builtin_bit_cast(i32x4, Bt[n][k]), __builtin_bit_cast(i32x4, At[m][k]), __builtin_bit_cast(i32x4, acc[ai][bj][m][n]), 0, 0, 0)); \
          else acc[ai][bj][m][n] = __builtin_amdgcn_mfma_f32_16x16x32_bf16(Bt[n][k], At[m][k], acc[ai][bj][m][n], 0, 0, 0); } __builtin_amdgcn_s_setprio(0); } while (0)
#define PG8_WAIT_V(n) asm volatile("s_waitcnt vmcnt(" #n ")" ::: "memory")
#define PG8_WAIT_L(n) asm volatile("s_waitcnt lgkmcnt(" #n ")" ::: "memory")
#define PG8_BAR __builtin_amdgcn_s_barrier()
#define PG8_SCHED __builtin_amdgcn_sched_barrier(0)
#define PG8_PA(u) ((const char*)g.A + 2 * ((long)(u).pm * g.a_pm + (long)(u).pn * g.a_pn))
#define PG8_PB(u) ((const char*)g.Bt + 2 * ((long)(u).pm * g.b_pm + (long)(u).pn * g.b_pn))
    Unit cur, nxt; int ui = 0;
    if (!S.next(0, cur)) return;
    f32x4 acc[2][2][4][2];
#pragma unroll
    for (int a = 0; a < 2; ++a)
#pragma unroll
        for (int b = 0; b < 2; ++b)
#pragma unroll
            for (int m = 0; m < 4; ++m)
#pragma unroll
                for (int n = 0; n < 2; ++n) acc[a][b][m][n] = (f32x4){0.f, 0.f, 0.f, 0.f};
    bf16x8 At[4][2], B0[2][2], B1[2][2];
    const char* cA = PG8_PA(cur); const char* cB = PG8_PB(cur);
    PG8_STAGE(PG8_SB(0, 0), cB, voffB); PG8_STAGE(PG8_SB(0, 1), cB + hB, voffB); PG8_STAGE(PG8_SA(0, 0), cA, voffA); PG8_STAGE(PG8_SA(0, 1), cA + hA, voffA);
    if (wr == 1) PG8_BAR;
    PG8_WAIT_V(2); PG8_BAR;
    PG8_STAGE(PG8_SB(1, 0), cB + kstep, voffB); PG8_STAGE(PG8_SA(1, 0), cA + kstep, voffA); PG8_STAGE(PG8_SB(1, 1), cB + hB + kstep, voffB);
    PG8_WAIT_V(6); PG8_BAR;
    for (;;) {
        const bool has_next = S.next(ui + 1, nxt);
        const char* nA = has_next ? PG8_PA(nxt) : cA; const char* nB = has_next ? PG8_PB(nxt) : cB;
        for (int t = 0; t < nt; t += 2) {
            const bool last = (t == nt - 2);
            const char* a1 = cA + (size_t)(t + 1) * kstep;
            const char* a2 = last ? nA : cA + (size_t)(t + 2) * kstep; const char* b2 = last ? nB : cB + (size_t)(t + 2) * kstep;
            const char* a3 = a2 + kstep; const char* b3 = b2 + kstep;
            PG8_LDB(B0, 0, 0); PG8_LDB(B1, 0, 1); PG8_SCHED; PG8_LDA(At, 0, 0); PG8_STAGE(PG8_SA(1, 1), a1 + hA, voffA);
            PG8_WAIT_V(8); PG8_WAIT_L(0); PG8_BAR; PG8_MMA(0, 0, At, B0); PG8_MMA(0, 1, At, B1); PG8_BAR; PG8_SCHED;
            PG8_LDA(At, 0, 1); PG8_STAGE(PG8_SB(0, 0), b2, voffB); PG8_STAGE(PG8_SB(0, 1), b2 + hB, voffB); PG8_STAGE(PG8_SA(0, 0), a2, voffA);
            PG8_WAIT_V(8); PG8_WAIT_L(0); PG8_BAR; PG8_MMA(1, 0, At, B0); PG8_MMA(1, 1, At, B1); PG8_BAR; PG8_SCHED;
            PG8_LDB(B0, 1, 0); PG8_LDB(B1, 1, 1); PG8_SCHED; PG8_LDA(At, 1, 0); PG8_STAGE(PG8_SA(0, 1), a2 + hA, voffA);
            PG8_WAIT_V(8); PG8_WAIT_L(0); PG8_BAR; PG8_MMA(0, 0, At, B0); PG8_MMA(0, 1, At, B1); PG8_BAR; PG8_SCHED;
            PG8_LDA(At, 1, 1); PG8_STAGE(PG8_SB(1, 0), b3, voffB); PG8_STAGE(PG8_SB(1, 1), b3 + hB, voffB); PG8_STAGE(PG8_SA(1, 0), a3, voffA);
            PG8_WAIT_V(8); PG8_WAIT_L(0); PG8_BAR; PG8_MMA(1, 0, At, B0); PG8_MMA(1, 1, At, B1); PG8_BAR; PG8_SCHED;
        }
        if constexpr (ALIGN_EPI) { if (wr == 0) PG8_BAR; }
        { int el = (int)__builtin_amdgcn_mbcnt_hi(~0u, __builtin_amdgcn_mbcnt_lo(~0u, 0u)); asm volatile("" : "+v"(el));
          if constexpr (I8) E.i8_scale(acc, cur, wr, wc, el & 15, el >> 4);
          E(acc, cur, wr, wc, el & 15, el >> 4); }
        if (!has_next) break;
#pragma unroll
        for (int a = 0; a < 2; ++a)
#pragma unroll
            for (int b = 0; b < 2; ++b)
#pragma unroll
                for (int m = 0; m < 4; ++m)
#pragma unroll
                    for (int n = 0; n < 2; ++n) acc[a][b][m][n] = (f32x4){0.f, 0.f, 0.f, 0.f};
        cur = nxt; cA = nA; cB = nB; ++ui;
        if constexpr (ALIGN_EPI) { if (wr == 1) PG8_BAR; }
    }
    PG8_WAIT_V(0);
    if constexpr (!ALIGN_EPI) { if (wr == 0) PG8_BAR; }
    PG8_BAR;
#undef PG8_SA
#undef PG8_SB
#undef PG8_STAGE
#undef PG8_LDA
#undef PG8_LDB
#undef PG8_MMA
#undef PG8_WAIT_V
#undef PG8_WAIT_L
#undef PG8_BAR
#undef PG8_SCHED
#undef PG8_PA
#undef PG8_PB
}
}

namespace attn {
using bf16 = __hip_bfloat16;
constexpr int D = 128, NW = 8, QBLK = 32, KVBLK = 64;
constexpr float SCALE = 0.088388347648318440f;
constexpr float THR = 8.f;
constexpr int LDQ = 1024, LDK = 256, LDO = 1024;
constexpr size_t SHM_V = KVBLK * D * 2, SHM_K = KVBLK * D * 2, SHM_ATTN = 2 * SHM_V + 2 * SHM_K + NW * 64 * 4;
using bf16x8 = __attribute__((ext_vector_type(8))) short;
using s16x4  = __attribute__((ext_vector_type(4))) short;
using f32x16 = __attribute__((ext_vector_type(16))) float;
using u32x4  = __attribute__((ext_vector_type(4))) unsigned;
#define KSWZ(row, colB) ((row) * 256 + ((colB) ^ (((row) & 7) << 4)))
#define SBAR() __builtin_amdgcn_sched_barrier(0)
__device__ __forceinline__ int crow(int r, int hi) { return (r & 3) + 8 * (r >> 2) + 4 * hi; }
__device__ __forceinline__ unsigned cvtpk(float lo, float hi) { unsigned r; asm volatile("v_cvt_pk_bf16_f32 %0, %1, %2" : "=v"(r) : "v"(lo), "v"(hi)); return r; }
__device__ __forceinline__ void partialSM(f32x16& p0, f32x16& p1, float& m_reg, float& mn, float& alpha) {
  constexpr float C = SCALE * 1.4426950408889634f;
  float pmax = p0[0]; for (int r = 1; r < 16; ++r) pmax = fmaxf(pmax, p0[r]); for (int r = 0; r < 16; ++r) pmax = fmaxf(pmax, p1[r]);
  { auto rr = __builtin_amdgcn_permlane32_swap(__float_as_uint(pmax), __float_as_uint(pmax), false, false);
    pmax = fmaxf(__uint_as_float(rr[0]), __uint_as_float(rr[1])); }
  if (__builtin_expect(__all(pmax - m_reg <= THR / SCALE), 1)) { mn = m_reg; alpha = 1.f; }
  else { mn = fmaxf(m_reg, pmax); alpha = __builtin_amdgcn_exp2f((m_reg - mn) * C); m_reg = mn; }
  float mnC = -mn * C;
  for (int r = 0; r < 16; ++r) p0[r] = fmaf(p0[r], C, mnC); for (int r = 0; r < 16; ++r) p1[r] = fmaf(p1[r], C, mnC);
  for (int r = 0; r < 16; ++r) p0[r] = __builtin_amdgcn_exp2f(p0[r]);
}
__device__ __forceinline__ void finishSM(f32x16& p0, f32x16& p1, float alpha, float& l_reg, bf16x8& pa0, bf16x8& pa1, bf16x8& pa2, bf16x8& pa3) {
  for (int r = 0; r < 16; ++r) p1[r] = __builtin_amdgcn_exp2f(p1[r]);
  float ps = 0; for (int r = 0; r < 16; ++r) ps += p0[r]; for (int r = 0; r < 16; ++r) ps += p1[r];
  { auto rr = __builtin_amdgcn_permlane32_swap(__float_as_uint(ps), __float_as_uint(ps), false, false);
    ps = __uint_as_float(rr[0]) + __uint_as_float(rr[1]); }
  l_reg = l_reg * alpha + ps;
#define PK4(P, BASE, OUT) do { unsigned a0 = cvtpk(P[BASE + 0], P[BASE + 1]), a1 = cvtpk(P[BASE + 2], P[BASE + 3]);   \
    unsigned b0 = cvtpk(P[BASE + 4], P[BASE + 5]), b1 = cvtpk(P[BASE + 6], P[BASE + 7]);                              \
    auto r0 = __builtin_amdgcn_permlane32_swap(a0, b0, false, false); auto r1 = __builtin_amdgcn_permlane32_swap(a1, b1, false, false); \
    u32x4 w = {r0[0], r1[0], r0[1], r1[1]}; OUT = *reinterpret_cast<bf16x8*>(&w); } while (0)
  PK4(p0, 0, pa0); PK4(p0, 8, pa1); PK4(p1, 0, pa2); PK4(p1, 8, pa3);
#undef PK4
}
__device__ __forceinline__ void qkt(f32x16& p0, f32x16& p1, const bf16* Ks, const bf16x8* qr, int r32, int hi) {
  p0 = f32x16{}; p1 = f32x16{};
  for (int d0 = 0; d0 < 8; ++d0) { int cb = (d0 * 16 + hi * 8) * 2;
    bf16x8 b0 = *reinterpret_cast<const bf16x8*>((const char*)Ks + KSWZ(r32, cb));
    bf16x8 b1 = *reinterpret_cast<const bf16x8*>((const char*)Ks + KSWZ(32 + r32, cb));
    p0 = __builtin_amdgcn_mfma_f32_32x32x16_bf16(b0, qr[d0], p0, 0, 0, 0);
    p1 = __builtin_amdgcn_mfma_f32_32x32x16_bf16(b1, qr[d0], p1, 0, 0, 0); }
}
__device__ __forceinline__ int v_st(int k, int c) { const int kk = (k & ~0xC) | ((k & 4) << 1) | ((k & 8) >> 1); return ((kk >> 3) * 4 + (c >> 5)) * 512 + ((kk & 7) * 32 + (c & 31)) * 2; }
__device__ __forceinline__ int v_rd_base(int lane) { return ((lane & 3) << 3) | (((lane >> 2) & 3) << 6) | (((lane >> 4) & 1) << 5) | (((lane >> 5) & 1) << 8); }
constexpr int v_rd_off(int d0, int ks, int half) { return d0 * 512 + ks * 4096 + half * 2048; }
template <int OFF> __device__ __forceinline__ s16x4 tr_read(int vb) {
  s16x4 r; asm volatile("ds_read_b64_tr_b16 %0, %1 offset:%2" : "=&v"(r) : "v"(vb), "i"(OFF) : "memory"); return r;
}
template <int D0> __device__ __forceinline__ void pv_one(f32x16& od, int vb, bf16x8 pa0, bf16x8 pa1, bf16x8 pa2, bf16x8 pa3) {
  const s16x4 l0 = tr_read<v_rd_off(D0, 0, 0)>(vb), h0 = tr_read<v_rd_off(D0, 0, 1)>(vb), l1 = tr_read<v_rd_off(D0, 1, 0)>(vb), h1 = tr_read<v_rd_off(D0, 1, 1)>(vb);
  const s16x4 l2 = tr_read<v_rd_off(D0, 2, 0)>(vb), h2 = tr_read<v_rd_off(D0, 2, 1)>(vb), l3 = tr_read<v_rd_off(D0, 3, 0)>(vb), h3 = tr_read<v_rd_off(D0, 3, 1)>(vb);
  asm volatile("s_waitcnt lgkmcnt(0)" ::: "memory"); SBAR();
#define PK(L, H) (bf16x8){L[0], L[1], L[2], L[3], H[0], H[1], H[2], H[3]}
  od = __builtin_amdgcn_mfma_f32_32x32x16_bf16(pa0, PK(l0, h0), od, 0, 0, 0);
  od = __builtin_amdgcn_mfma_f32_32x32x16_bf16(pa1, PK(l1, h1), od, 0, 0, 0);
  od = __builtin_amdgcn_mfma_f32_32x32x16_bf16(pa2, PK(l2, h2), od, 0, 0, 0);
  od = __builtin_amdgcn_mfma_f32_32x32x16_bf16(pa3, PK(l3, h3), od, 0, 0, 0);
#undef PK
}
__device__ __forceinline__ void pv_d0(f32x16* o, int vb, bf16x8 pa0, bf16x8 pa1, bf16x8 pa2, bf16x8 pa3) {
  pv_one<0>(o[0], vb, pa0, pa1, pa2, pa3); pv_one<1>(o[1], vb, pa0, pa1, pa2, pa3); pv_one<2>(o[2], vb, pa0, pa1, pa2, pa3); pv_one<3>(o[3], vb, pa0, pa1, pa2, pa3);
}
__device__ __forceinline__ void attn_dense_body(const bf16* __restrict__ Qb, const bf16* __restrict__ Kh, const bf16* __restrict__ Vh,
                                                bf16* __restrict__ Ob, int seq, char* lds, const int tid) {
  const int wid = tid >> 6, lane = tid & 63, r32 = lane & 31, hi = lane >> 5;
  bf16* V_lds = (bf16*)lds; bf16* K_lds = (bf16*)(lds + 2 * SHM_V);
  float* ws = (float*)(lds + 2 * SHM_V + 2 * SHM_K) + wid * 64; float* li_l = ws; float* al_l = ws + 32;
  float m_reg = -1e30f, l_reg = 0; f32x16 o[4] = {}; bf16x8 qr[8];
  const bf16* Qw = Qb + (long)(wid * QBLK + r32) * LDQ + hi * 8;
#pragma unroll
  for (int d0 = 0; d0 < 8; ++d0) qr[d0] = *reinterpret_cast<const bf16x8*>(Qw + d0 * 16);
  const int sr = tid >> 4, sc = (tid & 15) * 8, vst0 = v_st(sr, sc), vst1 = v_st(32 + sr, sc);
  const int vb0 = (int)(uintptr_t)V_lds + v_rd_base(lane);
  struct { bf16x8 vs0, vs1, ks0, ks1; } sr_[1];
#define SLOAD(i, k0) do { sr_[i].vs0 = *reinterpret_cast<const bf16x8*>(&Vh[(long)((k0) + sr) * LDK + sc]); sr_[i].vs1 = *reinterpret_cast<const bf16x8*>(&Vh[(long)((k0) + 32 + sr) * LDK + sc]); \
    sr_[i].ks0 = *reinterpret_cast<const bf16x8*>(&Kh[(long)((k0) + sr) * LDK + sc]); sr_[i].ks1 = *reinterpret_cast<const bf16x8*>(&Kh[(long)((k0) + 32 + sr) * LDK + sc]); } while (0)
#define SWRITE(b, i) do { *(bf16x8*)((char*)V_lds + (b) * SHM_V + vst0) = sr_[i].vs0;          \
    *(bf16x8*)((char*)V_lds + (b) * SHM_V + vst1) = sr_[i].vs1; int kc = sc * 2;               \
    *(bf16x8*)((char*)K_lds + (b) * SHM_K + KSWZ(sr, kc)) = sr_[i].ks0;                       \
    *(bf16x8*)((char*)K_lds + (b) * SHM_K + KSWZ(32 + sr, kc)) = sr_[i].ks1; } while (0)
#define SWAIT() asm volatile("s_waitcnt vmcnt(0)" ::: "memory")
#define RESC(a) do { if (__any((a) < 1.f)) { if (hi == 0) al_l[r32] = (a); asm volatile("s_waitcnt lgkmcnt(0)" ::: "memory"); \
    for (int d = 0; d < 4; ++d) for (int r = 0; r < 16; ++r) o[d][r] *= al_l[crow(r, hi)]; } } while (0)
  f32x16 pA0, pA1, pB0, pB1; float mnA, mnB, alA, alB; bf16x8 pa0, pa1, pa2, pa3; const int NT = seq / KVBLK;
  constexpr int SE = 0, SO = 0;
  SLOAD(SE, 0); asm volatile("s_waitcnt vmcnt(0)" ::: "memory"); SWRITE(0, SE); __syncthreads();
  qkt(pA0, pA1, K_lds, qr, r32, hi); partialSM(pA0, pA1, m_reg, mnA, alA);
  SLOAD(SO, KVBLK);
  SWAIT(); SWRITE(1, SO); __syncthreads();
  for (int j = 1; j + 1 < NT; j += 2) {
    SBAR(); qkt(pB0, pB1, (bf16*)((char*)K_lds + SHM_K), qr, r32, hi);
    finishSM(pA0, pA1, alA, l_reg, pa0, pa1, pa2, pa3); SBAR();
    SLOAD(SO, (j + 1) * KVBLK); SBAR();
    pv_d0(o, vb0, pa0, pa1, pa2, pa3); partialSM(pB0, pB1, m_reg, mnB, alB);
    __syncthreads(); SWAIT(); SWRITE(0, SE);
    RESC(alB); __syncthreads();
    SBAR(); qkt(pA0, pA1, K_lds, qr, r32, hi);
    finishSM(pB0, pB1, alB, l_reg, pa0, pa1, pa2, pa3); SBAR();
    SLOAD(SE, (j + 2) * KVBLK); SBAR();
    pv_d0(o, vb0 + (int)SHM_V, pa0, pa1, pa2, pa3); partialSM(pA0, pA1, m_reg, mnA, alA);
    __syncthreads(); SWAIT(); SWRITE(1, SO);
    RESC(alA); __syncthreads();
  }
  SBAR(); qkt(pB0, pB1, (bf16*)((char*)K_lds + SHM_K), qr, r32, hi);
  finishSM(pA0, pA1, alA, l_reg, pa0, pa1, pa2, pa3); SBAR();
  pv_d0(o, vb0, pa0, pa1, pa2, pa3); partialSM(pB0, pB1, m_reg, mnB, alB);
  __syncthreads(); RESC(alB);
  finishSM(pB0, pB1, alB, l_reg, pa0, pa1, pa2, pa3); SBAR();
  pv_d0(o, vb0 + (int)SHM_V, pa0, pa1, pa2, pa3);
  if (hi == 0) li_l[r32] = l_reg; asm volatile("s_waitcnt lgkmcnt(0)" ::: "memory");
  float rli[16];
#pragma unroll
  for (int r = 0; r < 16; ++r) rli[r] = __builtin_amdgcn_rcpf(li_l[crow(r, hi)]);
  unsigned short* Ow = (unsigned short*)Ob + (long)(wid * QBLK) * LDO;
#pragma unroll
  for (int r = 0; r < 16; ++r) { int orow = crow(r, hi);
    for (int d0 = 0; d0 < 4; ++d0) { const unsigned pk = cvtpk(o[d0][r] * rli[r], 0.f); Ow[(long)orow * LDO + d0 * 32 + r32] = (unsigned short)(pk & 0xffffu); } }
  __syncthreads();
#undef SLOAD
#undef SWRITE
#undef SWAIT
#undef RESC
}
#undef KSWZ
#undef SBAR
}

constexpr int NWAVES = 8;
constexpr int DM = 1024, NB = 8, SEQ = 2048, CTXL = 256, NLAT = NB * SEQ, NCTX = NB * CTXL, NTOK = NLAT + NCTX;
constexpr int DEPTH = 4, MODW = 6 * DM;
constexpr float EPS = 1e-6f;
constexpr int SGUW = 2048, NEXP = 16384, KVROWS = SEQ + CTXL;

constexpr size_t MiB = 1u << 20;
constexpr size_t WS_CTL = 0, CTL_ZERO_BYTES = 1 * MiB;
constexpr size_t WS_MOD = 1 * MiB;
constexpr size_t WS_SS = 2 * MiB;
constexpr size_t WS_X = 4 * MiB;
constexpr size_t WS_W8IN = 56 * MiB, WS_SW8 = 53 * MiB;
constexpr size_t WS_WPQ8 = 44 * MiB, WS_SWQ = 52 * MiB;
constexpr size_t WS_H = 76 * MiB;
constexpr size_t WS_Z = 112 * MiB;
constexpr size_t WS_G = 256 * MiB;
constexpr size_t WS_SG = 328 * MiB;
constexpr size_t WS_WSGUIN = 346 * MiB;
constexpr size_t WS_WSGUOUT = 362 * MiB;
constexpr size_t WS_WPOOLIN = 370 * MiB, WS_WPOOLOUT = 372 * MiB, WS_WGRP = 374 * MiB, WS_WQKV = 375 * MiB, WS_WO = 378 * MiB;
constexpr size_t WS_WPQ = 380 * MiB;
constexpr size_t WS_KB = 396 * MiB;
constexpr size_t WS_TU = 400 * MiB;
constexpr size_t WS_TV = 464 * MiB;
constexpr size_t WS_SU = 528 * MiB, WS_SV = 529 * MiB;
constexpr size_t WS_IDX = 530 * MiB;
constexpr size_t WS_SHQ = 539 * MiB;
constexpr size_t WS_H8 = 540 * MiB;
constexpr size_t WS_END = 558 * MiB;
constexpr int CW_BAR = 4096;

constexpr int RING_BYTES = 131072;
constexpr int LDSCTL_OFF = RING_BYTES, MISC_OFF = LDSCTL_OFF + 320, WSLOT_OFF = LDSCTL_OFF + 1024;
constexpr int LDS_BYTES = 147456;

#define GAS __attribute__((address_space(1)))
#define LAS __attribute__((address_space(3)))
typedef unsigned short bf16;
typedef unsigned v4u __attribute__((ext_vector_type(4)));
typedef unsigned v2u __attribute__((ext_vector_type(2)));
typedef float f32x4 __attribute__((ext_vector_type(4)));
typedef short bf16x8 __attribute__((ext_vector_type(8)));
typedef __bf16 bf2 __attribute__((ext_vector_type(2)));
#define LDS_WAIT() asm volatile("s_waitcnt lgkmcnt(0)" ::: "memory")
__device__ __forceinline__ unsigned f2bf(float f) { unsigned u = __builtin_bit_cast(unsigned, f); return (u + 0x7fffu + ((u >> 16) & 1u)) >> 16; }
__device__ __forceinline__ unsigned pk2(float lo, float hi) { return pg8::cvt_pk_bf16(lo, hi); }
__device__ __forceinline__ float dot2bf(unsigned a, unsigned b, float c) { asm("v_dot2c_f32_bf16 %0, %1, %2" : "+v"(c) : "v"(a), "v"(b)); return c; }
typedef _Float16 h2_t __attribute__((ext_vector_type(2)));
__device__ __forceinline__ unsigned h2u(h2_t v) { return __builtin_bit_cast(unsigned, v); }
__device__ __forceinline__ h2_t u2h(unsigned v) { return __builtin_bit_cast(h2_t, v); }
__device__ __forceinline__ float bflo(unsigned u) { return __uint_as_float(u << 16); }
__device__ __forceinline__ float bfhi(unsigned u) { return __uint_as_float(u & 0xffff0000u); }

#define XB_TMO      128
#define XB_XCNT(j)  (256  + 64 * (j))
#define XB_XSUB(j)  (1280 + 64 * (j))
#define XB_XGEN(j)  (2304 + 64 * (j))
#define XB_TOP      3328
#define XB_TOPGEN   3392
#define XCD_BAR_WORDS 3456
#define XB_SPIN_CAP (1u << 22)
__device__ __forceinline__ unsigned xb_ld(unsigned* p)              { return __hip_atomic_load(p, __ATOMIC_RELAXED, __HIP_MEMORY_SCOPE_AGENT); }
__device__ __forceinline__ unsigned xb_add(unsigned* p, unsigned v) { return __hip_atomic_fetch_add(p, v, __ATOMIC_RELAXED, __HIP_MEMORY_SCOPE_AGENT); }
__device__ __forceinline__ unsigned xb_xcc_id() { return (unsigned)__builtin_amdgcn_s_getreg((3 << 11) | 20) & 0xFu; }
#define XB_SPIN(cond, bar) do { unsigned _sp = 0; while (cond) { __builtin_amdgcn_s_sleep(1); \
    if ((++_sp & 255u) == 0u) { if (xb_ld(&(bar)[XB_TMO])) break; if (_sp > XB_SPIN_CAP) { atomicAdd(&(bar)[XB_TMO], 1u); break; } } } } while (0)
struct XcdBarrier { unsigned* bar; unsigned x; volatile LAS unsigned* st; };
__device__ __forceinline__ XcdBarrier xcd_barrier_post(unsigned* bar, volatile LAS unsigned* st) {
    XcdBarrier b; b.bar = bar; b.x = xb_xcc_id(); b.st = st;
    if (threadIdx.x == 0) (void)xb_add(&bar[XB_XCNT(b.x)], 1u);
    return b;
}
__device__ __forceinline__ void xcd_barrier_complete(unsigned* bar, unsigned x, unsigned& nloc, unsigned& nx) {
    const unsigned G = gridDim.x * gridDim.y * gridDim.z;
    unsigned sum, cnt, mine, sp = 0u;
    for (;;) {
        sum = 0u; cnt = 0u; mine = 0u;
#pragma unroll
        for (unsigned j = 0; j < 16; ++j) { const unsigned c = xb_ld(&bar[XB_XCNT(j)]); sum += c; cnt += (c > 0u) ? 1u : 0u; mine = (j == x) ? c : mine; }
        if (sum == G) break;
        __builtin_amdgcn_s_sleep(1);
        if ((++sp & 255u) == 0u) { if (xb_ld(&bar[XB_TMO])) break; if (sp > XB_SPIN_CAP) { atomicAdd(&bar[XB_TMO], 1u); break; } }
    }
    nloc = mine > 0u ? mine : 1u; nx = cnt > 0u ? cnt : 1u;
}
__device__ __forceinline__ void xcd_barrier(const XcdBarrier& b, const int tid) {
    asm volatile("s_waitcnt vmcnt(0)" ::: "memory");
    __syncthreads();
    if (tid == 0) {
        unsigned* bar = b.bar;
        __builtin_amdgcn_s_waitcnt(0);
        unsigned nloc = b.st[0], nx = b.st[1];
        if (nloc == 0u) { xcd_barrier_complete(bar, b.x, nloc, nx); b.st[0] = nloc; b.st[1] = nx; }
        const unsigned old = xb_add(&bar[XB_XSUB(b.x)], 1u);
        const unsigned gen = old / nloc;
        if (old + 1u == (gen + 1u) * nloc) {
            __builtin_amdgcn_fence(__ATOMIC_RELEASE, "agent");
            asm volatile("s_waitcnt vmcnt(0)" ::: "memory");
            const unsigned og = xb_add(&bar[XB_TOP], 1u);
            const unsigned tg = og / nx;
            if (og + 1u == (tg + 1u) * nx) xb_add(&bar[XB_TOPGEN], 1u);
            else XB_SPIN(xb_ld(&bar[XB_TOPGEN]) == tg, bar);
            __builtin_amdgcn_fence(__ATOMIC_ACQUIRE, "agent");
            xb_add(&bar[XB_XGEN(b.x)], 1u);
            asm volatile("s_waitcnt vmcnt(0)" ::: "memory");
        } else {
            XB_SPIN(xb_ld(&bar[XB_XGEN(b.x)]) == gen, bar);
            __builtin_amdgcn_fence(__ATOMIC_ACQUIRE, "agent");
            asm volatile("s_waitcnt vmcnt(0)" ::: "memory");
        }
    }
    __syncthreads();
}

enum { I_X = 0, I_C, I_CTX, I_CCTX, I_ADAW, I_ADAB, I_N1G, I_N2G, I_SGU_WIN, I_SGU_VG, I_SGU_WS, I_SGU_BS, I_SGU_WOUT, I_POOL_WIN, I_POOL_WGRP, I_POOL_SCALE, I_POOL_WOUT,
       I_ATT_WQKV, I_ATT_QG, I_ATT_KG, I_ATT_WO, I_PEER_WQ, I_PEER_K1, I_PEER_K2, I_PEER_U, I_PEER_V, I_FINAL_G, N_IN };
struct Args { const float* in[N_IN]; float* out; unsigned char* ws; int lo, hi; };
typedef const __attribute__((address_space(4))) Args* KArgs;
#define ws_ (A->ws)

struct Frame {
    LAS unsigned char* lds;
    int tid, lane, wave, vcu, G, bx;
};

__device__ __forceinline__ float wave_sum(float v) {
    v += shx<1>(v); v += shx<2>(v); v += shx<4>(v); v += shx<8>(v); v += shx<16>(v);
    { auto r = __builtin_amdgcn_permlane32_swap(__float_as_uint(v), __float_as_uint(v), false, false); v = __uint_as_float(r[0]) + __uint_as_float(r[1]); }
    return v;
}

__device__ __forceinline__ void p0_transpose_item(const float* W, int K, int N, bf16* WT, LAS float* scr, int item, int lane) {
    const int nblk = N / 32, kb = item / nblk, nb = item % nblk, k0 = 64 * kb, n0 = 32 * nb;
    float tv[32];
#pragma unroll
    for (int i = 0; i < 32; ++i) { const int kk = 2 * i + (lane >> 5); tv[i] = W[(size_t)(k0 + kk) * N + n0 + (lane & 31)]; }
#pragma unroll
    for (int i = 0; i < 32; ++i) { const int kk = 2 * i + (lane >> 5); scr[kk * 33 + (lane & 31)] = tv[i]; }
    LDS_WAIT(); asm volatile("" ::: "memory");
    const int c = lane & 7;
#pragma unroll
    for (int j = 0; j < 4; ++j) { const int n = (lane >> 3) + 8 * j; const LAS float* s = scr + (8 * c) * 33 + n;
        v4u o; o.x = pk2(s[0 * 33], s[1 * 33]); o.y = pk2(s[2 * 33], s[3 * 33]); o.z = pk2(s[4 * 33], s[5 * 33]); o.w = pk2(s[6 * 33], s[7 * 33]);
        *(v4u*)(WT + (size_t)(n0 + n) * K + k0 + 8 * c) = o; }
    LDS_WAIT(); asm volatile("" ::: "memory");
}
__device__ __forceinline__ float silu(float v) { return v / (1.f + __expf(-v)); }

constexpr int TAB_ITEMS_PER_LAYER = 2 * NEXP / 4;
__device__ __forceinline__ void tables_item(Frame& F, KArgs A, int row0) {
        const bool isU = row0 < DEPTH * NEXP; const int r0 = isU ? row0 : row0 - DEPTH * NEXP;
        const float* sp = (isU ? A->in[I_PEER_U] : A->in[I_PEER_V]) + (size_t)r0 * DM;
        f32x4 v[4][4];
#pragma unroll
        for (int q = 0; q < 4; ++q)
#pragma unroll
            for (int j = 0; j < 4; ++j) v[q][j] = __builtin_nontemporal_load((const f32x4*)(sp + (size_t)q * DM) + F.lane + 64 * j);
        float ssq[4];
#pragma unroll
        for (int q = 0; q < 4; ++q) { float ss = 0.f;
#pragma unroll
            for (int j = 0; j < 4; ++j) ss += (v[q][j].x * v[q][j].x + v[q][j].y * v[q][j].y) + (v[q][j].z * v[q][j].z + v[q][j].w * v[q][j].w);
            ssq[q] = ss; }
        float inv4[4];
        { const bool c0 = F.lane & 1, c1 = F.lane & 2;
          const float t0 = (c0 ? ssq[1] : ssq[0]) + shx<1>(c0 ? ssq[0] : ssq[1]), t1 = (c0 ? ssq[3] : ssq[2]) + shx<1>(c0 ? ssq[2] : ssq[3]);
          float u = (c1 ? t1 : t0) + shx<2>(c1 ? t0 : t1);
          u += shx<4>(u); u += shx<8>(u);
          { auto r = __builtin_amdgcn_permlane16_swap(__float_as_uint(u), __float_as_uint(u), false, false); u = __uint_as_float(r[0]) + __uint_as_float(r[1]); }
          { auto r = __builtin_amdgcn_permlane32_swap(__float_as_uint(u), __float_as_uint(u), false, false); u = __uint_as_float(r[0]) + __uint_as_float(r[1]); }
          const float iv = __builtin_amdgcn_rsqf(fmaxf(u * (1.f / DM), 1e-30f)) * (1.f / 0.3352f);
          inv4[0] = __uint_as_float((unsigned)__builtin_amdgcn_mov_dpp((int)__float_as_uint(iv), 0x00, 0xf, 0xf, true)); inv4[1] = __uint_as_float((unsigned)__builtin_amdgcn_mov_dpp((int)__float_as_uint(iv), 0x55, 0xf, 0xf, true));
          inv4[2] = __uint_as_float((unsigned)__builtin_amdgcn_mov_dpp((int)__float_as_uint(iv), 0xAA, 0xf, 0xf, true)); inv4[3] = __uint_as_float((unsigned)__builtin_amdgcn_mov_dpp((int)__float_as_uint(iv), 0xFF, 0xf, 0xf, true)); }
        {
            const int lyr = r0 >> 14;
            unsigned char* tb4 = ws_ + (isU ? WS_TU : WS_TV) + (size_t)lyr * NEXP * 512;
            const unsigned bias = isU ? 0x8888u : 0x8080u;
#pragma unroll
            for (int q = 0; q < 4; ++q) { const int e = (r0 + q) & (NEXP - 1);
                const float inv = inv4[q];
#pragma unroll
                for (int j = 0; j < 4; ++j) { unsigned w = 0u;
#pragma unroll
                    for (int i = 0; i < 4; ++i) { const float t = __builtin_fminf(__builtin_fmaxf(v[q][j][i] * inv + 8.f, 0.f), 15.5f); w |= (unsigned)t << (4 * i); }
                    *(unsigned short*)(tb4 + (size_t)j * (NEXP * 128) + (size_t)e * 128 + 2 * F.lane) = (unsigned short)(w ^ bias); }
                if (F.lane == 0) ((float*)(ws_ + (isU ? WS_SU : WS_SV)))[r0 + q] = __builtin_amdgcn_rcpf(inv); }
        }
}
__device__ __forceinline__ void op_tables(Frame& F, KArgs A, int item_lo, int item_hi, int w, int nw) {
    for (int item = item_lo + w; item < item_hi; item += nw) {
        const int layer = item / TAB_ITEMS_PER_LAYER, rem = item % TAB_ITEMS_PER_LAYER, t = rem / (NEXP / 4), rg = rem % (NEXP / 4);
        tables_item(F, A, t * DEPTH * NEXP + layer * NEXP + rg * 4);
    }
}

__device__ __forceinline__ void op_prep(Frame& F, KArgs A) {
    unsigned char* ws = ws_;
    for (int rep_ = 0; rep_ < 1 + ((PREPREP >> 0) & 1); ++rep_) {
        LAS float* S = (LAS float*)F.lds;
        LAS float* Pp = (LAS float*)(F.lds + 40960);
        for (int e = F.tid; e < 9 * 1024; e += NWAVES * 64) { const int r = e >> 10, k = e & 1023; S[e] = silu(r < 8 ? A->in[I_C][r * 1024 + k] : A->in[I_CCTX][k]); }
        __syncthreads();
        for (int task = F.vcu; task < DEPTH * 48; task += F.G) {
            const int i = task / 48, cg = task % 48, col = cg * 128 + 2 * F.lane;
            const float* W = A->in[I_ADAW] + (size_t)i * 1024 * MODW + col;
            float acc[9][2];
#pragma unroll
            for (int r = 0; r < 9; ++r) { acc[r][0] = 0.f; acc[r][1] = 0.f; }
            const int k0 = F.wave * 128;
#pragma unroll 1
            for (int kb = k0; kb < k0 + 128; kb += 32) {
                pg8::f32x2 wv[32];
#pragma unroll
                for (int i = 0; i < 32; ++i) wv[i] = __builtin_nontemporal_load((const pg8::f32x2*)(W + (size_t)(kb + i) * MODW));
                __builtin_amdgcn_sched_barrier(0);
#pragma unroll
                for (int i = 0; i < 32; ++i) {
#pragma unroll
                    for (int r = 0; r < 9; ++r) { const float sv = S[r * 1024 + kb + i]; acc[r][0] += sv * wv[i].x; acc[r][1] += sv * wv[i].y; } }
                __builtin_amdgcn_sched_barrier(0);
            }
#pragma unroll
            for (int r = 0; r < 9; ++r) *(LAS pg8::f32x2*)(Pp + (F.wave * 9 + r) * 128 + 2 * F.lane) = (pg8::f32x2){acc[r][0], acc[r][1]};
            __syncthreads();
            for (int e = F.tid; e < 9 * 128; e += NWAVES * 64) { const int r = e >> 7, l = e & 127; float sacc = 0.f;
#pragma unroll
                for (int w = 0; w < 8; ++w) sacc += Pp[(w * 9 + r) * 128 + l];
                const int c2 = cg * 128 + l;
                ((float*)(ws + WS_MOD))[((size_t)i * 9 + r) * MODW + c2] = sacc + A->in[I_ADAB][(size_t)i * MODW + c2]; }
            __syncthreads();
        }
    }
    __syncthreads();
    const int gw = F.vcu * NWAVES + F.wave, NGW = F.G * NWAVES;
    const long gt = (long)F.vcu * (NWAVES * 64) + F.tid, NGT = (long)F.G * NWAVES * 64;
    for (int rep_ = 0; rep_ < 1 + ((PREPREP >> 1) & 1); ++rep_) {
        LAS float* scr = (LAS float*)(F.lds + F.wave * 16384);
        constexpr int IT_SIN = (1024 / 64) * (4096 / 32), IT_SOUT = (2048 / 64) * (1024 / 32), IT_SQ = (1024 / 64) * (1024 / 32), IT_GRP = (256 / 64) * (256 / 32),
                      IT_QKV = (1024 / 64) * (1536 / 32);
        constexpr int NITEMS = 2 * IT_SIN + 2 * IT_SOUT + 2 * IT_SQ + 4 * IT_GRP + IT_QKV + IT_SQ;
        for (int it = gw; it < NITEMS; it += NGW) {
            int r = it;
            if (r < 2 * IT_SIN) { const int j = r / IT_SIN; p0_transpose_item(A->in[I_SGU_WIN] + (size_t)j * 1024 * 4096, 1024, 4096, (bf16*)(ws + WS_WSGUIN) + (size_t)j * 4096 * 1024, scr, r % IT_SIN, F.lane); continue; } r -= 2 * IT_SIN;
            if (r < 2 * IT_SOUT) { const int j = r / IT_SOUT; p0_transpose_item(A->in[I_SGU_WOUT] + (size_t)j * 2048 * 1024, 2048, 1024, (bf16*)(ws + WS_WSGUOUT) + (size_t)j * 1024 * 2048, scr, r % IT_SOUT, F.lane); continue; } r -= 2 * IT_SOUT;
            if (r < IT_SQ) { p0_transpose_item(A->in[I_POOL_WIN], 1024, 1024, (bf16*)(ws + WS_WPOOLIN), scr, r, F.lane); continue; } r -= IT_SQ;
            if (r < IT_SQ) { p0_transpose_item(A->in[I_POOL_WOUT], 1024, 1024, (bf16*)(ws + WS_WPOOLOUT), scr, r, F.lane); continue; } r -= IT_SQ;
            if (r < 4 * IT_GRP) { const int j = r / IT_GRP; p0_transpose_item(A->in[I_POOL_WGRP] + (size_t)j * 65536, 256, 256, (bf16*)(ws + WS_WGRP) + (size_t)j * 65536, scr, r % IT_GRP, F.lane); continue; } r -= 4 * IT_GRP;
            if (r < IT_QKV) { p0_transpose_item(A->in[I_ATT_WQKV], 1024, 1536, (bf16*)(ws + WS_WQKV), scr, r, F.lane); continue; } r -= IT_QKV;
            { p0_transpose_item(A->in[I_ATT_WO], 1024, 1024, (bf16*)(ws + WS_WO), scr, r, F.lane); }
        }
        for (long ch = gt; ch < (long)DEPTH * 1024 * 2048 / 8; ch += NGT) {
            const int d8 = (int)(ch & 31), h = (int)(ch >> 5) & 7, kk = (int)(ch >> 8) & 1023, i = (int)(ch >> 18);
            const float* src = A->in[I_PEER_WQ] + ((size_t)i * 1024 + kk) * 2048 + h * 256 + d8 * 8;
            const f32x4 a = *(const f32x4*)src, b = *(const f32x4*)(src + 4);
            v4u o; o.x = pk2(a[0], a[1]); o.y = pk2(a[2], a[3]); o.z = pk2(b[0], b[1]); o.w = pk2(b[2], b[3]);
            *(v4u*)((bf16*)(ws + WS_G) + (((size_t)(i * 8 + h) * 1024 + kk) * 256 + d8 * 8)) = o;
        }
    }
    for (long ch = gt; ch < (long)DEPTH * 8 * 256 * 32; ch += NGT) {
        const int d0 = (int)(ch & 31) * 8, n = (int)(ch >> 5) & 255, ih = (int)(ch >> 13);
        v4u o = {0u, 0u, 0u, 0u};
        const float* src = nullptr;
        if (n < 128 && d0 < 128) src = A->in[I_PEER_K1] + ((size_t)ih * 128 + n) * 128 + d0;
        else if (n >= 128 && d0 >= 128) src = A->in[I_PEER_K2] + ((size_t)ih * 128 + (n - 128)) * 128 + (d0 - 128);
        if (src) { const f32x4 a = *(const f32x4*)src, b = *(const f32x4*)(src + 4); o.x = pk2(a[0], a[1]); o.y = pk2(a[2], a[3]); o.z = pk2(b[0], b[1]); o.w = pk2(b[2], b[3]); }
        *(v4u*)((bf16*)(ws + WS_KB) + ch * 8) = o;
    }
    for (int rep_ = 0; rep_ < 1 + ((PREPREP >> 3) & 1); ++rep_) {
        op_tables(F, A, 0, TAB_ITEMS_PER_LAYER, gw, NGW);
        if (F.G != 256) op_tables(F, A, TAB_ITEMS_PER_LAYER, 4 * TAB_ITEMS_PER_LAYER, gw, NGW);
    }
}

__device__ __forceinline__ float wave_max_nn(float v) {
    unsigned m = __float_as_uint(v);
    m = max(m, (unsigned)__builtin_amdgcn_update_dpp(0, (int)m, 0xB1, 0xf, 0xf, false));
    m = max(m, (unsigned)__builtin_amdgcn_update_dpp(0, (int)m, 0x4E, 0xf, 0xf, false));
    m = max(m, (unsigned)__builtin_amdgcn_update_dpp(0, (int)m, 0x141, 0xf, 0xf, false));
    m = max(m, (unsigned)__builtin_amdgcn_update_dpp(0, (int)m, 0x140, 0xf, 0xf, false));
    { auto r = __builtin_amdgcn_permlane16_swap(m, m, false, false); m = max(r[0], r[1]); }
    { auto r = __builtin_amdgcn_permlane32_swap(m, m, false, false); m = max(r[0], r[1]); }
    return __uint_as_float(m);
}
__device__ __forceinline__ unsigned xadd16(unsigned x, unsigned y) { auto r = __builtin_amdgcn_permlane16_swap(x, y, false, false); return r[0] + r[1]; }
__device__ __forceinline__ unsigned xadd32(unsigned x, unsigned y) { auto r = __builtin_amdgcn_permlane32_swap(x, y, false, false); return r[0] + r[1]; }
__device__ __forceinline__ float wave_max(float v) {
    v = fmaxf(v, shx<1>(v)); v = fmaxf(v, shx<2>(v)); v = fmaxf(v, shx<4>(v)); v = fmaxf(v, shx<8>(v)); v = fmaxf(v, shx<16>(v));
    { auto r = __builtin_amdgcn_permlane32_swap(__float_as_uint(v), __float_as_uint(v), false, false); v = fmaxf(__uint_as_float(r[0]), __uint_as_float(r[1])); }
    return v;
}
__device__ __forceinline__ void op_modulate(Frame& F, KArgs A, const float* srcLat, const float* srcCtx, const bf16* srcX, const float* gain, const float* modl, int ch_shift, int nrows, bool fin, bool hq = false) {
    const int gw = F.vcu * NWAVES + F.wave, NGW = F.G * NWAVES;
    bf16* H = (bf16*)(ws_ + WS_H);
    v2u xq[4] = {{0u, 0u}, {0u, 0u}, {0u, 0u}, {0u, 0u}}; f32x4 xf[4];
    const int rlast = nrows - 1, RPW = (nrows + NGW - 1) / NGW, rbeg = gw * RPW, rend = min(nrows, rbeg + RPW);
    if (rbeg >= rend) return;
    f32x4 ga[4], sa[4], sb[4]; int mr_cur = -1;
#pragma unroll
    for (int j = 0; j < 4; ++j) ga[j] = *((const f32x4*)gain + F.lane + 64 * j);
    if (srcX) { const v2u* xr = (const v2u*)(srcX + (size_t)rbeg * DM);
#pragma unroll
        for (int j = 0; j < 4; ++j) xq[j] = xr[F.lane + 64 * j]; }
    else { const float* xr = rbeg < NLAT ? srcLat + (size_t)rbeg * DM : srcCtx + (size_t)(rbeg - NLAT) * DM;
#pragma unroll
        for (int j = 0; j < 4; ++j) xf[j] = *((const f32x4*)xr + F.lane + 64 * j); }
    for (int row = rbeg; row < rend; ++row) {
        const int mr = row < NLAT ? (row >> 11) : 8;
        if (!fin && mr != mr_cur) { mr_cur = mr; const float* sh = modl + mr * MODW + ch_shift * DM; const float* sc = sh + DM;
#pragma unroll
            for (int j = 0; j < 4; ++j) { sa[j] = *((const f32x4*)sc + F.lane + 64 * j); sb[j] = *((const f32x4*)sh + F.lane + 64 * j); } }
        f32x4 v[4]; float s = 0.f;
        const int rn = row + 1 < rend ? row + 1 : row;
        if (srcX) {
#pragma unroll
            for (int j = 0; j < 4; ++j) { const v2u q = xq[j]; v[j] = (f32x4){bflo(q.x), bfhi(q.x), bflo(q.y), bfhi(q.y)}; }
            const v2u* xr = (const v2u*)(srcX + (size_t)rn * DM);
#pragma unroll
            for (int j = 0; j < 4; ++j) xq[j] = xr[F.lane + 64 * j];
        } else {
#pragma unroll
            for (int j = 0; j < 4; ++j) v[j] = xf[j];
            const float* xr = rn < NLAT ? srcLat + (size_t)rn * DM : srcCtx + (size_t)(rn - NLAT) * DM;
#pragma unroll
            for (int j = 0; j < 4; ++j) xf[j] = *((const f32x4*)xr + F.lane + 64 * j); }
#pragma unroll
        for (int j = 0; j < 4; ++j) s += (v[j].x * v[j].x + v[j].y * v[j].y) + (v[j].z * v[j].z + v[j].w * v[j].w);
        const float rstd = __builtin_amdgcn_rsqf(wave_sum(s) * (1.f / DM) + EPS);
        if (fin) {
            f32x4* o16 = (f32x4*)(A->out + (size_t)row * DM) + F.lane;
#pragma unroll
            for (int j = 0; j < 4; ++j) o16[64 * j] = v[j] * rstd * ga[j];
            continue;
        }
        float m = 0.f;
#pragma unroll
        for (int j = 0; j < 4; ++j) { const f32x4 g = ga[j], a = sa[j], b = sb[j];
            const f32x4 y = v[j] * rstd * g * (a + 1.f) + b;
            v[j] = y; m = fmaxf(m, fmaxf(fmaxf(fabsf(y[0]), fabsf(y[1])), fmaxf(fabsf(y[2]), fabsf(y[3])))); }
        m = wave_max(m);
        if (!hq) {
            const float inv = m > 0.f ? 127.f / m : 0.f;
            unsigned* h8 = (unsigned*)(ws_ + WS_H) + (size_t)row * 256 + F.lane;
#pragma unroll
            for (int j = 0; j < 4; ++j) { unsigned pq = 0u;
#pragma unroll
                for (int i = 0; i < 4; ++i) { int q = (int)__builtin_rintf(v[j][i] * inv); q = q > 127 ? 127 : (q < -127 ? -127 : q); pq |= ((unsigned)q & 255u) << (8 * i); }
                h8[64 * j] = pq; }
            if (F.lane == 0) ((float*)(ws_ + WS_SHQ))[row] = m * (1.f / 127.f);
        } else {
            const float inv = m > 0.f ? 119.f / m : 0.f;
            unsigned short* hp = (unsigned short*)(ws_ + WS_H8) + (size_t)row * 512 + F.lane;
            unsigned* h8 = (unsigned*)(ws_ + WS_H) + (size_t)row * 256 + F.lane;
#pragma unroll
            for (int j = 0; j < 4; ++j) { unsigned pa = 0u, pb = 0u, pq = 0u;
#pragma unroll
                for (int i = 0; i < 4; ++i) { int q = (int)__builtin_rintf(v[j][i] * inv); q = q > 119 ? 119 : (q < -119 ? -119 : q);
                    const int b = ((q + 8) & 15) - 8, a = (q - b) >> 4; pa |= ((unsigned)a & 15u) << (4 * i); pb |= ((unsigned)b & 15u) << (4 * i); pq |= ((unsigned)q & 255u) << (8 * i); }
                hp[j * 128] = (unsigned short)pa; hp[j * 128 + 64] = (unsigned short)pb; h8[64 * j] = pq; }
            if (F.lane == 0) ((float*)(ws_ + WS_SHQ))[row] = m * (1.f / 119.f);
        }
    }
}

__device__ __forceinline__ void op_quant_rows(Frame& F, KArgs A, size_t src_off, size_t dst_off, size_t step_off, int nrows) {
    const int gw = F.vcu * NWAVES + F.wave, NGW = F.G * NWAVES;
    if (gw >= nrows) return;
    pg8::u32x4 n0, n1;
    { const pg8::u32x4* src = (const pg8::u32x4*)(ws_ + src_off + (size_t)gw * 2048) + 2 * F.lane; n0 = src[0]; n1 = src[1]; }
    for (int row = gw; row < nrows; row += NGW) {
        const pg8::u32x4 p0 = n0, p1 = n1;
        { const int rn = row + NGW < nrows ? row + NGW : row; const pg8::u32x4* src = (const pg8::u32x4*)(ws_ + src_off + (size_t)rn * 2048) + 2 * F.lane; n0 = src[0]; n1 = src[1]; }
        float w[16];
#pragma unroll
        for (int i = 0; i < 4; ++i) { w[2 * i] = bflo(p0[i]); w[2 * i + 1] = bfhi(p0[i]); w[8 + 2 * i] = bflo(p1[i]); w[8 + 2 * i + 1] = bfhi(p1[i]); }
        float m = 0.f;
#pragma unroll
        for (int i = 0; i < 16; ++i) m = fmaxf(m, fabsf(w[i]));
        m = wave_max(m);
        const float inv = m > 0.f ? 127.f / m : 0.f;
        pg8::u32x4 o;
#pragma unroll
        for (int d = 0; d < 4; ++d) { unsigned pq = 0u;
#pragma unroll
            for (int i = 0; i < 4; ++i) { int q = (int)__builtin_rintf(w[4 * d + i] * inv); q = q > 127 ? 127 : (q < -127 ? -127 : q); pq |= ((unsigned)q & 255u) << (8 * i); }
            o[d] = pq; }
        *((pg8::u32x4*)(ws_ + dst_off + (size_t)row * 1024) + F.lane) = o;
        if (F.lane == 0) ((float*)(ws_ + step_off))[row] = m * (1.f / 127.f);
    }
}

__device__ __forceinline__ void op_spatial(Frame& F, KArgs A, int j, int nrows) {
    const float* Ws = A->in[I_SGU_WS] + (size_t)j * 8 * 128 * 128; const float* vgain = A->in[I_SGU_VG] + (size_t)j * SGUW; const float* bs = A->in[I_SGU_BS] + (size_t)j * 8 * 128;
    const bf16* ZU = (const bf16*)(ws_ + WS_Z); const bf16* VT = ZU + (size_t)NTOK * SGUW; bf16* GT = (bf16*)(ws_ + WS_G); const float* SS = (const float*)(ws_ + WS_SS);
    LAS unsigned char* lA = F.lds;
    LAS unsigned char* lB = F.lds + 34816;
    LAS float* lR = (LAS float*)(F.lds + 34816 + 69632);
    const int nunits = (nrows / 128) * 8;
    const int wr = F.wave >> 2, wc = F.wave & 3, fr = F.lane & 15, fq = F.lane >> 4;
    int u = F.vcu;
    if (u >= nunits) return;
    const int g = u & 7;
    if ((F.G & 7) != 0) {
    }
    const unsigned tid = (unsigned)F.tid;
    f32x4 wsr[4][2];
#pragma unroll
    for (int it = 0; it < 4; ++it) { const unsigned e = it * 512u + tid, p = e >> 4, q0 = (e & 15u) * 8u; const float* sp = Ws + ((size_t)g * 128 + p) * 128 + q0; wsr[it][0] = *(const f32x4*)sp; wsr[it][1] = *(const f32x4*)(sp + 4); }
    const unsigned erow = tid >> 5, d0 = (tid & 31u) * 8u;
    const f32x4 vg0 = *(const f32x4*)(vgain + g * 256 + d0), vg1 = *(const f32x4*)(vgain + g * 256 + d0 + 4);
    float bsr[8];
#pragma unroll
    for (int ps = 0; ps < 8; ++ps) bsr[ps] = bs[g * 128 + ps * 16 + erow];
    v4u breg[8];
#define SP_PREFETCH(uu) do { const int _c = (uu) >> 3, _g = (uu) & 7; \
        _Pragma("unroll") for (int it = 0; it < 8; ++it) { const unsigned e = it * 512u + tl, d = e >> 4, q0 = (e & 15u) * 8u; breg[it] = *(const v4u*)(VT + (size_t)(_g * 256 + d) * NTOK + _c * 128 + q0); } } while (0)
    unsigned tl = tid; asm volatile("" : "+v"(tl));
    SP_PREFETCH(u);
    for (; u < nunits; u += F.G) {
        const int c = u >> 3;
        tl = tid; asm volatile("" : "+v"(tl));
        { float ssr[4];
#pragma unroll
          for (int sl = 0; sl < 4; ++sl) ssr[sl] = SS[(size_t)((tl >> 7) * 4 + sl) * NTOK + c * 128 + (tl & 127u)];
          lR[128 + tid] = (ssr[0] + ssr[1]) + (ssr[2] + ssr[3]); }
        __syncthreads();
        if (tid < 128u) lR[tid] = __builtin_amdgcn_rsqf((((lR[128 + tid] + lR[256 + tid]) + lR[384 + tid]) + lR[512 + tid]) * (1.f / SGUW) + EPS);
        __syncthreads();
#pragma unroll
        for (int it = 0; it < 4; ++it) { const unsigned e = it * 512u + tid, p = e >> 4, q0 = (e & 15u) * 8u; const f32x4 a = wsr[it][0], bq = wsr[it][1];
            v4u o; o.x = pk2(a[0] * lR[q0], a[1] * lR[q0 + 1]); o.y = pk2(a[2] * lR[q0 + 2], a[3] * lR[q0 + 3]); o.z = pk2(bq[0] * lR[q0 + 4], bq[1] * lR[q0 + 5]); o.w = pk2(bq[2] * lR[q0 + 6], bq[3] * lR[q0 + 7]);
            *(LAS v4u*)(lA + p * 272 + q0 * 2) = o; }
#pragma unroll
        for (int it = 0; it < 8; ++it) { const unsigned e = it * 512u + tid, d = e >> 4, q0 = (e & 15u) * 8u; *(LAS v4u*)(lB + d * 272 + q0 * 2) = breg[it]; }
        __syncthreads();
        { const int un = (u + F.G < nunits) ? u + F.G : u; SP_PREFETCH(un); }
        v4u zu[8];
        const size_t rowbase = (size_t)(c * 128) * SGUW + g * 256 + d0;
#pragma unroll
        for (int ps = 0; ps < 8; ++ps) zu[ps] = *(const v4u*)(ZU + rowbase + (size_t)(ps * 16 + erow) * SGUW);
        f32x4 acc[4][4];
#pragma unroll
        for (int m = 0; m < 4; ++m)
#pragma unroll
            for (int n = 0; n < 4; ++n) acc[m][n] = (f32x4){0.f, 0.f, 0.f, 0.f};
#pragma unroll
        for (int k = 0; k < 4; ++k) {
            bf16x8 af[4], bfr[4];
#pragma unroll
            for (int m = 0; m < 4; ++m) af[m] = *(const LAS bf16x8*)(lA + (wr * 64 + m * 16 + fr) * 272 + (k * 32 + fq * 8) * 2);
#pragma unroll
            for (int n = 0; n < 4; ++n) bfr[n] = *(const LAS bf16x8*)(lB + (wc * 64 + n * 16 + fr) * 272 + (k * 32 + fq * 8) * 2);
#pragma unroll
            for (int m = 0; m < 4; ++m)
#pragma unroll
                for (int n = 0; n < 4; ++n) acc[m][n] = __builtin_amdgcn_mfma_f32_16x16x32_bf16(bfr[n], af[m], acc[m][n], 0, 0, 0);
        }
        __syncthreads();
#pragma unroll
        for (int m = 0; m < 4; ++m)
#pragma unroll
            for (int n = 0; n < 4; ++n) { v2u w; w.x = pk2(acc[m][n][0], acc[m][n][1]); w.y = pk2(acc[m][n][2], acc[m][n][3]);
                *(LAS v2u*)(lB + (wr * 64 + m * 16 + fr) * 528 + (wc * 64 + n * 16 + 4 * fq) * 2) = w; }
        __syncthreads();
#pragma unroll
        for (int ps = 0; ps < 8; ++ps) { const unsigned p = ps * 16u + erow; const v4u sv = *(const LAS v4u*)(lB + p * 528 + d0 * 2); const v4u z = zu[ps]; const float bsv = bsr[ps];
            v4u o;
            o.x = pk2(bflo(z.x) * (bflo(sv.x) * vg0[0] + bsv), bfhi(z.x) * (bfhi(sv.x) * vg0[1] + bsv)); o.y = pk2(bflo(z.y) * (bflo(sv.y) * vg0[2] + bsv), bfhi(z.y) * (bfhi(sv.y) * vg0[3] + bsv));
            o.z = pk2(bflo(z.z) * (bflo(sv.z) * vg1[0] + bsv), bfhi(z.z) * (bfhi(sv.z) * vg1[1] + bsv)); o.w = pk2(bflo(z.w) * (bflo(sv.w) * vg1[2] + bsv), bfhi(z.w) * (bfhi(sv.w) * vg1[3] + bsv));
            *(v4u*)(GT + rowbase + (size_t)p * SGUW) = o; }
    }
#undef SP_PREFETCH
}

__device__ __forceinline__ void op_pool(Frame& F, KArgs A, int nrows) {
    const bf16* ZP = (const bf16*)(ws_ + WS_Z); bf16* P = (bf16*)(ws_ + WS_G);
    const long gt = (long)F.vcu * (NWAVES * 64) + F.tid, NGT = (long)F.G * NWAVES * 64;
    constexpr int RUN = 32;
    for (long e = gt; e < (long)(nrows / RUN) * 128; e += NGT) {
        const int run = (int)(e >> 7), c0 = (int)(e & 127) * 8, g = c0 >> 8, half = 1 << g;
        const int row0 = run * RUN;
        int pos0, L; if (row0 < NLAT) { pos0 = row0 & (SEQ - 1); L = SEQ; } else { pos0 = (row0 - NLAT) & (CTXL - 1); L = CTXL; }
        const bf16* zb = ZP + (size_t)(row0 - pos0) * DM + c0;
        float s[8];
#pragma unroll
        for (int i = 0; i < 8; ++i) s[i] = 0.f;
#define POOL_ACC(sgn, vv) do { const v4u _v = (vv); s[0] += (sgn) * bflo(_v.x); s[1] += (sgn) * bfhi(_v.x); s[2] += (sgn) * bflo(_v.y); s[3] += (sgn) * bfhi(_v.y); \
        s[4] += (sgn) * bflo(_v.z); s[5] += (sgn) * bfhi(_v.z); s[6] += (sgn) * bflo(_v.w); s[7] += (sgn) * bfhi(_v.w); } while (0)
        { v4u wv[16];
#pragma unroll
          for (int w = 0; w < 16; ++w) { const int tc = min(max(pos0 - half + w, 0), L - 1); wv[w] = *(const v4u*)(zb + (size_t)tc * DM); }
          __builtin_amdgcn_sched_barrier(0);
#pragma unroll
          for (int w = 0; w < 16; ++w) { const int t = pos0 - half + w; const bool in = (w < 2 * half) && t >= 0 && t < L; const float f = in ? 1.f : 0.f; POOL_ACC(f, wv[w]); } }
#define POOL_LOADBLK(Z_, VI_, VO_, ib_) do { _Pragma("unroll") for (int k = 0; k < 4; ++k) { const int pos = pos0 + (ib_) * 4 + k; \
            Z_[k] = *(const v4u*)(zb + (size_t)pos * DM); VI_[k] = *(const v4u*)(zb + (size_t)min(pos + half, L - 1) * DM); VO_[k] = *(const v4u*)(zb + (size_t)max(pos - half, 0) * DM); } } while (0)
#define POOL_PROCBLK(Z_, VI_, VO_, ib_) do { _Pragma("unroll") for (int k = 0; k < 4; ++k) { const int i = (ib_) * 4 + k, pos = pos0 + i; \
            const int lo = max(pos - half, 0), hi = min(pos + half, L); const v4u z = Z_[k]; const float ic = 1.f / (float)(hi - lo); \
            v4u o; o.x = pk2(s[0] * ic - bflo(z.x), s[1] * ic - bfhi(z.x)); o.y = pk2(s[2] * ic - bflo(z.y), s[3] * ic - bfhi(z.y)); \
            o.z = pk2(s[4] * ic - bflo(z.z), s[5] * ic - bfhi(z.z)); o.w = pk2(s[6] * ic - bflo(z.w), s[7] * ic - bfhi(z.w)); \
            *(v4u*)(P + (size_t)(row0 + i) * DM + c0) = o; \
              \
            const int tin = pos + half, tout = pos - half; POOL_ACC(tin < L ? 1.f : 0.f, VI_[k]); POOL_ACC(tout >= 0 ? -1.f : 0.f, VO_[k]); } } while (0)
        v4u zA[4], iA[4], oA[4], zB[4], iB[4], oB[4];
        POOL_LOADBLK(zA, iA, oA, 0);
#pragma unroll 1
        for (int ib = 0; ib < RUN / 4; ib += 2) {
            POOL_LOADBLK(zB, iB, oB, ib + 1);
            asm volatile("" ::: "memory");
            POOL_PROCBLK(zA, iA, oA, ib);
            asm volatile("" ::: "memory");
            { const int ibn = ib + 2 < RUN / 4 ? ib + 2 : ib; POOL_LOADBLK(zA, iA, oA, ibn); }
            asm volatile("" ::: "memory");
            POOL_PROCBLK(zB, iB, oB, ib + 1);
            asm volatile("" ::: "memory");
        }
#undef POOL_LOADBLK
#undef POOL_PROCBLK
#undef POOL_ACC
    }
}

__device__ __forceinline__ void op_qknorm(Frame& F, KArgs A, int nrows) {
    const bf16* R = (const bf16*)(ws_ + WS_Z);
    bf16* QB = (bf16*)(ws_ + WS_G); bf16* KBUF = QB + (size_t)NTOK * DM; bf16* VBUF = KBUF + (size_t)NB * KVROWS * 256;
    const float* qg = A->in[I_ATT_QG]; const float* kg = A->in[I_ATT_KG];
    LAS float* tab = (LAS float*)F.lds;
    for (int e = F.tid; e < 64 * 32; e += NWAVES * 64) { const int pos = e >> 5, f = e & 31; const float fr = __expf(-(float)f * (9.210340371976184f / 32.f)); float sn, cs; sincosf((float)pos * fr, &sn, &cs); tab[e * 2] = cs; tab[e * 2 + 1] = sn; }
    __syncthreads();
    const int gw = F.vcu * NWAVES + F.wave, NGW = F.G * NWAVES;
    const int hl = F.lane >> 4, j = F.lane & 15;
    v4u nx[3], nv;
#define QK_FETCH(rw) do { const bf16* _rr = R + (size_t)(rw) * 1536; \
        _Pragma("unroll") for (int ps = 0; ps < 3; ++ps) { const int hd = ps * 4 + hl; nx[ps] = *(const v4u*)(_rr + (hd < 10 ? hd : 9) * 128 + j * 8); } \
        nv = *(const v4u*)(_rr + 1280 + (F.lane & 31) * 8); } while (0)
    f32x4 gq[3][2];
#pragma unroll
    for (int ps = 0; ps < 3; ++ps) { const int hd = ps * 4 + hl; const float* gp = (hd < 8 ? qg : kg) + j * 8; gq[ps][0] = *(const f32x4*)gp; gq[ps][1] = *(const f32x4*)(gp + 4); }
    QK_FETCH(gw < nrows ? gw : nrows - 1);
    for (int row = gw; row < nrows; row += NGW) {
        v4u cx[3], cv;
#pragma unroll
        for (int ps = 0; ps < 3; ++ps) cx[ps] = nx[ps];
        cv = nv;
        QK_FETCH(row + NGW < nrows ? row + NGW : nrows - 1);
        const bool lat = row < NLAT; int b, pos; if (lat) { b = row >> 11; pos = row & (SEQ - 1); } else { b = (row - NLAT) >> 8; pos = (row - NLAT) & (CTXL - 1); }
        const int krow = b * KVROWS + (lat ? pos : SEQ + pos);
#pragma unroll
        for (int pass = 0; pass < 3; ++pass) {
            const int head = pass * 4 + hl;
            const bool act = head < 10;
            float x[8];
            { const v4u v = cx[pass];
              x[0] = bflo(v.x); x[1] = bfhi(v.x); x[2] = bflo(v.y); x[3] = bfhi(v.y); x[4] = bflo(v.z); x[5] = bfhi(v.z); x[6] = bflo(v.w); x[7] = bfhi(v.w); }
            float ss = 0.f;
#pragma unroll
            for (int i = 0; i < 8; ++i) ss += x[i] * x[i];
            ss += shx<1>(ss); ss += shx<2>(ss); ss += shx<4>(ss); ss += shx<8>(ss);
            const float rstd = __builtin_amdgcn_rsqf(ss * (1.f / 128.f) + EPS);
#pragma unroll
            for (int i = 0; i < 8; ++i) x[i] = x[i] * rstd * gq[pass][i >> 2][i & 3];
            float y[8];
#pragma unroll
            for (int i = 0; i < 8; ++i) { const float other = shx<4>(x[i]);
                const int dd = j * 8 + i, f = dd & 31, axis = dd >> 6, second = (dd >> 5) & 1;
                const int p = axis ? (pos & 63) : (pos >> 6);
                const float cs = tab[(p * 32 + f) * 2], sn = tab[(p * 32 + f) * 2 + 1];
                y[i] = lat ? (second ? x[i] * cs + other * sn : x[i] * cs - other * sn) : x[i]; }
            if (act) { v4u o; o.x = pk2(y[0], y[1]); o.y = pk2(y[2], y[3]); o.z = pk2(y[4], y[5]); o.w = pk2(y[6], y[7]);
                if (head < 8) *(v4u*)(QB + (size_t)row * DM + head * 128 + j * 8) = o;
                else *(v4u*)(KBUF + (size_t)krow * 256 + (head - 8) * 128 + j * 8) = o; }
        }
        if (F.lane < 32) *(v4u*)(VBUF + (size_t)krow * 256 + F.lane * 8) = cv;
    }
#undef QK_FETCH
}

__device__ __forceinline__ void op_attn(Frame& F, KArgs A, int nunits) {
    const attn::bf16* QB = (const attn::bf16*)(ws_ + WS_G); const attn::bf16* KBUF = QB + (size_t)NTOK * DM; const attn::bf16* VBUF = KBUF + (size_t)NB * KVROWS * 256;
    attn::bf16* OB = (attn::bf16*)(ws_ + WS_H);
    for (int u = F.vcu; u < nunits; u += F.G) {
        int b, hq, rowbase, kbase, seq;
        if (u < 512) { b = u >> 6; hq = (u >> 3) & 7; rowbase = b * SEQ + (u & 7) * 256; kbase = b * KVROWS; seq = KVROWS; }
        else { const int v = u - 512; b = v >> 3; hq = v & 7; rowbase = NLAT + b * CTXL; kbase = b * KVROWS + SEQ; seq = CTXL; }
        const size_t qo = (size_t)rowbase * DM + hq * 128, ko = (size_t)kbase * 256 + (hq >> 2) * 128;
        attn::attn_dense_body(QB + qo, KBUF + ko, VBUF + ko, OB + qo, seq, (char*)F.lds, F.tid);
    }
}

__device__ __forceinline__ unsigned fkey(float v) { const unsigned u = __float_as_uint(v); return (u & 0x80000000u) ? ~u : (u | 0x80000000u); }
__device__ __forceinline__ float keyf(unsigned k) { return __uint_as_float((k & 0x80000000u) ? (k & 0x7fffffffu) : ~k); }
#define ROR_MAX(m, n) m = max(m, (unsigned)__builtin_amdgcn_update_dpp(0, (int)(m), 0x120 + (n), 0xf, 0xf, false))
__device__ __forceinline__ unsigned row_max16(unsigned m) { ROR_MAX(m, 1); ROR_MAX(m, 2); ROR_MAX(m, 4); ROR_MAX(m, 8); return m; }
__device__ __forceinline__ float row_sum16(float v) {
    v += __uint_as_float((unsigned)__builtin_amdgcn_update_dpp(0, (int)__float_as_uint(v), 0x121, 0xf, 0xf, false));
    v += __uint_as_float((unsigned)__builtin_amdgcn_update_dpp(0, (int)__float_as_uint(v), 0x122, 0xf, 0xf, false));
    v += __uint_as_float((unsigned)__builtin_amdgcn_update_dpp(0, (int)__float_as_uint(v), 0x124, 0xf, 0xf, false));
    v += __uint_as_float((unsigned)__builtin_amdgcn_update_dpp(0, (int)__float_as_uint(v), 0x128, 0xf, 0xf, false));
    return v;
}
#define CE(a, b) do { const unsigned _x = max(a, b), _y = min(a, b); a = _x; b = _y; } while (0)
#define RMAX8(m) do { m = max(m, (unsigned)__builtin_amdgcn_update_dpp(0, (int)(m), 0x141, 0xf, 0xf, false)); m = max(m, (unsigned)__builtin_amdgcn_update_dpp(0, (int)(m), 0xB1, 0xf, 0xf, false)); \
    m = max(m, (unsigned)__builtin_amdgcn_update_dpp(0, (int)(m), 0x4E, 0xf, 0xf, false)); } while (0)
__device__ __forceinline__ void op_topk(Frame& F, KArgs A, int layer, int nrows) {
    const unsigned short* SC = (const unsigned short*)(ws_ + WS_Z);   int* IDX = (int*)(ws_ + WS_IDX); unsigned* SG = (unsigned*)(ws_ + WS_SG); const float* SHQ = (const float*)(ws_ + WS_SHQ);
    const float* SU = (const float*)(ws_ + WS_SU) + (size_t)layer * NEXP; const float* SV = (const float*)(ws_ + WS_SV) + (size_t)layer * NEXP;
    const int gw = F.vcu * NWAVES + F.wave, NGW = F.G * NWAVES;
    const int rowi = F.lane >> 4, l16 = F.lane & 15, gi = F.lane >> 3, l8 = F.lane & 7;
    constexpr int NS = 2;
    const int npairs = nrows * 8;
    LAS unsigned* lk = (LAS unsigned*)(F.lds + F.wave * 13312);
    LAS unsigned* lres = lk + NS * 64 * 18;
    LAS unsigned* lbest = lres + 16 * 16;
    LAS float* lval = (LAS float*)(lbest + 2 * 4 * 16);
    unsigned caoff[8], cboff[8], cid_[8]; bool cvalid[8];
#pragma unroll
    for (int sl = 0; sl < 8; ++sl) { const int q = 8 * l8 + sl;
        const int ci = q < 16 ? 0 : q < 24 ? 1 : q < 29 ? 2 : q < 33 ? 3 : q < 36 ? 4 : q < 38 ? 5 : q < 40 ? 6 : q < 42 ? 7 : (q - 34);
        const int st = q < 16 ? 0 : q < 24 ? 16 : q < 29 ? 24 : q < 33 ? 29 : q < 36 ? 33 : q < 38 ? 36 : q < 40 ? 38 : q < 42 ? 40 : q;
        const int cj = q - st; cvalid[sl] = q < 50; const int ci2 = cvalid[sl] ? ci : 0;
        caoff[sl] = (unsigned)(gi * 128 + ci2 * 4); cboff[sl] = (unsigned)(gi * 128 + 64 + cj * 4); cid_[sl] = (unsigned)(ci2 * 16 + cj); }
    const unsigned cbase = (unsigned)(rowi * 128);
    v4u va[NS][2];
#define TK_FETCH(pb_) do { _Pragma("unroll") for (int u = 0; u < NS; ++u) { const int th = min((pb_) + 4 * u + (gi >> 1), npairs - 1); \
        const unsigned short* sp = SC + (size_t)th * 256 + (gi & 1) * 128 + 16 * l8; va[u][0] = *(const v4u*)sp; va[u][1] = *(const v4u*)(sp + 8); } } while (0)
    TK_FETCH(gw * 8);
    float p_su[2], p_sv[2], p_gate[2], p_sh = 0.f; int p_pb = npairs;
#define TK_FLUSH(g) do { const int pth = p_pb + 4 * g + rowi; if (pth < npairs) SG[(size_t)pth * 16 + l16] = __builtin_bit_cast(unsigned, __builtin_amdgcn_cvt_pkrtz(p_su[g] * p_sh, p_gate[g] * p_sv[g])); } while (0)
    for (int pb = gw * 8; pb < npairs; pb += NGW * 8) {
        unsigned head[NS], hoff[NS];
#pragma unroll
        for (int u = 0; u < NS; ++u) {
            unsigned k[16];
#pragma unroll
            for (int i = 0; i < 8; ++i) {
                typedef short s16x2 __attribute__((ext_vector_type(2)));
                const unsigned xx = va[u][i >> 2][i & 3], sg = __builtin_bit_cast(unsigned, __builtin_bit_cast(s16x2, xx) >> (short)15), yy = xx ^ (sg | 0x80008000u);
                k[2 * i] = (yy << 16) | (unsigned)(16 * l8 + 2 * i); k[2 * i + 1] = (yy & 0xffff0000u) | (unsigned)(16 * l8 + 2 * i + 1); }
            CE(k[0], k[1]); CE(k[2], k[3]); CE(k[0], k[2]); CE(k[1], k[3]); CE(k[1], k[2]); CE(k[4], k[5]); CE(k[6], k[7]); CE(k[4], k[6]); CE(k[5], k[7]); CE(k[5], k[6]); CE(k[0], k[4]); CE(k[2], k[6]); CE(k[2], k[4]); CE(k[1], k[5]); CE(k[3], k[7]); CE(k[3], k[5]); CE(k[1], k[2]); CE(k[3], k[4]); CE(k[5], k[6]); CE(k[8], k[9]); CE(k[10], k[11]); CE(k[8], k[10]); CE(k[9], k[11]); CE(k[9], k[10]); CE(k[12], k[13]); CE(k[14], k[15]); CE(k[12], k[14]); CE(k[13], k[15]); CE(k[13], k[14]); CE(k[8], k[12]); CE(k[10], k[14]); CE(k[10], k[12]); CE(k[9], k[13]); CE(k[11], k[15]); CE(k[11], k[13]); CE(k[9], k[10]); CE(k[11], k[12]); CE(k[13], k[14]); CE(k[0], k[8]); CE(k[4], k[12]); CE(k[4], k[8]); CE(k[2], k[10]); CE(k[6], k[14]); CE(k[6], k[10]); CE(k[2], k[4]); CE(k[6], k[8]); CE(k[10], k[12]); CE(k[1], k[9]); CE(k[5], k[13]); CE(k[5], k[9]); CE(k[3], k[11]); CE(k[7], k[15]); CE(k[7], k[11]); CE(k[3], k[5]); CE(k[7], k[9]); CE(k[11], k[13]); CE(k[1], k[2]); CE(k[3], k[4]); CE(k[5], k[6]); CE(k[7], k[8]); CE(k[9], k[10]); CE(k[11], k[12]); CE(k[13], k[14]);
            LAS unsigned* lp = lk + (u * 64 + F.lane) * 18;
#pragma unroll
            for (int j = 0; j < 8; ++j) *(LAS v2u*)(lp + 2 * j) = (v2u){k[2 * j], k[2 * j + 1]};
            { unsigned z0 = 0u; asm volatile("" : "+v"(z0)); *(LAS v2u*)(lp + 16) = (v2u){z0, z0}; }
            head[u] = k[0]; hoff[u] = (unsigned)(unsigned long)lp;
        }
        TK_FETCH(pb + NGW * 8);
#pragma unroll
        for (int it = 0; it < 16; ++it) {
            unsigned m[NS];
#pragma unroll
            for (int u = 0; u < NS; ++u) m[u] = head[u];
#pragma unroll
            for (int u = 0; u < NS; ++u) m[u] = max(m[u], (unsigned)__builtin_amdgcn_update_dpp(0, (int)m[u], 0x141, 0xf, 0xf, false));
#pragma unroll
            for (int u = 0; u < NS; ++u) m[u] = max(m[u], (unsigned)__builtin_amdgcn_update_dpp(0, (int)m[u], 0xB1, 0xf, 0xf, false));
#pragma unroll
            for (int u = 0; u < NS; ++u) m[u] = max(m[u], (unsigned)__builtin_amdgcn_update_dpp(0, (int)m[u], 0x4E, 0xf, 0xf, false));
#pragma unroll
            for (int u = 0; u < NS; ++u) {
                lres[(u * 8 + gi) * 16 + it] = m[u];
                hoff[u] += (head[u] == m[u]) ? 4u : 0u;
                head[u] = *(const LAS unsigned*)(unsigned long)hoff[u];
            }
        }
#pragma unroll
        for (int e = 0; e < 4; ++e) { const unsigned kk = lres[e * 64 + F.lane]; const unsigned hk = kk >> 16, hb = hk ^ ((hk & 0x8000u) ? 0x8000u : 0xffffu);
            lval[e * 64 + F.lane] = (float)__builtin_bit_cast(_Float16, (unsigned short)hb); }
        {
            unsigned k[8];
#pragma unroll
            for (int sl = 0; sl < 8; ++sl) { const float sum = *(const LAS float*)((const LAS unsigned char*)lval + caoff[sl]) + *(const LAS float*)((const LAS unsigned char*)lval + cboff[sl]);
                k[sl] = cvalid[sl] ? ((fkey(sum) & ~255u) | cid_[sl]) : 0u; }
            CE(k[0], k[1]); CE(k[2], k[3]); CE(k[4], k[5]); CE(k[6], k[7]);
            CE(k[0], k[2]); CE(k[1], k[3]); CE(k[4], k[6]); CE(k[5], k[7]);
            CE(k[1], k[2]); CE(k[5], k[6]); CE(k[0], k[4]); CE(k[3], k[7]);
            CE(k[1], k[5]); CE(k[2], k[6]);
            CE(k[1], k[4]); CE(k[3], k[6]);
            CE(k[2], k[4]); CE(k[3], k[5]);
            CE(k[3], k[4]);
            LAS unsigned* lp = lk + F.lane * 18;
#pragma unroll
            for (int j = 0; j < 4; ++j) *(LAS v2u*)(lp + 2 * j) = (v2u){k[2 * j], k[2 * j + 1]};
            { unsigned z0 = 0u; asm volatile("" : "+v"(z0)); *(LAS v2u*)(lp + 8) = (v2u){z0, z0}; }
            unsigned hd = k[0], ho = (unsigned)(unsigned long)lp;
#pragma unroll
            for (int it = 0; it < 16; ++it) {
                unsigned m = hd; RMAX8(m);
                lbest[gi * 16 + it] = m;
                ho += (hd == m) ? 4u : 0u;
                hd = *(const LAS unsigned*)(unsigned long)ho;
            }
        }
#pragma unroll
        for (int g = 0; g < 2; ++g) {
            const int th = pb + 4 * g + rowi;
            const unsigned best = lbest[(g * 4 + rowi) * 16 + l16];
            const int cid = (int)(best & 255u); const float bsum = keyf(best & ~255u);
            const LAS unsigned char* rb = (const LAS unsigned char*)lres + cbase + g * 512;
            const int e1 = (int)(*(const LAS unsigned*)(rb + ((cid >> 4) << 2)) & 127u), e2 = (int)(*(const LAS unsigned*)(rb + 64 + ((cid & 15) << 2)) & 127u);
            const float mx = bperm(rowi * 16, bsum);
            const float ex = __expf(bsum - mx);
            const float den = row_sum16(ex);
            if (g == 0) { TK_FLUSH(0); TK_FLUSH(1); }
            const int eid = e1 * 128 + e2;
            if (th < npairs) IDX[(size_t)th * 16 + l16] = eid;
            p_su[g] = SU[eid]; p_sv[g] = SV[eid]; p_gate[g] = ex / den;
            if (g == 1) { int vz = 0; asm volatile("" : "+v"(vz)); p_sh = SHQ[(pb >> 3) + vz] * 16.f; p_pb = pb; }
        }
    }
    TK_FLUSH(0); TK_FLUSH(1);
#undef TK_FLUSH
#undef TK_FETCH
}

__device__ __forceinline__ void fmac(float& d, float a, float b) { asm("v_fmac_f32 %0, %1, %2" : "+v"(d) : "v"(a), "v"(b)); }
#define FP8_LO(w) __builtin_amdgcn_cvt_pk_f32_fp8((int)(w), false)
#define FP8_HI(w) __builtin_amdgcn_cvt_pk_f32_fp8((int)(w), true)
#define DOT16(a, r) do { pg8::f32x2 _f; \
    _f = FP8_LO((r).x); a += _f.x * hf[0] + _f.y * hf[1];   _f = FP8_HI((r).x); a += _f.x * hf[2] + _f.y * hf[3]; \
    _f = FP8_LO((r).y); a += _f.x * hf[4] + _f.y * hf[5];   _f = FP8_HI((r).y); a += _f.x * hf[6] + _f.y * hf[7]; \
    _f = FP8_LO((r).z); a += _f.x * hf[8] + _f.y * hf[9];   _f = FP8_HI((r).z); a += _f.x * hf[10] + _f.y * hf[11]; \
    _f = FP8_LO((r).w); a += _f.x * hf[12] + _f.y * hf[13]; _f = FP8_HI((r).w); a += _f.x * hf[14] + _f.y * hf[15]; } while (0)
#define AXPY16(w, r) do { pg8::f32x2 _f; \
    _f = FP8_LO((r).x); fmac(fo[0], (w), _f.x); fmac(fo[1], (w), _f.y);   _f = FP8_HI((r).x); fmac(fo[2], (w), _f.x); fmac(fo[3], (w), _f.y); \
    _f = FP8_LO((r).y); fmac(fo[4], (w), _f.x); fmac(fo[5], (w), _f.y);   _f = FP8_HI((r).y); fmac(fo[6], (w), _f.x); fmac(fo[7], (w), _f.y); \
    _f = FP8_LO((r).z); fmac(fo[8], (w), _f.x); fmac(fo[9], (w), _f.y);   _f = FP8_HI((r).z); fmac(fo[10], (w), _f.x); fmac(fo[11], (w), _f.y); \
    _f = FP8_LO((r).w); fmac(fo[12], (w), _f.x); fmac(fo[13], (w), _f.y); _f = FP8_HI((r).w); fmac(fo[14], (w), _f.x); fmac(fo[15], (w), _f.y); } while (0)
#define DOT16V(a, r, H_) do { pg8::f32x2 _f; \
    _f = FP8_LO((r).x); fmac(a, _f.x, H_[0]); fmac(a, _f.y, H_[1]);   _f = FP8_HI((r).x); fmac(a, _f.x, H_[2]); fmac(a, _f.y, H_[3]); \
    _f = FP8_LO((r).y); fmac(a, _f.x, H_[4]); fmac(a, _f.y, H_[5]);   _f = FP8_HI((r).y); fmac(a, _f.x, H_[6]); fmac(a, _f.y, H_[7]); \
    _f = FP8_LO((r).z); fmac(a, _f.x, H_[8]); fmac(a, _f.y, H_[9]);   _f = FP8_HI((r).z); fmac(a, _f.x, H_[10]); fmac(a, _f.y, H_[11]); \
    _f = FP8_LO((r).w); fmac(a, _f.x, H_[12]); fmac(a, _f.y, H_[13]); _f = FP8_HI((r).w); fmac(a, _f.x, H_[14]); fmac(a, _f.y, H_[15]); } while (0)
#define CVH_LO(w) __builtin_bit_cast(h2_t, __builtin_amdgcn_cvt_scalef32_pk_f16_fp8((w), 1.0f, false))
#define CVH_HI(w) __builtin_bit_cast(h2_t, __builtin_amdgcn_cvt_scalef32_pk_f16_fp8((w), 1.0f, true))
#define DOT16H(a, r, Hh) do { \
    a = __builtin_amdgcn_fdot2(CVH_LO((r).x), Hh[0], a, false); a = __builtin_amdgcn_fdot2(CVH_HI((r).x), Hh[1], a, false); \
    a = __builtin_amdgcn_fdot2(CVH_LO((r).y), Hh[2], a, false); a = __builtin_amdgcn_fdot2(CVH_HI((r).y), Hh[3], a, false); \
    a = __builtin_amdgcn_fdot2(CVH_LO((r).z), Hh[4], a, false); a = __builtin_amdgcn_fdot2(CVH_HI((r).z), Hh[5], a, false); \
    a = __builtin_amdgcn_fdot2(CVH_LO((r).w), Hh[6], a, false); a = __builtin_amdgcn_fdot2(CVH_HI((r).w), Hh[7], a, false); } while (0)
#define AXPY16H(wh, r) do { \
    fo[0] = __builtin_elementwise_fma(CVH_LO((r).x), (wh), fo[0]); fo[1] = __builtin_elementwise_fma(CVH_HI((r).x), (wh), fo[1]); \
    fo[2] = __builtin_elementwise_fma(CVH_LO((r).y), (wh), fo[2]); fo[3] = __builtin_elementwise_fma(CVH_HI((r).y), (wh), fo[3]); \
    fo[4] = __builtin_elementwise_fma(CVH_LO((r).z), (wh), fo[4]); fo[5] = __builtin_elementwise_fma(CVH_HI((r).z), (wh), fo[5]); \
    fo[6] = __builtin_elementwise_fma(CVH_LO((r).w), (wh), fo[6]); fo[7] = __builtin_elementwise_fma(CVH_HI((r).w), (wh), fo[7]); } while (0)
__device__ __forceinline__ h2_t pkh(float a, float b) { return __builtin_bit_cast(h2_t, __builtin_amdgcn_cvt_pkrtz(a, b)); }
#define CVL(d, w) asm volatile("v_cvt_scalef32_pk_f16_fp8 %0, %1, 1.0" : "=v"(d) : "v"(w))
#define CVU(d, w) asm volatile("v_cvt_scalef32_pk_f16_fp8 %0, %1, 1.0 op_sel:[1,0,0]" : "=v"(d) : "v"(w))
#define D2H(a, x, h) asm volatile("v_dot2c_f32_f16 %0, %1, %2" : "+v"(a) : "v"(x), "v"(h))
#define PKF(f, x, w) asm volatile("v_pk_fma_f16 %0, %1, %2, %0" : "+v"(f) : "v"(x), "v"(w))
#define DOT2ROWS(accA, accB, ra, rb, hu) do { unsigned _t0, _t1, _t2, _t3, _t4, _t5, _t6, _t7, _s0, _s1, _s2, _s3, _s4, _s5, _s6, _s7; float _a2 = 0.f, _b2 = 0.f; \
    CVL(_t0, (ra).x); CVU(_t1, (ra).x); CVL(_t2, (ra).y); CVU(_t3, (ra).y); CVL(_t4, (ra).z); CVU(_t5, (ra).z); CVL(_t6, (ra).w); CVU(_t7, (ra).w); \
    CVL(_s0, (rb).x); CVU(_s1, (rb).x); CVL(_s2, (rb).y); CVU(_s3, (rb).y); CVL(_s4, (rb).z); CVU(_s5, (rb).z); CVL(_s6, (rb).w); CVU(_s7, (rb).w); \
    D2H(accA, _t0, hu[0]); D2H(accB, _s0, hu[0]); D2H(_a2, _t1, hu[1]); D2H(_b2, _s1, hu[1]); D2H(accA, _t2, hu[2]); D2H(accB, _s2, hu[2]); D2H(_a2, _t3, hu[3]); D2H(_b2, _s3, hu[3]); \
    D2H(accA, _t4, hu[4]); D2H(accB, _s4, hu[4]); D2H(_a2, _t5, hu[5]); D2H(_b2, _s5, hu[5]); D2H(accA, _t6, hu[6]); D2H(accB, _s6, hu[6]); \
      \
    asm volatile("v_dot2c_f32_f16 %2, %4, %6\n\tv_dot2c_f32_f16 %3, %5, %6\n\ts_nop 2\n\tv_add_f32 %0, %0, %2\n\tv_add_f32 %1, %1, %3" \
        : "+v"(accA), "+v"(accB), "+v"(_a2), "+v"(_b2) : "v"(_t7), "v"(_s7), "v"(hu[7])); } while (0)
#define AXPYROW(fu, wu, r) do { unsigned _t0, _t1, _t2, _t3, _t4, _t5, _t6, _t7; \
    CVL(_t0, (r).x); CVU(_t1, (r).x); CVL(_t2, (r).y); CVU(_t3, (r).y); CVL(_t4, (r).z); CVU(_t5, (r).z); CVL(_t6, (r).w); CVU(_t7, (r).w); \
    PKF(fu[0], _t0, wu); PKF(fu[1], _t1, wu); PKF(fu[2], _t2, wu); PKF(fu[3], _t3, wu); PKF(fu[4], _t4, wu); PKF(fu[5], _t5, wu); PKF(fu[6], _t6, wu); PKF(fu[7], _t7, wu); } while (0)
#define C4B0(d, w) asm volatile("v_cvt_scalef32_pk_f16_fp4 %0, %1, 1.0" : "=v"(d) : "v"(w))
#define C4B1(d, w) asm volatile("v_cvt_scalef32_pk_f16_fp4 %0, %1, 1.0 op_sel:[1,0,0]" : "=v"(d) : "v"(w))
#define C4B2(d, w) asm volatile("v_cvt_scalef32_pk_f16_fp4 %0, %1, 1.0 op_sel:[0,1,0]" : "=v"(d) : "v"(w))
#define C4B3(d, w) asm volatile("v_cvt_scalef32_pk_f16_fp4 %0, %1, 1.0 op_sel:[1,1,0]" : "=v"(d) : "v"(w))
#define C4ROW(T, r) do { C4B0(T[0], (r).x); C4B1(T[1], (r).x); C4B2(T[2], (r).x); C4B3(T[3], (r).x); C4B0(T[4], (r).y); C4B1(T[5], (r).y); C4B2(T[6], (r).y); C4B3(T[7], (r).y); \
    C4B0(T[8], (r).z); C4B1(T[9], (r).z); C4B2(T[10], (r).z); C4B3(T[11], (r).z); C4B0(T[12], (r).w); C4B1(T[13], (r).w); C4B2(T[14], (r).w); C4B3(T[15], (r).w); } while (0)
#define DOT2ROWS4(accA, accB, ra, rb, hu) do { unsigned _t[16], _s[16]; float _a2 = 0.f, _b2 = 0.f; C4ROW(_t, ra); C4ROW(_s, rb); \
    _Pragma("unroll") for (int _i = 0; _i < 14; _i += 2) { D2H(accA, _t[_i], hu[_i]); D2H(accB, _s[_i], hu[_i]); D2H(_a2, _t[_i + 1], hu[_i + 1]); D2H(_b2, _s[_i + 1], hu[_i + 1]); } \
    D2H(accA, _t[14], hu[14]); D2H(accB, _s[14], hu[14]); \
    asm volatile("v_dot2c_f32_f16 %2, %4, %6\n\tv_dot2c_f32_f16 %3, %5, %6\n\ts_nop 2\n\tv_add_f32 %0, %0, %2\n\tv_add_f32 %1, %1, %3" \
        : "+v"(accA), "+v"(accB), "+v"(_a2), "+v"(_b2) : "v"(_t[15]), "v"(_s[15]), "v"(hu[15])); } while (0)
#define AXPYROW4(fu, wu, r) do { unsigned _t[16]; C4ROW(_t, r); _Pragma("unroll") for (int _i = 0; _i < 16; ++_i) PKF(fu[_i], _t[_i], wu); } while (0)
__device__ __forceinline__ void slice_map(Frame& F, KArgs A, int& x0, int& nsl, int& w0, int& NW_) {
    if ((F.G % 8) != 0) { x0 = 0; nsl = 8; w0 = F.vcu * NWAVES + F.wave; NW_ = F.G * NWAVES; return; }
    unsigned* bar = (unsigned*)(ws_ + WS_CTL) + CW_BAR; bool even = true;
#pragma unroll
    for (int j = 0; j < 8; ++j) even = even && (xb_ld(&bar[XB_XCNT(j)]) == (unsigned)(F.G >> 3));
    const unsigned rk = ((volatile LAS unsigned*)(F.lds + MISC_OFF))[12], xcc = ((volatile LAS unsigned*)(F.lds + MISC_OFF))[13];
    const int sl = even ? (int)__builtin_amdgcn_readfirstlane(xcc) : (F.bx & 7), sub = even ? (int)__builtin_amdgcn_readfirstlane(rk) : (F.bx >> 3);
    x0 = sl; nsl = 1; w0 = sub * NWAVES + F.wave; NW_ = (F.G >> 3) * NWAVES;
}
__device__ __forceinline__ void slice_map4(Frame& F, KArgs A, int& x0, int& nsl, int& w0, int& NW_) {
    slice_map(F, A, x0, nsl, w0, NW_);
    if (nsl == 8) { nsl = 4; return; }
    const int sl = x0; x0 = sl >> 1; w0 += (sl & 1) * NW_; NW_ *= 2;
}
#define G_LOAD_E(E_, tt) do { const int* _ip = IDX + (size_t)(tt) * 128; _Pragma("unroll") for (int q = 0; q < 4; ++q) E_[q] = *(const v4u*)(_ip + 16u * gg + 4u * q); } while (0)
#define G_LOAD_R8(R_, Ea, Eb, tsl_) do { \
    R_[0] = *(const v4u*)((tsl_) + ((Ea).x * 128u + 16u * pp)); R_[1] = *(const v4u*)((tsl_) + ((Ea).y * 128u + 16u * pp)); \
    R_[2] = *(const v4u*)((tsl_) + ((Ea).z * 128u + 16u * pp)); R_[3] = *(const v4u*)((tsl_) + ((Ea).w * 128u + 16u * pp)); \
    R_[4] = *(const v4u*)((tsl_) + ((Eb).x * 128u + 16u * pp)); R_[5] = *(const v4u*)((tsl_) + ((Eb).y * 128u + 16u * pp)); \
    R_[6] = *(const v4u*)((tsl_) + ((Eb).z * 128u + 16u * pp)); R_[7] = *(const v4u*)((tsl_) + ((Eb).w * 128u + 16u * pp)); } while (0)
#define G_RING(r_, n_) ((r_) + (n_) >= 3 ? (r_) + (n_) - 3 : (r_) + (n_))
#define G_LOAD_R8L(R_, Ea, Eb, tsl_) do { \
    R_[0] = *(const v4u*)((tsl_) + ((Ea).x * 128u + 16u * pp)); R_[1] = *(const v4u*)((tsl_) + ((Ea).y * 128u + 16u * pp)); \
    R_[2] = *(const v4u*)((tsl_) + ((Ea).z * 128u + 16u * pp)); R_[3] = *(const v4u*)((tsl_) + ((Ea).w * 128u + 16u * pp)); \
    R_[4] = *(const v4u*)((tsl_) + ((Eb).x * 128u + 16u * pp)); R_[5] = *(const v4u*)((tsl_) + ((Eb).y * 128u + 16u * pp)); \
    R_[6] = *(const v4u*)((tsl_) + ((Eb).z * 128u + 16u * pp)); R_[7] = *(const v4u*)((tsl_) + ((Eb).w * 128u + 16u * pp)); } while (0)
__device__ __forceinline__ void op_gather_u(Frame& F, KArgs A, int layer, int nrows, bool dry) {
    const unsigned char* TU = ws_ + WS_TU + (size_t)layer * NEXP * 512;
    const int* IDX = (const int*)(ws_ + WS_IDX); const unsigned* HQ = (const unsigned*)(ws_ + WS_H8);
    unsigned* PACT = (unsigned*)(ws_ + (dry ? WS_G : WS_Z));
    int x0, nsl, w0, NW_; slice_map4(F, A, x0, nsl, w0, NW_);
    const unsigned pp0 = (unsigned)F.lane & 7u, gg0 = (unsigned)F.lane >> 3, ll0 = (unsigned)F.lane;
    const bool b0 = F.lane & 1, b1 = F.lane & 2, b2 = F.lane & 4;
    LAS unsigned* lE = (LAS unsigned*)(F.lds + F.wave * 4096 + 1024);
    LAS unsigned* lH = (LAS unsigned*)(F.lds + F.wave * 4096 + 2560);
    for (int xs = 0; xs < nsl; ++xs) {
        const int x = x0 + xs;
        const unsigned char* tsl = TU + (size_t)x * (NEXP * 128);
        const unsigned* Hx = HQ + x * 64;
        int t = w0;
        if (t >= nrows) continue;
        const int tlast = t + ((nrows - 1 - t) / NW_) * NW_;
        unsigned pp = pp0, gg = gg0, ll = ll0; asm volatile("" : "+v"(pp), "+v"(gg), "+v"(ll));
        v4u R0[8], R1[8]; v2u eraw; unsigned hraw;
#define G1_GLOAD(tt) do { const int _t = (tt) < tlast ? (tt) : tlast; eraw = *(const v2u*)(IDX + (size_t)_t * 128 + 2u * ll); hraw = Hx[(size_t)_t * 256 + ll]; } while (0)
#define G1_LWRITE(r_) do { *(LAS v2u*)(lE + (r_) * 128 + 2u * ll) = eraw; lH[(r_) * 64 + ll] = hraw; } while (0)
        G1_GLOAD(t); G1_LWRITE(0); G1_GLOAD(t + NW_); G1_LWRITE(1); G1_GLOAD(t + 2 * NW_);
        { const v4u e0 = *(const LAS v4u*)(lE + 16u * gg), e1 = *(const LAS v4u*)(lE + 16u * gg + 4u); G_LOAD_R8L(R0, e0, e1, tsl); }
        int r = 0;
        while (t < nrows) {
            const int tn = t + NW_;
            pp = pp0; gg = gg0; ll = ll0; asm volatile("" : "+v"(pp), "+v"(gg), "+v"(ll));
            const unsigned k0 = 16u * gg + ((pp & 1u) << 3) + ((pp & 2u) << 1) + ((pp & 4u) >> 1);
            const int r1 = G_RING(r, 1), r2 = G_RING(r, 2);
            const v4u ea0 = *(const LAS v4u*)(lE + r * 128 + 16u * gg + 8u), ea1 = *(const LAS v4u*)(lE + r * 128 + 16u * gg + 12u);
            const v4u eb0 = *(const LAS v4u*)(lE + r1 * 128 + 16u * gg), eb1 = *(const LAS v4u*)(lE + r1 * 128 + 16u * gg + 4u);
            const v4u ha = *(const LAS v4u*)(lH + r * 64 + 4u * pp), hb = *(const LAS v4u*)(lH + r * 64 + 32u + 4u * pp);
            G_LOAD_R8L(R1, ea0, ea1, tsl);
            int hs;
            { int sa = __builtin_amdgcn_sdot8((int)ha.x, 0x11111111, 0, false); sa = __builtin_amdgcn_sdot8((int)ha.y, 0x11111111, sa, false); sa = __builtin_amdgcn_sdot8((int)ha.z, 0x11111111, sa, false); sa = __builtin_amdgcn_sdot8((int)ha.w, 0x11111111, sa, false);
              int sb = __builtin_amdgcn_sdot8((int)hb.x, 0x11111111, 0, false); sb = __builtin_amdgcn_sdot8((int)hb.y, 0x11111111, sb, false); sb = __builtin_amdgcn_sdot8((int)hb.z, 0x11111111, sb, false); sb = __builtin_amdgcn_sdot8((int)hb.w, 0x11111111, sb, false);
              hs = (sa << 4) + sb; }
            unsigned a[16];
#define G1_ROW(R_) ({ int _a = __builtin_amdgcn_sdot8((int)(R_).x, (int)ha.x, 0, false), _b = __builtin_amdgcn_sdot8((int)(R_).x, (int)hb.x, 0, false); \
            _a = __builtin_amdgcn_sdot8((int)(R_).y, (int)ha.y, _a, false); _b = __builtin_amdgcn_sdot8((int)(R_).y, (int)hb.y, _b, false); \
            _a = __builtin_amdgcn_sdot8((int)(R_).z, (int)ha.z, _a, false); _b = __builtin_amdgcn_sdot8((int)(R_).z, (int)hb.z, _b, false); \
            _a = __builtin_amdgcn_sdot8((int)(R_).w, (int)ha.w, _a, false); _b = __builtin_amdgcn_sdot8((int)(R_).w, (int)hb.w, _b, false); \
            (unsigned)((((_a << 4) + _b) << 1) + hs); })
#pragma unroll
            for (int i = 0; i < 8; ++i) a[i] = G1_ROW(R0[i]);
            G_LOAD_R8L(R0, eb0, eb1, tsl);
            G1_LWRITE(r2);
            G1_GLOAD(t + 3 * NW_);
#pragma unroll
            for (int i = 0; i < 8; ++i) a[8 + i] = G1_ROW(R1[i]);
#undef G1_ROW
            unsigned a8[8], a4[4], a2[2];
#pragma unroll
            for (int i = 0; i < 8; ++i) { const unsigned mine = b0 ? a[8 + i] : a[i], send = b0 ? a[i] : a[8 + i]; a8[i] = mine + shx_u<1>(send); }
#pragma unroll
            for (int i = 0; i < 4; ++i) { const unsigned mine = b1 ? a8[4 + i] : a8[i], send = b1 ? a8[i] : a8[4 + i]; a4[i] = mine + shx_u<2>(send); }
#pragma unroll
            for (int i = 0; i < 2; ++i) { const unsigned mine = b2 ? a4[2 + i] : a4[i], send = b2 ? a4[i] : a4[2 + i]; a2[i] = mine + shx_u<4>(send); }
            PACT[((size_t)x * NTOK + t) * 64 + (k0 >> 1)] = h2u(pkh((float)(int)a2[0] * (1.f / 32.f), (float)(int)a2[1] * (1.f / 32.f)));
            r = r1; t = tn;
        }
#undef G1_GLOAD
#undef G1_LWRITE
        LDS_WAIT(); asm volatile("" ::: "memory");
    }
}
#define G2_TR4(y0, y1, y2, y3, x0, x1, x2, x3) do { const unsigned _t0 = __builtin_amdgcn_perm(x1, x0, 0x05010400u), _t1 = __builtin_amdgcn_perm(x1, x0, 0x07030602u), \
    _t2 = __builtin_amdgcn_perm(x3, x2, 0x05010400u), _t3 = __builtin_amdgcn_perm(x3, x2, 0x07030602u); \
    y0 = __builtin_amdgcn_perm(_t2, _t0, 0x05040100u); y1 = __builtin_amdgcn_perm(_t2, _t0, 0x07060302u); y2 = __builtin_amdgcn_perm(_t3, _t1, 0x05040100u); y3 = __builtin_amdgcn_perm(_t3, _t1, 0x07060302u); } while (0)
#define G2_QUAD(Ra, Rb, Rc, Rd, W_) do { _Pragma("unroll") for (int _d = 0; _d < 4; ++_d) { unsigned _y0, _y1, _y2, _y3; G2_TR4(_y0, _y1, _y2, _y3, (Ra)[_d], (Rb)[_d], (Rc)[_d], (Rd)[_d]); \
    aT[4 * _d] = __builtin_amdgcn_sdot4((int)_y0, (int)(W_), aT[4 * _d], false); aL[4 * _d] = __builtin_amdgcn_sdot4((int)(_y0 & 0x0f0f0f0fu), (int)(W_), aL[4 * _d], false); \
    aT[4 * _d + 1] = __builtin_amdgcn_sdot4((int)_y1, (int)(W_), aT[4 * _d + 1], false); aL[4 * _d + 1] = __builtin_amdgcn_sdot4((int)(_y1 & 0x0f0f0f0fu), (int)(W_), aL[4 * _d + 1], false); \
    aT[4 * _d + 2] = __builtin_amdgcn_sdot4((int)_y2, (int)(W_), aT[4 * _d + 2], false); aL[4 * _d + 2] = __builtin_amdgcn_sdot4((int)(_y2 & 0x0f0f0f0fu), (int)(W_), aL[4 * _d + 2], false); \
    aT[4 * _d + 3] = __builtin_amdgcn_sdot4((int)_y3, (int)(W_), aT[4 * _d + 3], false); aL[4 * _d + 3] = __builtin_amdgcn_sdot4((int)(_y3 & 0x0f0f0f0fu), (int)(W_), aL[4 * _d + 3], false); } } while (0)
#define G2_D0(d, y, w) asm volatile("v_dot4_i32_i8 %0, %1, %2, 0" : "=v"(d) : "v"(y), "v"(w))
#define G2_QUAD0(Ra, Rb, Rc, Rd, W_) do { _Pragma("unroll") for (int _d = 0; _d < 4; ++_d) { unsigned _y0, _y1, _y2, _y3; G2_TR4(_y0, _y1, _y2, _y3, (Ra)[_d], (Rb)[_d], (Rc)[_d], (Rd)[_d]); \
    const unsigned _m0 = _y0 & 0x0f0f0f0fu, _m1 = _y1 & 0x0f0f0f0fu, _m2 = _y2 & 0x0f0f0f0fu, _m3 = _y3 & 0x0f0f0f0fu; \
    G2_D0(aT[4 * _d], _y0, W_); G2_D0(aL[4 * _d], _m0, W_); G2_D0(aT[4 * _d + 1], _y1, W_); G2_D0(aL[4 * _d + 1], _m1, W_); \
    G2_D0(aT[4 * _d + 2], _y2, W_); G2_D0(aL[4 * _d + 2], _m2, W_); G2_D0(aT[4 * _d + 3], _y3, W_); G2_D0(aL[4 * _d + 3], _m3, W_); } } while (0)
__device__ __forceinline__ void op_gather_v(Frame& F, KArgs A, int layer, int nrows, bool dry) {
    const unsigned char* TV = ws_ + WS_TV + (size_t)layer * NEXP * 512;
    const int* IDX = (const int*)(ws_ + WS_IDX); const v2u* SG = (const v2u*)(ws_ + WS_SG); const unsigned* PACT = (const unsigned*)(ws_ + WS_Z);
    unsigned* X = (unsigned*)(ws_ + WS_X); unsigned* Xw = dry ? (unsigned*)(ws_ + WS_Z + 80 * MiB) : X;
    const float* modl = (const float*)(ws_ + WS_MOD) + (size_t)layer * 9 * MODW;
    LAS unsigned* wl = (LAS unsigned*)(F.lds + F.wave * 4096);
    LAS unsigned* lE = (LAS unsigned*)(F.lds + F.wave * 4096 + 1024);
    int x0, nsl, w0, NW_; slice_map4(F, A, x0, nsl, w0, NW_);
    const unsigned pp0 = (unsigned)F.lane & 7u, gg0 = (unsigned)F.lane >> 3, ll0 = (unsigned)F.lane;
    const bool b3 = F.lane & 8, b4 = F.lane & 16, b5 = F.lane & 32;
    for (int xs = 0; xs < nsl; ++xs) {
        const int x = x0 + xs;
        const unsigned char* tsl = TV + (size_t)x * (NEXP * 128);
        int t = w0;
        if (t >= nrows) continue;
        const int tlast = t + ((nrows - 1 - t) / NW_) * NW_;
        v4u R0[8], R1[8]; v2u eraw;
        unsigned pp = pp0, gg = gg0, ll = ll0; asm volatile("" : "+v"(pp), "+v"(gg), "+v"(ll));
        unsigned pw[4]; v2u psg;
        float swc, swn;
#define G2_LOAD_W(tt) do { const int _t = (tt) < tlast ? (tt) : tlast; const unsigned char* _pa = (const unsigned char*)(PACT + (size_t)_t * 64);     \
        _Pragma("unroll") for (int xx = 0; xx < 4; ++xx) { const __attribute__((address_space(1))) unsigned char* _px = (const __attribute__((address_space(1))) unsigned char*)(_pa + (size_t)xx * NTOK * 256); asm volatile("" : "+s"(_px)); \
            pw[xx] = *(const __attribute__((address_space(1))) unsigned*)(_px + (ll << 2)); }     \
        psg = *(const v2u*)((const unsigned char*)(SG + (size_t)_t * 64) + (ll << 3)); } while (0)
#define G2_MAKE_W(buf, sw_) do { h2_t _hs = u2h(pw[0]) + u2h(pw[1]); _hs = _hs + u2h(pw[2]); _hs = _hs + u2h(pw[3]);     \
        const h2_t _g0 = u2h(psg.x), _g1 = u2h(psg.y); \
        const pg8::f32x2 _ge = pg8::gelu_pk((pg8::f32x2){(float)_hs.x * (float)_g0.x, (float)_hs.y * (float)_g1.x}); \
        const float _w0 = _ge.x * (float)_g0.y, _w1 = _ge.y * (float)_g1.y; \
        const float _m = wave_max_nn(fmaxf(fabsf(_w0), fabsf(_w1))), _inv = 127.f * __builtin_amdgcn_rcpf(fmaxf(_m, 1e-30f)); \
        const int _q0 = (int)__builtin_rintf(_w0 * _inv), _q1 = (int)__builtin_rintf(_w1 * _inv); \
        *((LAS unsigned short*)(wl + (buf) * 32) + ll) = (unsigned short)(((unsigned)_q0 & 255u) | (((unsigned)_q1 & 255u) << 8)); sw_ = _m * (0.5f / 127.f); } while (0)
#define G2_GLOAD(tt) do { const int _t = (tt) < tlast ? (tt) : tlast; eraw = *(const v2u*)((const unsigned char*)(IDX + (size_t)_t * 128) + (ll << 3)); } while (0)
#define G2_LWRITE(r_) do { *(LAS v2u*)(lE + (r_) * 128 + 2u * ll) = eraw; } while (0)
        G2_GLOAD(t); G2_LWRITE(0); G2_GLOAD(t + NW_); G2_LWRITE(1); G2_GLOAD(t + 2 * NW_);
        G2_LOAD_W(t);
        { const v4u e0 = *(const LAS v4u*)(lE + 16u * gg), e1 = *(const LAS v4u*)(lE + 16u * gg + 4u), e2 = *(const LAS v4u*)(lE + 16u * gg + 8u), e3 = *(const LAS v4u*)(lE + 16u * gg + 12u);
          G_LOAD_R8L(R0, e0, e1, tsl); G_LOAD_R8L(R1, e2, e3, tsl); }
        G2_MAKE_W(0, swc);
        int buf = 0, r = 0;
        while (t < nrows) {
            const int tn = t + NW_; const int mr = t < NLAT ? (t >> 11) : 8;
            pp = pp0; gg = gg0; ll = ll0; asm volatile("" : "+v"(pp), "+v"(gg), "+v"(ll));
            const unsigned colb = (unsigned)x * 256u + 32u * pp + ((gg & 1u) << 4) + ((gg & 2u) << 2) + (gg & 4u);
            const int r1 = G_RING(r, 1), r2 = G_RING(r, 2);
            const v4u ea0 = *(const LAS v4u*)(lE + r1 * 128 + 16u * gg + 8u), ea1 = *(const LAS v4u*)(lE + r1 * 128 + 16u * gg + 12u);
            const v4u eb0 = *(const LAS v4u*)(lE + r1 * 128 + 16u * gg), eb1 = *(const LAS v4u*)(lE + r1 * 128 + 16u * gg + 4u);
            G2_LOAD_W(tn);
            const f32x4 gt2 = *(const f32x4*)((const unsigned char*)(modl + mr * MODW + 5 * DM) + (colb << 2));
            const v2u xo = *(const v2u*)((const unsigned char*)(X + (size_t)t * (DM / 2)) + (colb << 1));
            LDS_WAIT(); asm volatile("" ::: "memory");
            const v4u wq = *(const LAS v4u*)(wl + buf * 32 + 4u * gg);
            int aT[16], aL[16];
            G2_QUAD0(R0[0], R0[1], R0[2], R0[3], wq.x); G2_QUAD(R0[4], R0[5], R0[6], R0[7], wq.y);
            G_LOAD_R8L(R0, eb0, eb1, tsl);
            G2_LWRITE(r2);
            G2_GLOAD(t + 3 * NW_);
            G2_QUAD(R1[0], R1[1], R1[2], R1[3], wq.z); G2_QUAD(R1[4], R1[5], R1[6], R1[7], wq.w);
            G_LOAD_R8L(R1, ea0, ea1, tsl);
            int sw = __builtin_amdgcn_sdot4((int)wq.x, 0x01010101, 0, false); sw = __builtin_amdgcn_sdot4((int)wq.y, 0x01010101, sw, false);
            sw = __builtin_amdgcn_sdot4((int)wq.z, 0x01010101, sw, false); sw = __builtin_amdgcn_sdot4((int)wq.w, 0x01010101, sw, false);
            sw += (int)shx_u<8>((unsigned)sw); sw = (int)xadd16((unsigned)sw, (unsigned)sw); sw = (int)xadd32((unsigned)sw, (unsigned)sw);
            unsigned T8[8], T4[4], T2[2], L8[8], L4[4], L2[2];
            asm volatile("s_nop 2" ::: "memory");
#define G2_X8(r_, x_, y_) asm volatile("v_add_u32_dpp %0, %1, %1 row_ror:8 row_mask:0xf bank_mask:0xf\n\tv_add_u32_dpp %0, %2, %2 row_ror:8 row_mask:0xf bank_mask:0xc" : "=&v"(r_) : "v"(x_), "v"(y_))
#pragma unroll
            for (int i = 0; i < 8; ++i) { G2_X8(T8[i], aT[i], aT[8 + i]); G2_X8(L8[i], aL[i], aL[8 + i]); }
#undef G2_X8
#pragma unroll
            for (int i = 0; i < 4; ++i) { T4[i] = xadd16(T8[i], T8[4 + i]); L4[i] = xadd16(L8[i], L8[4 + i]); }
#pragma unroll
            for (int i = 0; i < 2; ++i) { T2[i] = xadd32(T4[i], T4[2 + i]); L2[i] = xadd32(L4[i], L4[2 + i]); }
            const float fsw = (float)sw * swc, c15 = -15.f * fsw, s2 = 2.f * swc, s8 = 0.125f * swc;
            const float o0 = __builtin_fmaf((float)(int)L2[0], s2, c15), o1 = __builtin_fmaf((float)((int)T2[0] - (int)L2[0]), s8, fsw);
            const float o2 = __builtin_fmaf((float)(int)L2[1], s2, c15), o3 = __builtin_fmaf((float)((int)T2[1] - (int)L2[1]), s8, fsw);
            { v2u xn; xn.x = pk2(bflo(xo.x) + gt2[0] * o0, bfhi(xo.x) + gt2[1] * o1); xn.y = pk2(bflo(xo.y) + gt2[2] * o2, bfhi(xo.y) + gt2[3] * o3);
              *(v2u*)((unsigned char*)(Xw + (size_t)t * (DM / 2)) + (colb << 1)) = xn; }
            G2_MAKE_W(1 - buf, swn);
            swc = swn;
            buf = 1 - buf; r = r1; t = tn;
        }
#undef G2_LOAD_W
#undef G2_MAKE_W
#undef G2_GLOAD
#undef G2_LWRITE
        LDS_WAIT(); asm volatile("" ::: "memory");
    }
}

constexpr int SPL = 11;
constexpr int NSTEPS = 2 + SPL * DEPTH;
#ifndef DIS
#define DIS 0
#endif
#ifndef ZB
#define ZB 0
#endif
#define EN(n) (!((DIS >> (n)) & 1))
__device__ __forceinline__ bool run_step(Frame& F, KArgs A, int step, bool dry) {
    unsigned char* ws = ws_;
    bf16* X = (bf16*)(ws + WS_X); const float* MOD = (const float*)(ws + WS_MOD);
    bf16* H = (bf16*)(ws + WS_H);
    if (step == 0) { if (EN(0)) op_prep(F, A); return true; }
    if (step == 1) { if (EN(1)) op_modulate(F, A, A->in[I_X], A->in[I_CTX], nullptr, A->in[I_N1G], MOD, 0, NTOK, false);
#pragma unroll 1
        for (int seg = 0; seg < 3; ++seg) {
            const size_t so = seg == 0 ? WS_WSGUIN : (seg == 1 ? WS_WPOOLIN : WS_WQKV); const int r0 = seg == 0 ? 0 : (seg == 1 ? 8192 : 9216), nr = seg == 0 ? 8192 : (seg == 1 ? 1024 : 1536);
            op_quant_rows(F, A, so, WS_W8IN + (size_t)r0 * 1024, WS_SW8 + (size_t)r0 * 4, nr); } }
    const int layer = (step - 2) / SPL, k = (step - 2) % SPL, kind = layer % 3, jj = layer / 3;
    const int nrows = (layer == DEPTH - 1 || (layer == DEPTH - 2 && k >= 2)) ? NLAT : NTOK, nM = nrows / 256;
    const float* modl = MOD + (size_t)layer * 9 * MODW;
    if (k == 1) { if (layer == 0) op_quant_rows(F, A, WS_WPQ, WS_WPQ8, WS_SWQ, DEPTH * 2048);
        if (kind == 0) { if (EN(4)) op_spatial(F, A, jj, nrows); } else if (kind == 1) { if (EN(5)) op_pool(F, A, nrows); } else { if (EN(6)) op_qknorm(F, A, nrows); } return true; }
    if (k == 2 && kind == 0) return false;
    if (k == 2 && kind == 2) { if (EN(8)) op_attn(F, A, layer == DEPTH - 2 ? 512 : 576); return true; }
    if (k == 4) { if (EN(10)) op_modulate(F, A, nullptr, nullptr, X, A->in[I_N2G] + layer * DM, modl, 3, nrows, false, true); return true; }
    if (k == 7) { if (EN(13)) op_topk(F, A, layer, nrows); return true; }
    if (k == 8) { if (EN(14)) op_gather_u(F, A, layer, nrows, dry); return true; }
    if (k == 9) { if (EN(14)) op_gather_v(F, A, layer, nrows, dry); return true; }
    if (k == 10) {
        if (layer == DEPTH - 1) op_modulate(F, A, nullptr, nullptr, X, A->in[I_FINAL_G], modl, 0, NLAT, true);
        else op_modulate(F, A, nullptr, nullptr, X, A->in[I_N1G] + (layer + 1) * DM, modl + 9 * MODW, 0, (layer == DEPTH - 2) ? NLAT : NTOK, false);
        return true; }
    if (k == 6) return false;
    const int nrep = (k == 0 && kind == 0) ? 2 : 1;
    for (int rep = 0; rep < nrep; ++rep) {
        pg8::Gemm g; pg8::EpiAny E;
        g.A = H; g.lda = DM; g.K = DM; g.nM = nM; g.nN = 4; g.a_pm = 256 * DM; g.a_pn = 0; g.Bt = H; g.ldb = DM; g.b_pm = 0; g.b_pn = 256 * DM;
        E.type = 0; E.perm = true; E.O = (void*)(ws + WS_Z); E.ldc = DM; E.act = 0; E.mul = nullptr; E.o_pm = 0; E.o_pn = 256;
        E.rsc = nullptr; E.csc = nullptr; E.srcLat = nullptr; E.srcCtx = nullptr; E.X = (void*)X; E.Xsrc = (const void*)X; E.modl = modl; E.nlat = NLAT; E.chunk = 2; E.SS = (float*)(ws + WS_SS); if (dry) E.X = (void*)(ws + WS_Z); E.gs = ((ZB >> kind) & 1) ? 0.f : 1.f;
        if (k < 0) {
            g.A = (const bf16*)(ws + WS_KB); g.lda = 256; g.K = 256; g.nM = DEPTH * 8; g.nN = 4; g.a_pm = 65536; g.a_pn = 0;
            g.Bt = (const bf16*)(ws + WS_G); g.ldb = 256; g.b_pm = 1024 * 256; g.b_pn = 65536;
            E.O = (void*)(ws + WS_WPQ); E.ldc = DM;
        } else if (k == 0) {
            const bf16* W8 = (const bf16*)(ws + WS_W8IN); const float* SW8 = (const float*)(ws + WS_SW8); const float* SH = (const float*)(ws + WS_SHQ);
            g.lda = 512; g.K = 512; g.a_pm = 256 * 512; g.ldb = 512; g.b_pn = 256 * 512; E.rsc = SH;
            if (kind == 0 && rep == 0) { g.Bt = W8 + (size_t)jj * 4096 * 512; g.nN = 8; E.ldc = SGUW; E.act = 1; E.csc = SW8 + jj * 4096; }
            else if (kind == 0) {
                g.A = W8 + (size_t)jj * 4096 * 512 + (size_t)2048 * 512; g.nM = 8; g.nN = nM; g.Bt = H;
                E.type = 3; E.O = (void*)((bf16*)(ws + WS_Z) + (size_t)NTOK * SGUW); E.ldc = NTOK; E.rsc = SW8 + jj * 4096 + 2048; E.csc = SH; }
            else if (kind == 1) { g.Bt = W8 + (size_t)8192 * 512; g.nN = 4; E.ldc = DM; E.csc = SW8 + 8192; }
            else { g.Bt = W8 + (size_t)9216 * 512; g.nN = 6; E.ldc = 1536; E.csc = SW8 + 9216; }
        } else if (k == 2) {
            g.A = (const bf16*)(ws + WS_G); g.K = 256; g.a_pn = 256; g.Bt = (const bf16*)(ws + WS_WGRP); g.ldb = 256; g.b_pn = 65536;
            E.O = (void*)H; E.ldc = DM; E.mul = A->in[I_POOL_SCALE];
        } else if (k == 3) {
            if (kind == 0) { g.A = (const bf16*)(ws + WS_G); g.lda = SGUW; g.K = SGUW; g.Bt = (const bf16*)(ws + WS_WSGUOUT) + (size_t)jj * 1024 * 2048; }
            else if (kind == 1) { g.Bt = (const bf16*)(ws + WS_WPOOLOUT); }
            else { g.Bt = (const bf16*)(ws + WS_WO); }
            g.ldb = g.K; g.a_pm = 256 * (long)g.lda; g.b_pn = 256 * (long)g.ldb;
            E.type = 2; E.perm = true; E.srcLat = layer == 0 ? A->in[I_X] : nullptr; E.srcCtx = layer == 0 ? A->in[I_CTX] : nullptr;
        } else {
            g.nN = 8; g.lda = 512; g.K = 512; g.a_pm = 256 * 512; g.Bt = (const bf16*)(ws + WS_WPQ8) + (size_t)layer * 2048 * 512; g.ldb = 512; g.b_pn = 256 * 512;
            E.act = 2; E.O = (void*)(ws + WS_Z); E.ldc = 2048; E.csc = (const float*)(ws + WS_SWQ) + layer * 2048; E.rsc = (const float*)(ws + WS_SHQ);
        }
        E.o_pm = 256 * (long)E.ldc;
        pg8::StaticOrder S; S.init(g.nM, g.nN, F.G, F.bx);
        if (k == 5 || k == 0) { if (EN(2)) pg8::gemm_phase<true, true>(F.lds, g, S, E, F.tid); }
        else if (EN(2)) pg8::gemm_phase<true>(F.lds, g, S, E, F.tid);
    }
    if (layer < 2 && (k == 0 || k == 3 || k == 5) && F.bx >= 64 && F.G == 256) {
        const int slot = layer * 3 + (k == 0 ? 0 : (k == 3 ? 1 : 2));
        const int lo = TAB_ITEMS_PER_LAYER + (slot == 0 ? 0 : slot == 1 ? 6144 : slot == 2 ? 12288 : slot == 3 ? 15360 : slot == 4 ? 17818 : 21504);
        const int hi = TAB_ITEMS_PER_LAYER + (slot == 0 ? 6144 : slot == 1 ? 12288 : slot == 2 ? 15360 : slot == 3 ? 17818 : slot == 4 ? 21504 : 24576);
        op_tables(F, A, lo, hi, (F.bx - 64) * NWAVES + F.wave, (F.G - 64) * NWAVES);
    }
    return true;
}

__global__ void __launch_bounds__(NWAVES * 64, 2) mega_fwd(Args args) {
    extern __shared__ __attribute__((aligned(16))) unsigned char lds[];
    for (int u = threadIdx.x; u < (LDS_BYTES - LDSCTL_OFF) / 4; u += NWAVES * 64) ((LAS unsigned*)((LAS unsigned char*)lds + LDSCTL_OFF))[u] = 0u;
    __syncthreads();
    { const unsigned hw = (unsigned)__builtin_amdgcn_s_getreg((5 << 11) | 4) & 63u;
      if ((threadIdx.x & 63) == 0) ((LAS unsigned*)((LAS unsigned char*)lds + WSLOT_OFF))[hw] = threadIdx.x >> 6; }
    const int lo = args.lo, hi = args.hi;
    if (hi - lo > 1 && threadIdx.x == 0) {
        const unsigned xcc = xb_xcc_id(); const unsigned rk = xb_add((unsigned*)(args.ws + WS_CTL) + CW_BAR + XB_XCNT(xcc), 1u);
        ((LAS unsigned*)((LAS unsigned char*)lds + MISC_OFF))[12] = rk; ((LAS unsigned*)((LAS unsigned char*)lds + MISC_OFF))[13] = xcc; }
    __syncthreads();
    for (int step = lo; step < hi; ++step) {
        KArgs kp = (KArgs)__builtin_amdgcn_kernarg_segment_ptr();
        asm volatile("" : "+s"(kp));
        int g_ = gridDim.x, bx_ = blockIdx.x; unsigned lo_ = 0;
        asm volatile("" : "+s"(g_), "+s"(bx_), "+s"(lo_));
        Frame F;
        F.lds = (LAS unsigned char*)lds + lo_;
        const unsigned hw = (unsigned)__builtin_amdgcn_s_getreg((5 << 11) | 4) & 63u;
        F.wave = __builtin_amdgcn_readfirstlane(((volatile LAS unsigned*)(F.lds + WSLOT_OFF))[hw]);
        F.lane = (int)__builtin_amdgcn_mbcnt_hi(~0u, __builtin_amdgcn_mbcnt_lo(~0u, 0u)); asm volatile("" : "+v"(F.lane));
        F.tid = F.wave * 64 + F.lane;
        F.G = g_; F.bx = bx_; F.vcu = (g_ % 8 == 0) ? (bx_ % 8) * (g_ / 8) + bx_ / 8 : bx_;
        const int kcls = step < 2 ? 11 + step : (step - 2) % SPL;
        bool dry = ((REPK >> kcls) & 1) != 0 && (step < 2 || ((REPL >> ((step - 2) / SPL)) & 1));
        bool did = run_step(F, kp, step, dry);
        if (dry) {
            XcdBarrier bar; bar.bar = (unsigned*)(kp->ws + WS_CTL) + CW_BAR; bar.x = xb_xcc_id(); bar.st = (volatile LAS unsigned*)(F.lds + MISC_OFF) + 8;
            if (did) xcd_barrier(bar, F.tid);
            did = run_step(F, kp, step, false);
        }
        if (did && step + 1 < hi) {
            XcdBarrier bar; bar.bar = (unsigned*)(kp->ws + WS_CTL) + CW_BAR; bar.x = xb_xcc_id(); bar.st = (volatile LAS unsigned*)(F.lds + MISC_OFF) + 8;
            xcd_barrier(bar, F.tid);
        }
    }
}

extern "C" void kernel_launch(void* const* d_in, const int* in_sizes, int n_in, void* d_out, int out_size, void* d_ws, size_t ws_size, hipStream_t stream) {
    static int grid = 0;
    if (grid == 0) {
        if (n_in != N_IN || out_size != NLAT * DM || ws_size < WS_END) { fprintf(stderr, "kernel_launch: unexpected shapes: n_in %d out %d ws %zu (need >= %zu)\n", n_in, out_size, ws_size, (size_t)WS_END); grid = -1; return; }
        int dev = 0, cus = 0, per_cu = 0;
        if (hipGetDevice(&dev) != hipSuccess || hipDeviceGetAttribute(&cus, hipDeviceAttributeMultiprocessorCount, dev) != hipSuccess) { grid = -1; return; }
        if (hipFuncSetAttribute((const void*)mega_fwd, hipFuncAttributeMaxDynamicSharedMemorySize, LDS_BYTES) != hipSuccess) { fprintf(stderr, "kernel_launch: hipFuncSetAttribute failed\n"); grid = -1; return; }
        if (hipOccupancyMaxActiveBlocksPerMultiprocessor(&per_cu, (const void*)mega_fwd, NWAVES * 64, LDS_BYTES) != hipSuccess || per_cu < 1) { fprintf(stderr, "kernel_launch: occupancy query says %d\n", per_cu); (void)hipGetLastError(); grid = -1; return; }
        grid = cus;
    }
    if (grid < 0) return;
    (void)hipMemsetAsync((char*)d_ws + WS_CTL, 0, CTL_ZERO_BYTES, stream);
    Args a{};
    for (int i = 0; i < N_IN; ++i) a.in[i] = (const float*)d_in[i];
    a.out = (float*)d_out; a.ws = (unsigned char*)d_ws;
#if MK_MULTI
    for (int s = 0; s < NSTEPS; ++s) { a.lo = s; a.hi = s + 1; hipLaunchKernelGGL(mega_fwd, dim3(grid), dim3(NWAVES * 64), LDS_BYTES, stream, a); }
#else
    a.lo = 0; a.hi = NSTEPS;
    void* kargs[] = {&a};
    hipError_t e = hipLaunchCooperativeKernel((const void*)mega_fwd, dim3(grid), dim3(NWAVES * 64), kargs, LDS_BYTES, stream);
    if (e != hipSuccess) { fprintf(stderr, "kernel_launch: cooperative launch failed: %s\n", hipGetErrorString(e)); (void)hipGetLastError();
        hipLaunchKernelGGL(mega_fwd, dim3(grid), dim3(NWAVES * 64), LDS_BYTES, stream, a); }
#endif
}
```
